# Optimizing an MI355X kernel written in HIP

```python
import math
import jax, jax.numpy as jnp
from jax import lax
import numpy as np

D_MODEL = 1024
BATCH = 4
SEQ = 4096
DEPTH = 2
DEC_BATCH = 32
DEC_SEQ = 1
PAST_LEN = 16384
PAGE_SIZE = 128

HEAD_DIM = 64
MIX_WIDTH = 3 * D_MODEL // 2
GROUP_WIDTH = MIX_WIDTH // 4
N_HEADS = GROUP_WIDTH // HEAD_DIM
DIL_PAIRS = ((128, 1), (512, 4), (2048, 16))
WIN_MAX = 2048
ATT_BLOCK = 128
ROPE_THETA = 10000.0
DELTA_CONV = 4
SHORT_CONV = 3
CHUNK = 64
D_FF = 4 * D_MODEL
EPS = 1e-6
NEG = -1e30

IN_SPLITS = (
    ('a_q', GROUP_WIDTH), ('a_k', GROUP_WIDTH), ('a_v', GROUP_WIDTH),
    ('b_q', GROUP_WIDTH), ('b_k', GROUP_WIDTH), ('b_v', GROUP_WIDTH), ('b_z', GROUP_WIDTH),
    ('b_a', N_HEADS), ('b_b', N_HEADS),
    ('c_q', GROUP_WIDTH), ('c_k', GROUP_WIDTH), ('c_v', GROUP_WIDTH), ('c_g', GROUP_WIDTH),
    ('d_x', GROUP_WIDTH), ('d_c', GROUP_WIDTH), ('d_b', GROUP_WIDTH),
)
IN_WIDTH = 4 * 3 * GROUP_WIDTH + GROUP_WIDTH + 2 * N_HEADS + GROUP_WIDTH

kernel_name = 'hybrid_dilated_delta_retention_shortconv_step'


def _split_cols(z):
    out, off = {}, 0
    for name, w in IN_SPLITS:
        out[name] = z[..., off:off + w]
        off += w
    return out


def _heads(a):
    return a.reshape(a.shape[:-1] + (-1, HEAD_DIM))


def rmsnorm(x, g):
    xf = x.astype(jnp.float32)
    y = xf * lax.rsqrt(jnp.mean(xf * xf, axis=-1, keepdims=True) + EPS)
    return (y * g.astype(jnp.float32)).astype(x.dtype)


def l2norm(x):
    xf = x.astype(jnp.float32)
    return xf * lax.rsqrt(jnp.sum(xf * xf, axis=-1, keepdims=True) + EPS)


def _rope_freq():
    return ROPE_THETA ** (-jnp.arange(0, HEAD_DIM, 2, dtype=jnp.float32) / HEAD_DIM)


def _retnet_freq():
    return 1.0 / (10000.0 ** jnp.linspace(0.0, 1.0, HEAD_DIM // 2, dtype=jnp.float32))


def _retention_log_decay():
    return jnp.log(1.0 - 2.0 ** (-5.0 - jnp.arange(N_HEADS, dtype=jnp.float32)))


def rotate(x, pos, inv_freq):
    ang = pos.astype(jnp.float32)[:, None] * inv_freq[None, :]
    cos, sin = jnp.cos(ang)[None, :, None, :], jnp.sin(ang)[None, :, None, :]
    xf = x.astype(jnp.float32)
    x1, x2 = xf[..., :HEAD_DIM // 2], xf[..., HEAD_DIM // 2:]
    return jnp.concatenate([x1 * cos - x2 * sin, x2 * cos + x1 * sin], axis=-1).astype(x.dtype)


def causal_dwconv(x, prev, w):
    width, T = w.shape[0], x.shape[1]
    xp = jnp.concatenate([prev.astype(x.dtype), x], axis=1)
    y = xp[:, 0:T] * w[0]
    for j in range(1, width):
        y = y + xp[:, j:j + T] * w[j]
    return y, xp[:, T:]


def dilated_branch_prompt(q, k, v, window, dil):
    N, S, H, E = q.shape
    L = S // dil
    nk = window // dil
    nb = -(-L // ATT_BLOCK)
    Lp = nb * ATT_BLOCK

    def by_residue(a):
        return a.astype(jnp.float32).reshape(N, L, dil, H, E).transpose(0, 2, 3, 1, 4)

    qs = jnp.pad(by_residue(q), [(0, 0)] * 3 + [(0, Lp - L), (0, 0)]).reshape(N, dil, H, nb, ATT_BLOCK, E)

    def key_blocks(a):
        a = jnp.pad(by_residue(a), [(0, 0)] * 3 + [(ATT_BLOCK, Lp - L), (0, 0)])
        a = a.reshape(N, dil, H, nb + 1, ATT_BLOCK, E)
        return jnp.concatenate([a[:, :, :, :-1], a[:, :, :, 1:]], axis=4)

    kk, vv = key_blocks(k), key_blocks(v)
    s = jnp.einsum('ndhbqe,ndhbke->ndhbqk', qs, kk) * (E ** -0.5)
    dist = ATT_BLOCK + jnp.arange(ATT_BLOCK)[:, None] - jnp.arange(2 * ATT_BLOCK)[None, :]
    kidx = (jnp.arange(nb)[:, None] - 1) * ATT_BLOCK + jnp.arange(2 * ATT_BLOCK)[None, :]
    valid = ((dist >= 0) & (dist <= nk))[None] & (kidx >= 0)[:, None, :]
    s = jnp.where(valid, s, NEG)
    lse = jax.nn.logsumexp(s, axis=-1)
    o = jnp.einsum('ndhbqk,ndhbke->ndhbqe', jnp.exp(s - lse[..., None]), vv)
    o = o.reshape(N, dil, H, Lp, E)[:, :, :, :L].transpose(0, 3, 1, 2, 4).reshape(N, S, H, E)
    lse = lse.reshape(N, dil, H, Lp)[..., :L].transpose(0, 3, 1, 2).reshape(N, S, H)
    return o, lse


def dilated_branch_gather(q, k_all, v_all, q_pos, buf_start, window, dil):
    nk = window // dil
    kpos = q_pos[:, None] - dil * jnp.arange(nk + 1)[None, :]
    idx = kpos - buf_start
    valid = idx >= 0
    idx = jnp.clip(idx, 0, k_all.shape[1] - 1)
    kg = jnp.take(k_all, idx, axis=1).astype(jnp.float32)
    vg = jnp.take(v_all, idx, axis=1).astype(jnp.float32)
    s = jnp.einsum('nthe,ntjhe->nthj', q.astype(jnp.float32), kg) * (q.shape[-1] ** -0.5)
    s = jnp.where(valid[None, :, None, :], s, NEG)
    lse = jax.nn.logsumexp(s, axis=-1)
    o = jnp.einsum('nthj,ntjhe->nthe', jnp.exp(s - lse[..., None]), vg)
    return o, lse


def mix_by_denominators(outs, lses):
    w = jax.nn.softmax(jnp.stack(lses), axis=0)
    return jnp.einsum('gnth,gnthe->nthe', w, jnp.stack(outs))


def _to_chunks(a, Tp):
    pad = Tp - a.shape[1]
    a = jnp.pad(a.astype(jnp.float32), [(0, 0), (0, pad)] + [(0, 0)] * (a.ndim - 2))
    a = jnp.moveaxis(a, 1, 2)
    return a.reshape(a.shape[:2] + (Tp // CHUNK, CHUNK) + a.shape[3:])


def _from_chunks(o, T):
    nc, N, H, C, E = o.shape
    return o.transpose(1, 0, 3, 2, 4).reshape(N, nc * C, H, E)[:, :T]


def _chunk_decay(g):
    G = jnp.cumsum(g, axis=-1)
    incl = jnp.tril(jnp.ones((CHUNK, CHUNK), bool))
    D = jnp.exp(jnp.where(incl, G[..., :, None] - G[..., None, :], -jnp.inf))
    return G, D


def gated_delta_rule(q, k, v, g, beta, s0):
    T = q.shape[1]
    Tp = -(-T // CHUNK) * CHUNK
    qc, kc, vc = _to_chunks(q, Tp), _to_chunks(k, Tp), _to_chunks(v, Tp)
    gc, bc = _to_chunks(g, Tp), _to_chunks(beta, Tp)
    G, D = _chunk_decay(gc)
    strict = jnp.tril(jnp.ones((CHUNK, CHUNK), bool), -1)
    kb, vb = kc * bc[..., None], vc * bc[..., None]
    A = jnp.where(strict, jnp.einsum('nhbid,nhbjd->nhbij', kb, kc) * D, 0.0)
    M = A + jnp.eye(CHUNK, dtype=jnp.float32)
    rhs = jnp.concatenate([vb, kb * jnp.exp(G)[..., None]], axis=-1)
    sol = lax.linalg.triangular_solve(M, rhs, left_side=True, lower=True)
    dv = v.shape[-1]
    u, w = sol[..., :dv], sol[..., dv:]
    qk = jnp.einsum('nhbid,nhbjd->nhbij', qc, kc) * D
    Glast = G[..., -1:]
    xs = tuple(jnp.moveaxis(a, 2, 0) for a in (
        qc * jnp.exp(G)[..., None], kc * jnp.exp(Glast - G)[..., None], u, w, qk, jnp.exp(Glast[..., 0])))

    def step(S, inp):
        qg_c, kd_c, u_c, w_c, qk_c, dl_c = inp
        v_new = u_c - jnp.einsum('nhid,nhde->nhie', w_c, S)
        o = jnp.einsum('nhid,nhde->nhie', qg_c, S) + jnp.einsum('nhij,nhje->nhie', qk_c, v_new)
        S = S * dl_c[..., None, None] + jnp.einsum('nhid,nhie->nhde', kd_c, v_new)
        return S, o

    S, o = lax.scan(step, s0.astype(jnp.float32), xs)
    return _from_chunks(o, T), S


def retention(q, k, v, g, s0):
    T = q.shape[1]
    Tp = -(-T // CHUNK) * CHUNK
    qc, kc, vc, gc = (_to_chunks(a, Tp) for a in (q, k, v, g))
    G, D = _chunk_decay(gc)
    qk = jnp.einsum('nhbid,nhbjd->nhbij', qc, kc) * D
    Glast = G[..., -1:]
    xs = tuple(jnp.moveaxis(a, 2, 0) for a in (
        qc * jnp.exp(G)[..., None], kc * jnp.exp(Glast - G)[..., None], vc, qk, jnp.exp(Glast[..., 0])))

    def step(S, inp):
        qg_c, kd_c, v_c, qk_c, dl_c = inp
        o = jnp.einsum('nhid,nhde->nhie', qg_c, S) + jnp.einsum('nhij,nhje->nhie', qk_c, v_c)
        S = S * dl_c[..., None, None] + jnp.einsum('nhid,nhie->nhde', kd_c, v_c)
        return S, o

    S, o = lax.scan(step, s0.astype(jnp.float32), xs)
    return _from_chunks(o, T), S


def trunk_layer(x, pos0, prev, lw, is_prompt):
    a_k_prev, a_v_prev, b_conv_prev, b_rec_prev, c_rec_prev, d_conv_prev = prev
    (norm_mix, w_in, q_norm_a, k_norm_a, conv_b, a_log_b, dt_bias_b, onorm_b, onorm_c,
     conv_d, w_out, norm_ffn, w_up, w_down) = lw
    N, T, _ = x.shape
    dt = x.dtype
    f32 = jnp.float32
    pos = pos0 + jnp.arange(T, dtype=jnp.int32)
    z = _split_cols(rmsnorm(x, norm_mix) @ w_in)

    qa = rotate(rmsnorm(_heads(z['a_q']), q_norm_a), pos, _rope_freq())
    ka = rotate(rmsnorm(_heads(z['a_k']), k_norm_a), pos, _rope_freq())
    va = _heads(z['a_v'])
    if is_prompt:
        k_all, v_all = ka, va
        res = [dilated_branch_prompt(qa, ka, va, w, d) for w, d in DIL_PAIRS]
    else:
        k_all = jnp.concatenate([a_k_prev.astype(dt), ka], axis=1)
        v_all = jnp.concatenate([a_v_prev.astype(dt), va], axis=1)
        buf_start = pos0 - a_k_prev.shape[1]
        res = [dilated_branch_gather(qa, k_all, v_all, pos, buf_start, w, d) for w, d in DIL_PAIRS]
    o_a = mix_by_denominators([r[0] for r in res], [r[1] for r in res])
    keep = min(WIN_MAX, k_all.shape[1])

    qkv_b = jnp.concatenate([z['b_q'], z['b_k'], z['b_v']], axis=-1)
    conv_out, b_conv_new = causal_dwconv(qkv_b, b_conv_prev, conv_b)
    qb, kb, vb = jnp.split(jax.nn.silu(conv_out), 3, axis=-1)
    qb = l2norm(_heads(qb)) * (HEAD_DIM ** -0.5)
    kb = l2norm(_heads(kb))
    vb = _heads(vb)
    beta = jax.nn.sigmoid(z['b_b'].astype(f32))
    g_b = -jnp.exp(a_log_b.astype(f32)) * jax.nn.softplus(z['b_a'].astype(f32) + dt_bias_b.astype(f32))
    o_b, b_rec_new = gated_delta_rule(qb, kb, vb, g_b, beta, b_rec_prev)
    o_b = rmsnorm(o_b, onorm_b) * jax.nn.silu(_heads(z['b_z']).astype(f32))

    qc = rotate(_heads(z['c_q']), pos, _retnet_freq())
    kc = rotate(_heads(z['c_k']), pos, _retnet_freq()) * (HEAD_DIM ** -0.5)
    vc = _heads(z['c_v'])
    g_c = jnp.broadcast_to(_retention_log_decay(), (N, T, N_HEADS))
    o_c, c_rec_new = retention(qc, kc, vc, g_c, c_rec_prev)
    o_c = rmsnorm(o_c, onorm_c) * jax.nn.silu(_heads(z['c_g']).astype(f32))

    conv_d_out, d_conv_new = causal_dwconv(z['d_c'] * z['d_x'], d_conv_prev, conv_d)
    o_d = z['d_b'] * conv_d_out

    mix = jnp.concatenate([o_a.reshape(N, T, GROUP_WIDTH).astype(dt), o_b.reshape(N, T, GROUP_WIDTH).astype(dt),
                           o_c.reshape(N, T, GROUP_WIDTH).astype(dt), o_d.astype(dt)], axis=-1)
    x = x + mix @ w_out
    x = x + jnp.square(jax.nn.relu(rmsnorm(x, norm_ffn) @ w_up)) @ w_down
    new = (k_all[:, -keep:], v_all[:, -keep:], b_conv_new.astype(dt), b_rec_new.astype(dt),
           c_rec_new.astype(dt), d_conv_new.astype(dt))
    return x, new


def setup_inputs(seed: int = 0) -> dict:
    key = jax.random.key(seed)
    ks = jax.random.split(key, 24)
    f32 = jnp.float32

    def nrm(k, shape, s):
        return jax.random.normal(k, shape, f32) * s

    def gain(k, shape):
        return 1.0 + nrm(k, shape, 0.02)

    a_buf = min(WIN_MAX, PAST_LEN)
    dt = jnp.exp(jax.random.uniform(ks[13], (DEPTH, N_HEADS), f32, math.log(1e-3), math.log(1e-1)))
    return {
        'x_prompt': nrm(ks[0], (BATCH, SEQ, D_MODEL), 1.0),
        'x_sample': nrm(ks[1], (DEC_BATCH, DEC_SEQ, D_MODEL), 1.0),
        'cache_a_k': nrm(ks[2], (DEPTH, DEC_BATCH, a_buf, N_HEADS, HEAD_DIM), 1.0),
        'cache_a_v': nrm(ks[3], (DEPTH, DEC_BATCH, a_buf, N_HEADS, HEAD_DIM), 1.0),
        'state_b_conv': nrm(ks[4], (DEPTH, DEC_BATCH, DELTA_CONV - 1, 3 * GROUP_WIDTH), 1.0),
        'state_b_rec': nrm(ks[5], (DEPTH, DEC_BATCH, N_HEADS, HEAD_DIM, HEAD_DIM), 0.1),
        'state_c_rec': nrm(ks[6], (DEPTH, DEC_BATCH, N_HEADS, HEAD_DIM, HEAD_DIM), 1.0),
        'state_d_conv': nrm(ks[7], (DEPTH, DEC_BATCH, SHORT_CONV - 1, GROUP_WIDTH), 1.0),
        'norm_mix': gain(ks[8], (DEPTH, D_MODEL)),
        'w_in': nrm(ks[9], (DEPTH, D_MODEL, IN_WIDTH), D_MODEL ** -0.5),
        'q_norm_a': gain(ks[10], (DEPTH, HEAD_DIM)),
        'k_norm_a': gain(ks[11], (DEPTH, HEAD_DIM)),
        'conv_b': nrm(ks[12], (DEPTH, DELTA_CONV, 3 * GROUP_WIDTH), DELTA_CONV ** -0.5),
        'a_log_b': jnp.log(jax.random.uniform(ks[14], (DEPTH, N_HEADS), f32, 1.0, 16.0)),
        'dt_bias_b': dt + jnp.log(-jnp.expm1(-dt)),
        'onorm_b': gain(ks[15], (DEPTH, HEAD_DIM)),
        'onorm_c': gain(ks[16], (DEPTH, HEAD_DIM)),
        'conv_d': nrm(ks[17], (DEPTH, SHORT_CONV, GROUP_WIDTH), SHORT_CONV ** -0.5),
        'w_out': nrm(ks[18], (DEPTH, MIX_WIDTH, D_MODEL), MIX_WIDTH ** -0.5),
        'norm_ffn': gain(ks[19], (DEPTH, D_MODEL)),
        'w_up': nrm(ks[20], (DEPTH, D_MODEL, D_FF), D_MODEL ** -0.5),
        'w_down': nrm(ks[21], (DEPTH, D_FF, D_MODEL), D_FF ** -0.5),
    }


def reference(x_prompt, x_sample, cache_a_k, cache_a_v, state_b_conv, state_b_rec, state_c_rec, state_d_conv,
              norm_mix, w_in, q_norm_a, k_norm_a, conv_b, a_log_b, dt_bias_b, onorm_b, onorm_c, conv_d,
              w_out, norm_ffn, w_up, w_down):
    weights = (norm_mix, w_in, q_norm_a, k_norm_a, conv_b, a_log_b, dt_bias_b, onorm_b, onorm_c, conv_d,
               w_out, norm_ffn, w_up, w_down)
    bp, dtp = x_prompt.shape[0], x_prompt.dtype
    yp, ys = x_prompt, x_sample
    new_p, new_s = [], []
    for l in range(DEPTH):
        lw = tuple(w[l] for w in weights)
        prev_p = (None, None,
                  jnp.zeros((bp, DELTA_CONV - 1, 3 * GROUP_WIDTH), dtp),
                  jnp.zeros((bp, N_HEADS, HEAD_DIM, HEAD_DIM), dtp),
                  jnp.zeros((bp, N_HEADS, HEAD_DIM, HEAD_DIM), dtp),
                  jnp.zeros((bp, SHORT_CONV - 1, GROUP_WIDTH), dtp))
        yp, sp = trunk_layer(yp, 0, prev_p, lw, True)
        prev_s = (cache_a_k[l], cache_a_v[l], state_b_conv[l], state_b_rec[l], state_c_rec[l], state_d_conv[l])
        ys, ss = trunk_layer(ys, PAST_LEN, prev_s, lw, False)
        new_p.append(sp)
        new_s.append(ss)
    p_a_k = jnp.stack([s[0] for s in new_p])
    p_a_v = jnp.stack([s[1] for s in new_p])
    p_b_conv = jnp.stack([s[2] for s in new_p])
    p_b_rec = jnp.stack([s[3] for s in new_p])
    p_c_rec = jnp.stack([s[4] for s in new_p])
    p_d_conv = jnp.stack([s[5] for s in new_p])
    s_a_k = jnp.stack([s[0] for s in new_s])
    s_a_v = jnp.stack([s[1] for s in new_s])
    s_b_conv = jnp.stack([s[2] for s in new_s])
    s_b_rec = jnp.stack([s[3] for s in new_s])
    s_c_rec = jnp.stack([s[4] for s in new_s])
    s_d_conv = jnp.stack([s[5] for s in new_s])
    return (yp, ys, p_a_k, p_a_v, p_b_conv, p_b_rec, p_c_rec, p_d_conv,
            s_a_k, s_a_v, s_b_conv, s_b_rec, s_c_rec, s_d_conv)
```

```cpp
#include <hip/hip_runtime.h>
#include <hip/hip_cooperative_groups.h>
#include <cstdio>
namespace cg = cooperative_groups;
namespace pg8 {
#define PG8_LAS __attribute__((address_space(3)))
typedef unsigned short bf16_t;
typedef short bf16x8 __attribute__((ext_vector_type(8)));
typedef float f32x4 __attribute__((ext_vector_type(4)));
typedef unsigned u32x4 __attribute__((ext_vector_type(4)));
constexpr int BM = 256, BK = 64, HALF = 128, HTB = HALF * BK * 2  , STAGE_BYTES = 8 * HTB, NXCD = 8, WGM = 8;

__host__ __device__ __forceinline__ int lds_byte(int r, int c) { const int st = (r >> 4) * 2 + (c >> 5), rr = r & 15, cc = c & 31, ob = rr * 64 + cc * 2; return st * 1024 + (ob ^ (((ob >> 9) & 1) << 5)); }
__host__ __device__ __forceinline__ void stage_rc(int b, int& R, int& C) { const int st = b / 1024, sb = b % 1024, swz = sb ^ (((sb >> 9) & 1) << 5); R = (st >> 1) * 16 + swz / 64; C = (st & 1) * 32 + (swz % 64) / 2; }
__host__ __device__ __forceinline__ int perm32(int rho) { const int n = rho >> 4, i = rho & 15; return 8 * (i >> 2) + 4 * n + (i & 3); }

struct Unit { int pm, pn; };
struct Gemm { const bf16_t* A; const bf16_t* Bt; int M, N, K; };

struct StaticOrder {
    int nM, nN, nwg, G, c;
    __host__ __device__ void init(int M, int N, int G_, int c_) { nM = M / BM; nN = N / BM; nwg = nM * nN; G = G_; c = c_; }
    __host__ __device__ bool next(int i, Unit& u) const {
        const long L = (long)i * G + c; if (L >= nwg) return false;
        int wgid = (int)L; { const int q = nwg / NXCD, r = nwg % NXCD, xcd = wgid % NXCD, off = wgid / NXCD; wgid = (xcd < r ? xcd * (q + 1) : r * (q + 1) + (xcd - r) * q) + off; }
        const int nig = WGM * nN, gid = wgid / nig, fm = gid * WGM, gsz = (nM - fm) < WGM ? (nM - fm) : WGM;
        u.pm = fm + ((wgid % nig) % gsz); u.pn = (wgid % nig) / gsz; return true;
    }
    __device__ __forceinline__ void a_ready(const Unit&) const {}
    __device__ __forceinline__ void done(const Unit&) const {}
};
__device__ __forceinline__ unsigned cvt_pk_bf16(float lo, float hi) { unsigned r; asm volatile("v_cvt_pk_bf16_f32 %0, %1, %2" : "=v"(r) : "v"(lo), "v"(hi)); return r; }
template <class Epi, class Sched, bool STAMP = false>
__device__ __forceinline__ void gemm_phase(PG8_LAS unsigned char* lds, const Gemm g, const Sched& S, const Epi& E, unsigned long long* stamps) {
    int tid_ = threadIdx.x; asm volatile("" : "+v"(tid_));
    const int tid = tid_, wid = __builtin_amdgcn_readfirstlane(tid >> 6), lane = tid & 63, wr = wid >> 2, wc = wid & 3, fr = lane & 15, fq = lane >> 4;
    const int K = g.K, nt = K / BK;
    int ts_lo = 0, ts_hi = 0, nts = 0; const unsigned long long rt_entry = STAMP ? (unsigned long long)wall_clock64() : 0ull;
#define PG8_STAMP() do { if (STAMP && wid == 0 && nts < 64) { const unsigned long long _c = (unsigned long long)clock64(); \
        ts_lo = (lane == nts) ? (int)(unsigned)_c : ts_lo; ts_hi = (lane == nts) ? (int)(unsigned)(_c >> 32) : ts_hi; ++nts; } } while (0)
    PG8_STAMP();
    unsigned voffA[2], voffB[2];
#pragma unroll
    for (int i = 0; i < 2; ++i) { int R, C; stage_rc(tid * 16 + i * 8192, R, C); const int Rb = Epi::PERM ? ((R & ~31) + perm32(R & 31)) : R;
        voffA[i] = (unsigned)(R * K + C) * 2u; voffB[i] = (unsigned)(Rb * K + C) * 2u; }
    const size_t kstep = (size_t)(BK * 2);
    const size_t hstep = (size_t)HALF * K * 2;
    const size_t tstep = 2 * hstep;
    const unsigned ldsw = (unsigned)wid * 1024u;
    const int aoff = lds_byte(wr * 64 + fr, fq * 8), boff = lds_byte(wc * 32 + fr, fq * 8);
#define PG8_SA(b, h) (((b) * 2 + (h)) * HTB)
#define PG8_SB(b, h) ((4 + (b) * 2 + (h)) * HTB)
#define PG8_STAGE(bufoff, gbase, voff) do { _Pragma("unroll") for (int _i = 0; _i < 2; ++_i) \
        __builtin_amdgcn_global_load_lds((const unsigned*)((const char*)(gbase) + (voff)[_i]), (PG8_LAS unsigned*)(lds + (bufoff) + ldsw + _i * 8192), 16, 0, 0); } while (0)
#define PG8_LDA(dst, b, h) do { _Pragma("unroll") for (int m = 0; m < 4; ++m) _Pragma("unroll") for (int k = 0; k < 2; ++k) dst[m][k] = *(const PG8_LAS bf16x8*)(lds + PG8_SA(b, h) + aoff + m * 2048 + k * 1024); } while (0)
#define PG8_LDB(dst, b, h) do { _Pragma("unroll") for (int n = 0; n < 2; ++n) _Pragma("unroll") for (int k = 0; k < 2; ++k) dst[n][k] = *(const PG8_LAS bf16x8*)(lds + PG8_SB(b, h) + boff + n * 2048 + k * 1024); } while (0)
#define PG8_MMA(ai, bj, At, Bt) do { __builtin_amdgcn_s_setprio(1); _Pragma("unroll") for (int m = 0; m < 4; ++m) _Pragma("unroll") for (int n = 0; n < 2; ++n) _Pragma("unroll") for (int k = 0; k < 2; ++k) \
        acc[ai][bj][m][n] = __builtin_amdgcn_mfma_f32_16x16x32_bf16(Bt[n][k], At[m][k], acc[ai][bj][m][n], 0, 0, 0); __builtin_amdgcn_s_setprio(0); } while (0)
#define PG8_WAIT_V(n) asm volatile("s_waitcnt vmcnt(" #n ")" ::: "memory")
#define PG8_WAIT_L(n) asm volatile("s_waitcnt lgkmcnt(" #n ")" ::: "memory")
#define PG8_BAR __builtin_amdgcn_s_barrier()
#define PG8_SCHED __builtin_amdgcn_sched_barrier(0)
    Unit cur, nxt; int ui = 0;
    if (!S.next(0, cur)) return;
    f32x4 acc[2][2][4][2];
#pragma unroll
    for (int a = 0; a < 2; ++a)
#pragma unroll
        for (int b = 0; b < 2; ++b)
#pragma unroll
            for (int m = 0; m < 4; ++m)
#pragma unroll
                for (int n = 0; n < 2; ++n) acc[a][b][m][n] = (f32x4){0.f, 0.f, 0.f, 0.f};
    bf16x8 At[4][2], B0[2][2], B1[2][2];
    const char* cA = (const char*)g.A + (size_t)cur.pm * tstep; const char* cB = (const char*)g.Bt + (size_t)cur.pn * tstep;
    S.a_ready(cur);
    PG8_STAGE(PG8_SB(0, 0), cB, voffB); PG8_STAGE(PG8_SA(0, 0), cA, voffA); PG8_STAGE(PG8_SB(0, 1), cB + hstep, voffB); PG8_STAGE(PG8_SA(0, 1), cA + hstep, voffA);
    if (wr == 1) PG8_BAR;
    PG8_WAIT_V(4); PG8_BAR;
    PG8_STAGE(PG8_SB(1, 0), cB + kstep, voffB); PG8_STAGE(PG8_SA(1, 0), cA + kstep, voffA); PG8_STAGE(PG8_SB(1, 1), cB + hstep + kstep, voffB);
    PG8_WAIT_V(6); PG8_BAR;
    PG8_STAMP();
    for (;;) {
        const bool has_next = S.next(ui + 1, nxt);
        const char* nA = has_next ? (const char*)g.A + (size_t)nxt.pm * tstep : cA; const char* nB = has_next ? (const char*)g.Bt + (size_t)nxt.pn * tstep : cB;
        for (int t = 0; t < nt; t += 2) {
            const bool last = (t == nt - 2);
            const char* a1 = cA + (size_t)(t + 1) * kstep;
            const char* a2 = last ? nA : cA + (size_t)(t + 2) * kstep; const char* b2 = last ? nB : cB + (size_t)(t + 2) * kstep;
            const char* a3 = a2 + kstep; const char* b3 = b2 + kstep;
            if (last && has_next) S.a_ready(nxt);
            PG8_LDB(B0, 0, 0); PG8_SCHED; PG8_LDA(At, 0, 0); PG8_STAGE(PG8_SA(1, 1), a1 + hstep, voffA);
            PG8_WAIT_L(8); PG8_BAR; PG8_WAIT_L(0); PG8_MMA(0, 0, At, B0); PG8_BAR; PG8_SCHED;
            PG8_LDB(B1, 0, 1); PG8_STAGE(PG8_SB(0, 0), b2, voffB);
            PG8_BAR; PG8_WAIT_L(0); PG8_MMA(0, 1, At, B1); PG8_BAR;
            PG8_LDA(At, 0, 1); PG8_STAGE(PG8_SA(0, 0), a2, voffA);
            PG8_BAR; PG8_WAIT_L(0); PG8_MMA(1, 0, At, B0); PG8_BAR; PG8_SCHED;
            PG8_STAGE(PG8_SB(0, 1), b2 + hstep, voffB);
            PG8_WAIT_V(6); PG8_BAR; PG8_MMA(1, 1, At, B1); PG8_BAR;
            PG8_LDB(B0, 1, 0); PG8_SCHED; PG8_LDA(At, 1, 0); PG8_STAGE(PG8_SA(0, 1), a2 + hstep, voffA);
            PG8_WAIT_L(8); PG8_BAR; PG8_WAIT_L(0); PG8_MMA(0, 0, At, B0); PG8_BAR; PG8_SCHED;
            PG8_LDB(B1, 1, 1); PG8_STAGE(PG8_SB(1, 0), b3, voffB);
            PG8_BAR; PG8_WAIT_L(0); PG8_MMA(0, 1, At, B1); PG8_BAR;
            PG8_LDA(At, 1, 1); PG8_STAGE(PG8_SA(1, 0), a3, voffA);
            PG8_BAR; PG8_WAIT_L(0); PG8_MMA(1, 0, At, B0); PG8_BAR; PG8_SCHED;
            PG8_STAGE(PG8_SB(1, 1), b3 + hstep, voffB);
            PG8_WAIT_V(6); PG8_BAR; PG8_MMA(1, 1, At, B1); PG8_BAR;
        }
        PG8_STAMP();
        if constexpr (!Epi::AFTER_DRAIN) { E(acc, cur, wr, wc, fr, fq); S.done(cur); }
        PG8_STAMP();
        if (!has_next) break;
#pragma unroll
        for (int a = 0; a < 2; ++a)
#pragma unroll
            for (int b = 0; b < 2; ++b)
#pragma unroll
                for (int m = 0; m < 4; ++m)
#pragma unroll
                    for (int n = 0; n < 2; ++n) acc[a][b][m][n] = (f32x4){0.f, 0.f, 0.f, 0.f};
        cur = nxt; cA = nA; cB = nB; ++ui;
    }
    PG8_WAIT_V(0);
    if (wr == 0) PG8_BAR;
    PG8_BAR;
    if constexpr (Epi::AFTER_DRAIN) { E.fused(acc, cur, wr, wc, fr, fq, lds, wid, lane); S.done(cur); }
    PG8_STAMP();
    if (STAMP && wid == 0) { stamps[lane] = lane < nts ? (((unsigned long long)(unsigned)ts_hi << 32) | (unsigned)ts_lo) : 0ull;
        if (lane == 62) stamps[62] = rt_entry; if (lane == 63) stamps[63] = (unsigned long long)wall_clock64(); }
#undef PG8_STAMP
#undef PG8_SA
#undef PG8_SB
#undef PG8_STAGE
#undef PG8_LDA
#undef PG8_LDB
#undef PG8_MMA
#undef PG8_WAIT_V
#undef PG8_WAIT_L
#undef PG8_BAR
#undef PG8_SCHED
}
}
using pg8::bf16_t; using pg8::bf16x8; using pg8::f32x4; using pg8::u32x4;
typedef float f32x16 __attribute__((ext_vector_type(16)));
typedef unsigned u32x2 __attribute__((ext_vector_type(2)));
#define LAS __attribute__((address_space(3)))
#define DI __device__ __forceinline__

constexpr int T_ = 4096, NBAT = 4, MP = NBAT * T_, MD = 32, DM = 1024, NH = 6, HD = 64, GW = 384, MIXW = 1536, DFF = 4096, ZS = 5632, NIN = 5388;
constexpr int AQ = 0, AK = 384, AV = 768, BQ = 1152, BKo = 1536, BV = 1920, BZ = 2304, CQ = 2688, CK = 3072, CV = 3456, CG = 3840, DX = 4224, DC = 4608, DB = 4992, GA = 5376, GB = 5382;
constexpr float EPS = 1e-6f;
constexpr int LDS_BYTES = 147456;

constexpr size_t al256(size_t x) { return (x + 255) & ~(size_t)255; }
constexpr size_t SZ_WT_IN = (size_t)ZS * DM * 2, SZ_WT_OUT = (size_t)DM * MIXW * 2, SZ_WT_UP = (size_t)DFF * DM * 2, SZ_WT_DOWN = (size_t)DM * DFF * 2;
constexpr size_t WS_WT_IN = 0;
constexpr size_t WS_WT_OUT = WS_WT_IN + 2 * SZ_WT_IN;
constexpr size_t WS_WT_UP = WS_WT_OUT + 2 * SZ_WT_OUT;
constexpr size_t WS_WT_DOWN = WS_WT_UP + 2 * SZ_WT_UP;
constexpr size_t WS_XB = WS_WT_DOWN + 2 * SZ_WT_DOWN;
constexpr size_t WS_R1 = WS_XB + (size_t)MP * DM * 2;
constexpr size_t SZ_HEADBUF = (size_t)NBAT * NH * T_ * HD * 2;
constexpr size_t WS_QA = WS_R1 + (size_t)MP * ZS * 2;
constexpr size_t WS_KA = WS_QA + SZ_HEADBUF;
constexpr size_t WS_VT = WS_KA + SZ_HEADBUF;
constexpr size_t SZ_BBLK = (size_t)NBAT * NH * 64 * 40960, SZ_CBLK = (size_t)NBAT * NH * 64 * 32768;
constexpr size_t WS_R2 = WS_VT + 3 * SZ_HEADBUF;
constexpr size_t WS_BBLK = WS_R2, WS_CBLK = WS_R2 + SZ_BBLK;
constexpr size_t WS_HF = WS_R2, WS_HB = WS_R2 + (size_t)MP * DM * 4;
static_assert((size_t)MP * DM * 6 <= SZ_BBLK + SZ_CBLK, "alias");
constexpr size_t WS_OPART = WS_R2 + SZ_BBLK + SZ_CBLK;
constexpr size_t WS_LSE = WS_OPART + (size_t)3 * 24 * T_ * 64 * 4;
constexpr size_t WS_MIX = WS_LSE + (size_t)3 * 24 * T_ * 4;
constexpr size_t WS_XF = WS_MIX + (size_t)MP * MIXW * 2;
constexpr size_t WS_ROWSS = WS_XF + (size_t)MP * DM * 4;
constexpr size_t WS_DLB = WS_ROWSS + (size_t)5 * MP * 16 * 4;
constexpr size_t WS_XSB = al256(WS_DLB + 24 * 64 * 4);
constexpr size_t WS_XSF = WS_XSB + (size_t)MD * DM * 2;
constexpr size_t WS_ZD = WS_XSF + (size_t)MD * DM * 4;
constexpr size_t WS_MIXS = WS_ZD + (size_t)MD * ZS * 4;
constexpr size_t WS_HSF = WS_MIXS + (size_t)MD * MIXW * 2;
constexpr size_t WS_HSB = WS_HSF + (size_t)MD * DM * 4;
constexpr size_t WS_US = WS_HSB + (size_t)MD * DM * 2;
constexpr size_t WS_ROWSS_S = WS_US + (size_t)MD * DFF * 2;
constexpr size_t WS_TAB = al256(WS_ROWSS_S + (size_t)5 * 32 * 32 * 4);
constexpr size_t WS_END = WS_TAB + 256;

constexpr size_t O_YP = 0;
constexpr size_t O_YS = O_YP + (size_t)MP * DM;
constexpr size_t O_PAK = O_YS + (size_t)MD * DM;
constexpr size_t O_PAV = O_PAK + (size_t)2 * NBAT * 2048 * GW;
constexpr size_t O_PBCONV = O_PAV + (size_t)2 * NBAT * 2048 * GW;
constexpr size_t O_PBREC = O_PBCONV + (size_t)2 * NBAT * 3 * 1152;
constexpr size_t O_PCREC = O_PBREC + (size_t)2 * NBAT * NH * 4096;
constexpr size_t O_PDCONV = O_PCREC + (size_t)2 * NBAT * NH * 4096;
constexpr size_t O_SAK = O_PDCONV + (size_t)2 * NBAT * 2 * GW;
constexpr size_t O_SAV = O_SAK + (size_t)2 * MD * 2048 * GW;
constexpr size_t O_SBCONV = O_SAV + (size_t)2 * MD * 2048 * GW;
constexpr size_t O_SBREC = O_SBCONV + (size_t)2 * MD * 3 * 1152;
constexpr size_t O_SCREC = O_SBREC + (size_t)2 * MD * NH * 4096;
constexpr size_t O_SDCONV = O_SCREC + (size_t)2 * MD * NH * 4096;
constexpr size_t O_END = O_SDCONV + (size_t)2 * MD * 2 * GW;

struct Params { const float* in[22]; float* out; unsigned char* ws; };
enum { I_XP = 0, I_XS, I_CAK, I_CAV, I_SBCONV, I_SBREC, I_SCREC, I_SDCONV, I_NORM_MIX, I_W_IN, I_QNORM, I_KNORM, I_CONVB, I_ALOG, I_DTBIAS, I_ONORMB, I_ONORMC, I_CONVD, I_W_OUT, I_NORM_FFN, I_W_UP, I_W_DOWN };

DI int opaque_tid() { int t = threadIdx.x; asm volatile("" : "+v"(t)); return t; }
DI unsigned short f2bf(float x) { unsigned u = __float_as_uint(x); u += 0x7fffu + ((u >> 16) & 1u); return (unsigned short)(u >> 16); }
DI float bf2f(unsigned short b) { return __uint_as_float(((unsigned)b) << 16); }
DI unsigned pack2(float lo, float hi) { return (unsigned)f2bf(lo) | ((unsigned)f2bf(hi) << 16); }
DI float bflo(unsigned w) { return __uint_as_float(w << 16); }
DI float bfhi(unsigned w) { return __uint_as_float(w & 0xffff0000u); }
DI void unpack8(const uint4& v, float* f) { f[0] = bflo(v.x); f[1] = bfhi(v.x); f[2] = bflo(v.y); f[3] = bfhi(v.y); f[4] = bflo(v.z); f[5] = bfhi(v.z); f[6] = bflo(v.w); f[7] = bfhi(v.w); }
DI uint4 pack8(const float* f) { uint4 v; v.x = pack2(f[0], f[1]); v.y = pack2(f[2], f[3]); v.z = pack2(f[4], f[5]); v.w = pack2(f[6], f[7]); return v; }
DI float silu_f(float x) { return x / (1.f + __expf(-x)); }
DI float wave_sum(float v) { for (int m = 32; m >= 1; m >>= 1) v += __shfl_xor(v, m); return v; }
DI float wave_max(float v) { for (int m = 32; m >= 1; m >>= 1) v = fmaxf(v, __shfl_xor(v, m)); return v; }
DI int crow(int reg, int h) { return (reg & 3) + 8 * (reg >> 2) + 4 * h; }
#define MFMA32(a, b, c) __builtin_amdgcn_mfma_f32_32x32x16_bf16((a), (b), (c), 0, 0, 0)
#define MFMA16(a, b, c) __builtin_amdgcn_mfma_f32_16x16x32_bf16((a), (b), (c), 0, 0, 0)
DI bf16x8 mk8(unsigned a, unsigned b, unsigned c, unsigned d) { u32x4 v; v.x = a; v.y = b; v.z = c; v.w = d; return __builtin_bit_cast(bf16x8, v); }
DI float rs_from_slots16(const float* p) { const float4 a = *(const float4*)p, b = *(const float4*)(p + 4), c = *(const float4*)(p + 8), d = *(const float4*)(p + 12);
    const float s = (a.x + a.y + a.z + a.w) + (b.x + b.y + b.z + b.w) + (c.x + c.y + c.z + c.w) + (d.x + d.y + d.z + d.w); return rsqrtf(s * (1.f / DM) + EPS); }

template <int ACT> struct EpiZ {
    static constexpr bool PERM = true, AFTER_DRAIN = false;
    bf16_t* O; int ldc; const float* rowss;
    DI void operator()(const f32x4 (&acc)[2][2][4][2], const pg8::Unit& u, int wr, int wc, int fr, int fq) const {
        const int row0 = u.pm * 256 + wr * 64 + fr, col0 = u.pn * 256 + wc * 32 + 8 * fq;
#pragma unroll
        for (int ai = 0; ai < 2; ++ai)
#pragma unroll
            for (int m = 0; m < 4; ++m) {
                const int row = row0 + ai * 128 + m * 16;
                const float rs = rs_from_slots16(rowss + (size_t)row * 16);
                bf16_t* rowp = O + (size_t)row * ldc + col0;
#pragma unroll
                for (int bj = 0; bj < 2; ++bj) {
                    f32x4 v0 = acc[ai][bj][m][0] * rs, v1 = acc[ai][bj][m][1] * rs;
                    if (ACT == 1) {
#pragma unroll
                        for (int j = 0; j < 4; ++j) { float a = fmaxf(v0[j], 0.f), b = fmaxf(v1[j], 0.f); v0[j] = a * a; v1[j] = b * b; } }
                    u32x4 w; w.x = pg8::cvt_pk_bf16(v0[0], v0[1]); w.y = pg8::cvt_pk_bf16(v0[2], v0[3]); w.z = pg8::cvt_pk_bf16(v1[0], v1[1]); w.w = pg8::cvt_pk_bf16(v1[2], v1[3]);
                    *(u32x4*)(rowp + bj * 128) = w; } }
    }
};
struct EpiRes {
    static constexpr bool PERM = false, AFTER_DRAIN = false;
    const float* resid; float* outf; bf16_t* outb; float* ssout;
    DI void operator()(const f32x4 (&acc)[2][2][4][2], const pg8::Unit& u, int wr, int wc, int fr, int fq) const {
        const int row0 = u.pm * 256 + wr * 64 + fr, col0 = u.pn * 256 + wc * 32 + 4 * fq;
#pragma unroll
        for (int ai = 0; ai < 2; ++ai)
#pragma unroll
            for (int m = 0; m < 4; ++m) {
                const int row = row0 + ai * 128 + m * 16; float ss = 0.f;
#pragma unroll
                for (int bj = 0; bj < 2; ++bj)
#pragma unroll
                    for (int n = 0; n < 2; ++n) {
                        const size_t o = (size_t)row * DM + col0 + bj * 128 + n * 16;
                        const f32x4 v = acc[ai][bj][m][n] + *(const f32x4*)(resid + o);
                        *(f32x4*)(outf + o) = v;
                        uint2 w; w.x = pg8::cvt_pk_bf16(v[0], v[1]); w.y = pg8::cvt_pk_bf16(v[2], v[3]);
                        *(uint2*)(outb + o) = w;
                        ss += v[0] * v[0] + v[1] * v[1] + v[2] * v[2] + v[3] * v[3]; }
                ss += __shfl_xor(ss, 16); ss += __shfl_xor(ss, 32);
                if (fq == 0) ssout[(size_t)row * 16 + u.pn * 4 + wc] = ss; }
    }
};

template <class F> DI void skinny(unsigned char* smem, const bf16_t* A, const bf16_t* Bt, int ntiles, int K, int first, int stride, F f) {
    float* red = (float*)smem;
    const int tid = opaque_tid(), wid = tid >> 6, lane = tid & 63, r = lane & 31, h = lane >> 5;
    const int kw = K >> 3;
    for (int tile = first; tile < ntiles; tile += stride) {
        f32x16 acc; for (int i = 0; i < 16; ++i) acc[i] = 0.f;
        const bf16_t* ap = A + (size_t)r * K + wid * kw + 8 * h;
        const bf16_t* bp = Bt + (size_t)(tile * 32 + r) * K + wid * kw + 8 * h;
#pragma unroll 4
        for (int k = 0; k < kw; k += 16) { const bf16x8 a = *(const bf16x8*)(ap + k); const bf16x8 b = *(const bf16x8*)(bp + k); acc = MFMA32(a, b, acc); }
#pragma unroll
        for (int i = 0; i < 16; ++i) red[wid * 1024 + crow(i, h) * 32 + r] = acc[i];
        __syncthreads();
        for (int o = tid; o < 1024; o += 512) { float s = 0.f;
#pragma unroll
            for (int w = 0; w < 8; ++w) s += red[w * 1024 + o];
            f(o >> 5, tile * 32 + (o & 31), s, tile); }
        __syncthreads();
    }
}
DI void transpose_tile(float* tl, const float* W, int ldw, int k0, int nsrc0, int nvalid, const float* gain, bf16_t* Bt, int K, int ndst0) {
    const int tid = opaque_tid(), col = tid & 63, rb = tid >> 6;
#pragma unroll
    for (int i = 0; i < 8; ++i) { const int kk = rb + 8 * i;
        float v = 0.f; if (col < nvalid) { v = W[(size_t)(k0 + kk) * ldw + nsrc0 + col]; if (gain) v *= gain[k0 + kk]; }
        tl[kk * 65 + col] = v; }
    __syncthreads();
    { const int n = tid >> 3, ks = (tid & 7) * 8; float f[8];
#pragma unroll
      for (int j = 0; j < 8; ++j) f[j] = tl[(ks + j) * 65 + n];
      *(uint4*)(Bt + (size_t)(ndst0 + n) * K + k0 + ks) = pack8(f); }
    __syncthreads();
}

DI void phase0(unsigned char* smem, const Params& p) {
    const int G = gridDim.x, b = blockIdx.x, tid = opaque_tid(), wid = tid >> 6, lane = tid & 63;
    float* tl = (float*)smem;
    for (int task = b; task < 2 * 3840; task += G) {
        const int l = task / 3840; int t = task % 3840;
        if (t < 1408) { const int kt = t / 88, nt = t % 88, nd = nt * 64; int ns, nv;
            if (nd < 2688) { ns = nd; nv = 64; } else if (nd < 5376) { ns = nd + 12; nv = 64; } else if (nd == 5376) { ns = 2688; nv = 12; } else { ns = 0; nv = 0; }
            transpose_tile(tl, p.in[I_W_IN] + (size_t)l * DM * NIN, NIN, kt * 64, ns, nv, p.in[I_NORM_MIX] + l * DM, (bf16_t*)(p.ws + WS_WT_IN + l * SZ_WT_IN), DM, nd); }
        else if (t < 1408 + 384) { t -= 1408; const int kt = t / 16, nt = t % 16;
            transpose_tile(tl, p.in[I_W_OUT] + (size_t)l * MIXW * DM, DM, kt * 64, nt * 64, 64, nullptr, (bf16_t*)(p.ws + WS_WT_OUT + l * SZ_WT_OUT), MIXW, nt * 64); }
        else if (t < 1408 + 384 + 1024) { t -= 1408 + 384; const int kt = t / 64, nt = t % 64;
            transpose_tile(tl, p.in[I_W_UP] + (size_t)l * DM * DFF, DFF, kt * 64, nt * 64, 64, p.in[I_NORM_FFN] + l * DM, (bf16_t*)(p.ws + WS_WT_UP + l * SZ_WT_UP), DM, nt * 64); }
        else { t -= 1408 + 384 + 1024; const int kt = t / 16, nt = t % 16;
            transpose_tile(tl, p.in[I_W_DOWN] + (size_t)l * DFF * DM, DM, kt * 64, nt * 64, 64, nullptr, (bf16_t*)(p.ws + WS_WT_DOWN + l * SZ_WT_DOWN), DFF, nt * 64); }
    }
    for (int row = b * 8 + wid; row < MP + MD; row += G * 8) {
        const bool dec = row >= MP; const int r = dec ? row - MP : row;
        const float* src = dec ? p.in[I_XS] + (size_t)r * DM : p.in[I_XP] + (size_t)r * DM;
        bf16_t* dst = dec ? (bf16_t*)(p.ws + WS_XSB) + (size_t)r * DM : (bf16_t*)(p.ws + WS_XB) + (size_t)r * DM;
        float ss = 0.f;
#pragma unroll
        for (int i = 0; i < 4; ++i) { const float4 v = *(const float4*)(src + i * 256 + lane * 4); ss += v.x * v.x + v.y * v.y + v.z * v.z + v.w * v.w;
            uint2 w; w.x = pack2(v.x, v.y); w.y = pack2(v.z, v.w); *(uint2*)(dst + i * 256 + lane * 4) = w; }
        ss = wave_sum(ss);
        if (dec) { float* s = (float*)(p.ws + WS_ROWSS_S) + (size_t)r * 32; if (lane < 32) s[lane] = lane == 0 ? ss : 0.f; }
        else { float* s = (float*)(p.ws + WS_ROWSS) + (size_t)r * 16; if (lane < 16) s[lane] = lane == 0 ? ss : 0.f; }
    }
    { const size_t per = (size_t)2047 * GW / 4, tot = per * 64 * 2;
      for (size_t i = (size_t)b * 512 + tid; i < tot; i += (size_t)G * 512) {
          const int which = (int)(i / (per * 64)); const size_t rem = i % (per * 64); const size_t ln = rem / per, off = rem % per;
          const f32x4* src = (const f32x4*)(p.in[which ? I_CAV : I_CAK] + ln * 2048 * GW + GW) + off;
          f32x4* dst = (f32x4*)(p.out + (which ? O_SAV : O_SAK) + ln * 2048 * GW) + off;
          __builtin_nontemporal_store(__builtin_nontemporal_load(src), dst); } }
}
DI float rope_inv_freq(int fi) { return exp2f(-(float)(2 * fi) * (13.287712379549449f / 64.f)); }
DI float ret_inv_freq(int fi) { return exp2f(-(float)fi * (13.287712379549449f / 31.f)); }

DI void aprep_task(unsigned char* smem, const Params& p, int l, int task) {
    const int n = task / (NH * 64), h = (task / 64) % NH, tile = task % 64;
    const int tid = opaque_tid(), i = tid >> 3, seg = tid & 7, t = tile * 64 + i;
    const bf16_t* zrow = (const bf16_t*)(p.ws + WS_R1) + (size_t)(n * T_ + t) * ZS;
    const size_t hoff = ((size_t)(n * NH + h) * T_ + t) * HD + 8 * seg;
    float cs[8], sn[8];
#pragma unroll
    for (int j = 0; j < 8; ++j) { const int fi = (8 * seg + j) & 31; const float ang = (float)t * rope_inv_freq(fi); sincosf(ang, &sn[j], &cs[j]); }
#pragma unroll
    for (int which = 0; which < 2; ++which) {
        float x[8]; unpack8(*(const uint4*)(zrow + (which ? AK : AQ) + h * 64 + 8 * seg), x);
        float ss = 0.f;
#pragma unroll
        for (int j = 0; j < 8; ++j) ss += x[j] * x[j];
        ss += __shfl_xor(ss, 1); ss += __shfl_xor(ss, 2); ss += __shfl_xor(ss, 4);
        const float r = rsqrtf(ss * (1.f / 64.f) + EPS);
        const float* gn = p.in[which ? I_KNORM : I_QNORM] + l * HD + 8 * seg;
        float y[8], o[8];
#pragma unroll
        for (int j = 0; j < 8; ++j) y[j] = x[j] * r * gn[j];
#pragma unroll
        for (int j = 0; j < 8; ++j) { const float pr = __shfl_xor(y[j], 4); o[j] = (seg < 4) ? (y[j] * cs[j] - pr * sn[j]) : (y[j] * cs[j] + pr * sn[j]); }
        if (which == 0) {
#pragma unroll
            for (int j = 0; j < 8; ++j) o[j] *= 0.125f;
            *(uint4*)((bf16_t*)(p.ws + WS_QA) + hoff) = pack8(o);
        } else {
            *(uint4*)((bf16_t*)(p.ws + WS_KA) + hoff) = pack8(o);
            if (t >= T_ - 2048) { float* d = p.out + O_PAK + (((size_t)(l * NBAT + n) * 2048 + (t - (T_ - 2048))) * NH + h) * HD + 8 * seg;
                *(float4*)d = make_float4(o[0], o[1], o[2], o[3]); *(float4*)(d + 4) = make_float4(o[4], o[5], o[6], o[7]); }
        }
    }
    unsigned short* vt = (unsigned short*)smem;
    { const uint4 raw = *(const uint4*)(zrow + AV + h * 64 + 8 * seg); float x[8]; unpack8(raw, x);
      if (t >= T_ - 2048) { float* d = p.out + O_PAV + (((size_t)(l * NBAT + n) * 2048 + (t - (T_ - 2048))) * NH + h) * HD + 8 * seg;
          *(float4*)d = make_float4(x[0], x[1], x[2], x[3]); *(float4*)(d + 4) = make_float4(x[4], x[5], x[6], x[7]); }
#pragma unroll
      for (int j = 0; j < 8; ++j) vt[i * 66 + 8 * seg + j] = f2bf(x[j]); }
    __syncthreads();
    { const int dim = tid >> 3, ts = tid & 7; unsigned short e[8];
#pragma unroll
      for (int j = 0; j < 8; ++j) e[j] = vt[(8 * ts + j) * 66 + dim];
      const int tb = tile * 64 + 8 * ts;
      bf16_t* base = (bf16_t*)(p.ws + WS_VT) + ((size_t)(n * NH + h) * HD + dim) * T_;
      uint4 w; w.x = e[0] | ((unsigned)e[1] << 16); w.y = e[2] | ((unsigned)e[3] << 16); w.z = e[4] | ((unsigned)e[5] << 16); w.w = e[6] | ((unsigned)e[7] << 16);
      *(uint4*)(base + tb) = w;
      bf16_t* b4 = base + SZ_HEADBUF / 2;
#pragma unroll
      for (int rr = 0; rr < 4; ++rr) *(unsigned*)(b4 + rr * 1024 + tb / 4) = e[rr] | ((unsigned)e[rr + 4] << 16);
      bf16_t* b16 = base + SZ_HEADBUF;
#pragma unroll
      for (int j = 0; j < 8; ++j) b16[(8 * (ts & 1) + j) * 256 + tb / 16] = e[j]; }
    __syncthreads();
}

DI void dmix_task(const Params& p, int l, int task) {
    const int n = task / 64, tile = task % 64, tid = opaque_tid();
    const bf16_t* zb = (const bf16_t*)(p.ws + WS_R1) + (size_t)n * T_ * ZS;
    const float* cw = p.in[I_CONVD] + (size_t)l * 3 * GW;
    for (int item = tid; item < 64 * 48; item += 512) {
        const int i = item / 48, cg8 = (item % 48) * 8, t = tile * 64 + i;
        float prod[3][8];
#pragma unroll
        for (int j = 0; j < 3; ++j) { const int tt = t - 2 + j;
            if (tt >= 0) { float a[8], c[8]; unpack8(*(const uint4*)(zb + (size_t)tt * ZS + DX + cg8), a); unpack8(*(const uint4*)(zb + (size_t)tt * ZS + DC + cg8), c);
#pragma unroll
                for (int e = 0; e < 8; ++e) prod[j][e] = a[e] * c[e]; }
            else {
#pragma unroll
                for (int e = 0; e < 8; ++e) prod[j][e] = 0.f; } }
        float bb[8], o[8]; unpack8(*(const uint4*)(zb + (size_t)t * ZS + DB + cg8), bb);
#pragma unroll
        for (int e = 0; e < 8; ++e) o[e] = bb[e] * (prod[0][e] * cw[cg8 + e] + prod[1][e] * cw[GW + cg8 + e] + prod[2][e] * cw[2 * GW + cg8 + e]);
        *(uint4*)((bf16_t*)(p.ws + WS_MIX) + (size_t)(n * T_ + t) * MIXW + 3 * GW + cg8) = pack8(o);
        if (t >= T_ - 2) { float* d = p.out + O_PDCONV + ((size_t)(l * NBAT + n) * 2 + (t - (T_ - 2))) * GW + cg8;
#pragma unroll
            for (int e = 0; e < 8; ++e) d[e] = prod[2][e]; }
    }
    if (tile == 63) for (int item = tid; item < 3 * 1152; item += 512) { const int rr = item / 1152, c = item % 1152;
        p.out[O_PBCONV + ((size_t)(l * NBAT + n) * 3 + rr) * 1152 + c] = bf2f(zb[(size_t)(T_ - 3 + rr) * ZS + BQ + c]); }
}

template <bool IS_B> DI void chunk_prep(unsigned char* smem, const Params& p, int l, int task) {
    const int nh = task / 64, ch = task % 64, n = nh / NH, h = nh % NH;
    float* qs = (float*)smem; float* ks = qs + 64 * 68; float* vs = ks + 64 * 68; float* As = vs + 64 * 68; float* Gs = As + 4096; float* betas = Gs + 64; float* graw = betas + 64;
    const int tid = opaque_tid(), i = tid >> 3, seg = tid & 7, t = ch * 64 + i;
    const bf16_t* zrow = (const bf16_t*)(p.ws + WS_R1) + (size_t)(n * T_ + t) * ZS;
    bf16_t* blk = IS_B ? (bf16_t*)(p.ws + WS_BBLK + (size_t)task * 40960) : (bf16_t*)(p.ws + WS_CBLK + (size_t)task * 32768);
    bf16_t* o_w = blk; bf16_t* o_kdt = IS_B ? blk + 4096 : blk; bf16_t* o_qg = o_kdt + 4096; bf16_t* o_qk = o_qg + 4096; bf16_t* o_ut = o_qk + 4096;
    const float lg = IS_B ? 0.f : __logf(1.f - exp2f(-5.f - (float)h));
    if (IS_B) {
        const float* cwb = p.in[I_CONVB] + (size_t)l * 4 * 1152;
#pragma unroll
        for (int which = 0; which < 3; ++which) {
            float a[8];
#pragma unroll
            for (int e = 0; e < 8; ++e) a[e] = 0.f;
            const int co = which * GW + h * 64 + 8 * seg;
#pragma unroll
            for (int j = 0; j < 4; ++j) { const int tt = t - 3 + j;
                if (tt >= 0) { float x[8]; unpack8(*(const uint4*)(zrow + (ptrdiff_t)(j - 3) * ZS + BQ + co), x);
                    const float4 w0 = *(const float4*)(cwb + j * 1152 + co), w1 = *(const float4*)(cwb + j * 1152 + co + 4);
                    a[0] += x[0] * w0.x; a[1] += x[1] * w0.y; a[2] += x[2] * w0.z; a[3] += x[3] * w0.w; a[4] += x[4] * w1.x; a[5] += x[5] * w1.y; a[6] += x[6] * w1.z; a[7] += x[7] * w1.w; } }
#pragma unroll
            for (int e = 0; e < 8; ++e) a[e] = silu_f(a[e]);
            if (which < 2) { float ss = 0.f;
#pragma unroll
                for (int e = 0; e < 8; ++e) ss += a[e] * a[e];
                ss += __shfl_xor(ss, 1); ss += __shfl_xor(ss, 2); ss += __shfl_xor(ss, 4);
                const float r = rsqrtf(ss + EPS) * (which == 0 ? 0.125f : 1.f);
#pragma unroll
                for (int e = 0; e < 8; ++e) a[e] *= r; }
            float* dst = (which == 0 ? qs : which == 1 ? ks : vs) + i * 68 + 8 * seg;
            *(float4*)dst = make_float4(a[0], a[1], a[2], a[3]); *(float4*)(dst + 4) = make_float4(a[4], a[5], a[6], a[7]);
        }
        if (seg == 0) { const float za = bf2f(zrow[GA + h]), zb = bf2f(zrow[GB + h]);
            const float xx = za + p.in[I_DTBIAS][l * NH + h]; const float sp = xx > 20.f ? xx : log1pf(__expf(xx));
            graw[i] = -__expf(p.in[I_ALOG][l * NH + h]) * sp; betas[i] = 1.f / (1.f + __expf(-zb)); }
        __syncthreads();
        if (tid < 64) { float v = graw[tid];
#pragma unroll
            for (int off = 1; off < 64; off <<= 1) { const float u = __shfl_up(v, off); if (tid >= off) v += u; }
            Gs[tid] = v; }
        __syncthreads();
    } else {
        float cs[8], sn[8];
#pragma unroll
        for (int j = 0; j < 8; ++j) { const int fi = (8 * seg + j) & 31; const float ang = (float)t * ret_inv_freq(fi); sincosf(ang, &sn[j], &cs[j]); }
#pragma unroll
        for (int which = 0; which < 2; ++which) {
            float y[8], o[8]; unpack8(*(const uint4*)(zrow + (which ? CK : CQ) + h * 64 + 8 * seg), y);
#pragma unroll
            for (int j = 0; j < 8; ++j) { const float pr = __shfl_xor(y[j], 4); o[j] = (seg < 4) ? (y[j] * cs[j] - pr * sn[j]) : (y[j] * cs[j] + pr * sn[j]); if (which) o[j] *= 0.125f; }
            float* dst = (which ? ks : qs) + i * 68 + 8 * seg;
            *(float4*)dst = make_float4(o[0], o[1], o[2], o[3]); *(float4*)(dst + 4) = make_float4(o[4], o[5], o[6], o[7]);
        }
        { float x[8]; unpack8(*(const uint4*)(zrow + CV + h * 64 + 8 * seg), x); float* dst = vs + i * 68 + 8 * seg;
          *(float4*)dst = make_float4(x[0], x[1], x[2], x[3]); *(float4*)(dst + 4) = make_float4(x[4], x[5], x[6], x[7]); }
        if (tid < 64) Gs[tid] = (float)(tid + 1) * lg;
        __syncthreads();
    }
    { const int jg = seg; float aqk[8], akk[8];
#pragma unroll
      for (int jj = 0; jj < 8; ++jj) { aqk[jj] = 0.f; akk[jj] = 0.f; }
#pragma unroll 4
      for (int d4 = 0; d4 < 16; ++d4) { const float4 qv = *(const float4*)(qs + i * 68 + 4 * d4); const float4 kiv = *(const float4*)(ks + i * 68 + 4 * d4);
#pragma unroll
          for (int jj = 0; jj < 8; ++jj) { const float4 kv = *(const float4*)(ks + (jg + 8 * jj) * 68 + 4 * d4);
              aqk[jj] += qv.x * kv.x + qv.y * kv.y + qv.z * kv.z + qv.w * kv.w;
              if (IS_B) akk[jj] += kiv.x * kv.x + kiv.y * kv.y + kiv.z * kv.z + kiv.w * kv.w; } }
      const float Gi = Gs[i]; const float bi = IS_B ? betas[i] : 0.f;
#pragma unroll
      for (int jj = 0; jj < 8; ++jj) { const int j = jg + 8 * jj; const float dec = (i >= j) ? __expf(Gi - Gs[j]) : 0.f;
          o_qk[i * 64 + j] = f2bf(aqk[jj] * dec);
          if (IS_B) As[i * 64 + j] = (i > j) ? bi * akk[jj] * dec : 0.f; } }
    { const float eg = __expf(Gs[i]); float o[8];
#pragma unroll
      for (int e = 0; e < 8; ++e) o[e] = qs[i * 68 + 8 * seg + e] * eg;
      *(uint4*)(o_qg + i * 64 + 8 * seg) = pack8(o);
      const int d = i; const float G63 = Gs[63];
#pragma unroll
      for (int e = 0; e < 8; ++e) { const int j = 8 * seg + e; o[e] = ks[j * 68 + d] * __expf(G63 - Gs[j]); }
      *(uint4*)(o_kdt + d * 64 + 8 * seg) = pack8(o);
      if (!IS_B) {
#pragma unroll
          for (int e = 0; e < 8; ++e) o[e] = vs[(8 * seg + e) * 68 + d];
          *(uint4*)(o_ut + d * 64 + 8 * seg) = pack8(o); }
      if (IS_B && tid == 0) ((float*)(p.ws + WS_DLB))[task] = __expf(G63); }
    __syncthreads();
    if (IS_B) {
        float* Xs = graw + 64;
        { const int c = tid & 127, pt = tid >> 7;
#pragma unroll 4
          for (int k = 0; k < 16; ++k) { const int i2 = pt * 16 + k;
              Xs[i2 * 128 + c] = (c < 64) ? betas[i2] * vs[i2 * 68 + c] : betas[i2] * __expf(Gs[i2]) * ks[i2 * 68 + (c - 64)]; } }
        __syncthreads();
#pragma unroll 1
        for (int rb = 0; rb < 4; ++rb) {
            if (rb > 0) { const int c = tid & 127, pt = tid >> 7, r0 = 16 * rb + 4 * pt; float a0 = 0.f, a1 = 0.f, a2 = 0.f, a3 = 0.f;
#pragma unroll 4
                for (int j = 0; j < 16 * rb; ++j) { const float x = Xs[j * 128 + c];
                    a0 += As[(r0 + 0) * 64 + j] * x; a1 += As[(r0 + 1) * 64 + j] * x; a2 += As[(r0 + 2) * 64 + j] * x; a3 += As[(r0 + 3) * 64 + j] * x; }
                Xs[(r0 + 0) * 128 + c] -= a0; Xs[(r0 + 1) * 128 + c] -= a1; Xs[(r0 + 2) * 128 + c] -= a2; Xs[(r0 + 3) * 128 + c] -= a3; }
            __syncthreads();
            if (tid < 128) { const int c = tid; float X[16];
#pragma unroll
                for (int i2 = 0; i2 < 16; ++i2) { float sx = Xs[(16 * rb + i2) * 128 + c];
#pragma unroll
                    for (int j = 0; j < i2; ++j) sx -= As[(16 * rb + i2) * 64 + 16 * rb + j] * X[j];
                    X[i2] = sx; Xs[(16 * rb + i2) * 128 + c] = sx; } }
            __syncthreads();
        }
        { const int e = tid >> 3, g = tid & 7; float o[8];
#pragma unroll
          for (int k = 0; k < 8; ++k) o[k] = Xs[(8 * g + k) * 128 + e];
          *(uint4*)(o_ut + e * 64 + 8 * g) = pack8(o);
#pragma unroll
          for (int k = 0; k < 8; ++k) o[k] = Xs[e * 128 + 64 + 8 * g + k];
          *(uint4*)(o_w + e * 64 + 8 * g) = pack8(o); }
    }
    __syncthreads();
}
DI void decode_task(unsigned char* smem, const Params& p, int l, int n) {
    const int tid = opaque_tid(), wid = tid >> 6, lane = tid & 63;
    float* wl = (float*)smem + wid * 512;
    const float* zr = (const float*)(p.ws + WS_ZD) + (size_t)n * ZS;
    bf16_t* mixs = (bf16_t*)(p.ws + WS_MIXS) + (size_t)n * MIXW;
    const float pos = 16384.f;
    for (int wt = wid; wt < 19; wt += 8) {
        if (wt < 6) {
            const int h = wt; const int fi = lane & 31;
            float sn, cs; sincosf(pos * rope_inv_freq(fi), &sn, &cs);
            float q = zr[AQ + h * 64 + lane], k = zr[AK + h * 64 + lane]; const float v = zr[AV + h * 64 + lane];
            { const float r = rsqrtf(wave_sum(q * q) * (1.f / 64.f) + EPS); q = q * r * p.in[I_QNORM][l * HD + lane];
              const float pr = __shfl_xor(q, 32); q = (lane < 32) ? (q * cs - pr * sn) : (q * cs + pr * sn); q *= 0.125f; }
            { const float r = rsqrtf(wave_sum(k * k) * (1.f / 64.f) + EPS); k = k * r * p.in[I_KNORM][l * HD + lane];
              const float pr = __shfl_xor(k, 32); k = (lane < 32) ? (k * cs - pr * sn) : (k * cs + pr * sn); }
            p.out[O_SAK + (((size_t)(l * MD + n) * 2048 + 2047) * NH + h) * HD + lane] = k;
            p.out[O_SAV + (((size_t)(l * MD + n) * 2048 + 2047) * NH + h) * HD + lane] = v;
            wl[lane] = q;
            const float snew = wave_sum(q * k);
            const float* ck = p.in[I_CAK] + (size_t)(l * MD + n) * 2048 * GW + h * HD;
            const float* cv = p.in[I_CAV] + (size_t)(l * MD + n) * 2048 * GW + h * HD;
            float mx = snew;
#pragma unroll 1
            for (int it = 0; it < 7; ++it) { const int e = it * 64 + lane; float s = -1e30f;
                if (e < 387) { const int br = e / 129, j = e % 129; const int dil = br == 0 ? 1 : (br == 1 ? 4 : 16);
                    if (j == 0) s = snew; else { const float* kr = ck + (size_t)(2048 - dil * j) * GW; float a = 0.f;
#pragma unroll 4
                        for (int d4 = 0; d4 < 16; ++d4) { const float4 kv = *(const float4*)(kr + 4 * d4); a += kv.x * wl[4 * d4] + kv.y * wl[4 * d4 + 1] + kv.z * wl[4 * d4 + 2] + kv.w * wl[4 * d4 + 3]; }
                        s = a; } }
                wl[64 + e] = s; mx = fmaxf(mx, s); }
            mx = wave_max(mx); float sum = 0.f;
#pragma unroll 1
            for (int it = 0; it < 7; ++it) { const int e = it * 64 + lane; const float pe = (e < 387) ? __expf(wl[64 + e] - mx) : 0.f; sum += pe; wl[64 + e] = pe; }
            sum = wave_sum(sum);
            float o = 0.f;
            for (int br = 0; br < 3; ++br) { const int dil = br == 0 ? 1 : (br == 1 ? 4 : 16); o += wl[64 + br * 129] * v;
#pragma unroll 8
                for (int j = 1; j < 129; ++j) o += wl[64 + br * 129 + j] * cv[(size_t)(2048 - dil * j) * GW + lane]; }
            mixs[h * 64 + lane] = f2bf(o / sum);
        } else if (wt < 12) {
            const int h = wt - 6; float qkv[3];
            const float* sb = p.in[I_SBCONV] + (size_t)(l * MD + n) * 3 * 1152; const float* cwb = p.in[I_CONVB] + (size_t)l * 4 * 1152;
            float* sbo = p.out + O_SBCONV + (size_t)(l * MD + n) * 3 * 1152;
#pragma unroll
            for (int which = 0; which < 3; ++which) { const int c = which * GW + h * 64 + lane; const float xn = zr[BQ + c];
                const float s0 = sb[c], s1 = sb[1152 + c], s2 = sb[2 * 1152 + c];
                qkv[which] = silu_f(s0 * cwb[c] + s1 * cwb[1152 + c] + s2 * cwb[2 * 1152 + c] + xn * cwb[3 * 1152 + c]);
                sbo[c] = s1; sbo[1152 + c] = s2; sbo[2 * 1152 + c] = xn; }
            const float q = qkv[0] * rsqrtf(wave_sum(qkv[0] * qkv[0]) + EPS) * 0.125f, k = qkv[1] * rsqrtf(wave_sum(qkv[1] * qkv[1]) + EPS), v = qkv[2];
            const float beta = 1.f / (1.f + __expf(-zr[GB + h])); const float xx = zr[GA + h] + p.in[I_DTBIAS][l * NH + h];
            const float sp = xx > 20.f ? xx : log1pf(__expf(xx)); const float eg = __expf(-__expf(p.in[I_ALOG][l * NH + h]) * sp);
            const float* S0 = p.in[I_SBREC] + (size_t)((l * MD + n) * NH + h) * 4096; float* S1 = p.out + O_SBREC + (size_t)((l * MD + n) * NH + h) * 4096;
            float kS = 0.f;
#pragma unroll 8
            for (int d = 0; d < 64; ++d) kS += __shfl(k, d) * S0[d * 64 + lane];
            const float vn = beta * (v - eg * kS); float o = 0.f;
#pragma unroll 8
            for (int d = 0; d < 64; ++d) { const float sn = eg * S0[d * 64 + lane] + __shfl(k, d) * vn; S1[d * 64 + lane] = sn; o += __shfl(q, d) * sn; }
            const float r = rsqrtf(wave_sum(o * o) * (1.f / 64.f) + EPS);
            mixs[GW + h * 64 + lane] = f2bf(o * r * p.in[I_ONORMB][l * HD + lane] * silu_f(zr[BZ + h * 64 + lane]));
        } else if (wt < 18) {
            const int h = wt - 12; const int fi = lane & 31;
            float sn, cs; sincosf(pos * ret_inv_freq(fi), &sn, &cs);
            float q = zr[CQ + h * 64 + lane], k = zr[CK + h * 64 + lane]; const float v = zr[CV + h * 64 + lane];
            { const float pr = __shfl_xor(q, 32); q = (lane < 32) ? (q * cs - pr * sn) : (q * cs + pr * sn); }
            { const float pr = __shfl_xor(k, 32); k = (lane < 32) ? (k * cs - pr * sn) : (k * cs + pr * sn); k *= 0.125f; }
            const float gam = 1.f - exp2f(-5.f - (float)h);
            const float* S0 = p.in[I_SCREC] + (size_t)((l * MD + n) * NH + h) * 4096; float* S1 = p.out + O_SCREC + (size_t)((l * MD + n) * NH + h) * 4096;
            float o = 0.f;
#pragma unroll 8
            for (int d = 0; d < 64; ++d) { const float sv = gam * S0[d * 64 + lane] + __shfl(k, d) * v; S1[d * 64 + lane] = sv; o += __shfl(q, d) * sv; }
            const float r = rsqrtf(wave_sum(o * o) * (1.f / 64.f) + EPS);
            mixs[2 * GW + h * 64 + lane] = f2bf(o * r * p.in[I_ONORMC][l * HD + lane] * silu_f(zr[CG + h * 64 + lane]));
        } else {
            const float* sd = p.in[I_SDCONV] + (size_t)(l * MD + n) * 2 * GW; const float* cw = p.in[I_CONVD] + (size_t)l * 3 * GW;
            float* sdo = p.out + O_SDCONV + (size_t)(l * MD + n) * 2 * GW;
            for (int c = lane; c < GW; c += 64) { const float pr = zr[DC + c] * zr[DX + c]; const float s0 = sd[c], s1 = sd[GW + c];
                mixs[3 * GW + c] = f2bf(zr[DB + c] * (s0 * cw[c] + s1 * cw[GW + c] + pr * cw[2 * GW + c]));
                sdo[c] = s1; sdo[GW + c] = pr; }
        }
    }
}
DI bf16x8 packB(const f32x4& x0, const f32x4& x1) { return mk8(pack2(x0[0], x0[1]), pack2(x0[2], x0[3]), pack2(x1[0], x1[1]), pack2(x1[2], x1[3])); }
DI bf16x8 afrag(LAS unsigned char* lds, unsigned tilebase, int it, int ks, int col, int q) {
    const unsigned a = tilebase + (unsigned)(16 * it + col) * 144u + (unsigned)(32 * ks + 4 * q) * 2u;
    const u32x2 lo = *(const LAS u32x2*)(lds + a), hi = *(const LAS u32x2*)(lds + a + 32);
    return mk8(lo.x, lo.y, hi.x, hi.y);
}
DI void chain_phase(unsigned char* smem, const Params& p, int l, int nh) {
    LAS unsigned char* lds = (LAS unsigned char*)smem;
    const int tid = opaque_tid(), wid = tid >> 6, lane = tid & 63, col = lane & 15, q = lane >> 4, chain = wid >> 2, w = wid & 3;
    const int n = nh / NH, h = nh % NH;
    const unsigned char* bsrc = p.ws + WS_BBLK + (size_t)nh * 64 * 40960 + (size_t)tid * 16;
    const unsigned char* csrc = p.ws + WS_CBLK + (size_t)nh * 64 * 32768 + (size_t)tid * 16;
    const unsigned dst0 = (unsigned)(tid >> 3) * 144u + (unsigned)(tid & 7) * 16u;
    const unsigned TB = chain ? 46080u : 0u;
    const unsigned T_W = 0u, T_KDT = chain ? TB : 9216u, T_QG = T_KDT + 9216u, T_QK = T_QG + 9216u, T_UT = T_QK + 9216u;
    LAS float* ssx = (LAS float*)(lds + 82944);
    const float* dlb = (const float*)(p.ws + WS_DLB) + nh * 64;
    const float gam64 = __expf(64.f * __logf(1.f - exp2f(-5.f - (float)h)));
    const bf16_t* gate0 = (const bf16_t*)(p.ws + WS_R1) + (size_t)(n * T_) * ZS + (chain ? CG : BZ) + h * 64 + 16 * w + col;
    bf16_t* mix0 = (bf16_t*)(p.ws + WS_MIX) + (size_t)(n * T_) * MIXW + (chain ? 2 * GW : GW) + h * 64 + 16 * w + col;
    const float onw = p.in[chain ? I_ONORMC : I_ONORMB][l * HD + 16 * w + col];
    u32x4 regs[9];
#pragma unroll
    for (int k = 0; k < 5; ++k) regs[k] = *(const u32x4*)(bsrc + k * 8192);
#pragma unroll
    for (int k = 0; k < 4; ++k) regs[5 + k] = *(const u32x4*)(csrc + k * 8192);
#pragma unroll
    for (int k = 0; k < 9; ++k) *(LAS u32x4*)(lds + (k < 5 ? k * 9216 : 46080 + (k - 5) * 9216) + dst0) = regs[k];
    __syncthreads();
    f32x4 S[4];
#pragma unroll
    for (int i = 0; i < 4; ++i) S[i] = (f32x4){0.f, 0.f, 0.f, 0.f};
    for (int c = 0; c < 64; ++c) {
        if (c < 63) {
#pragma unroll
            for (int k = 0; k < 5; ++k) regs[k] = *(const u32x4*)(bsrc + (size_t)(c + 1) * 40960 + k * 8192);
#pragma unroll
            for (int k = 0; k < 4; ++k) regs[5 + k] = *(const u32x4*)(csrc + (size_t)(c + 1) * 32768 + k * 8192);
        }
        unsigned short gt[4][4];
#pragma unroll
        for (int it = 0; it < 4; ++it)
#pragma unroll
            for (int i = 0; i < 4; ++i) gt[it][i] = gate0[(size_t)(c * 64 + 16 * it + 4 * q + i) * ZS];
        const float dl = chain ? gam64 : dlb[c];
        bf16x8 Sb[2], Vb[2]; Sb[0] = packB(S[0], S[1]); Sb[1] = packB(S[2], S[3]);
        f32x4 vn[4], o[4];
#pragma unroll
        for (int it = 0; it < 4; ++it) {
            const u32x2 ur = *(const LAS u32x2*)(lds + T_UT + (unsigned)(16 * w + col) * 144u + (unsigned)(16 * it + 4 * q) * 2u);
            f32x4 u; u[0] = bflo(ur.x); u[1] = bfhi(ur.x); u[2] = bflo(ur.y); u[3] = bfhi(ur.y);
            if (chain == 0) { f32x4 a = (f32x4){0.f, 0.f, 0.f, 0.f};
#pragma unroll
                for (int ks = 0; ks < 2; ++ks) a = MFMA16(afrag(lds, T_W, it, ks, col, q), Sb[ks], a);
                u = u - a; }
            vn[it] = u; }
        Vb[0] = packB(vn[0], vn[1]); Vb[1] = packB(vn[2], vn[3]);
#pragma unroll
        for (int it = 0; it < 4; ++it) { f32x4 a = (f32x4){0.f, 0.f, 0.f, 0.f};
#pragma unroll
            for (int ks = 0; ks < 2; ++ks) a = MFMA16(afrag(lds, T_QG, it, ks, col, q), Sb[ks], a);
#pragma unroll
            for (int ks = 0; ks < 2; ++ks) a = MFMA16(afrag(lds, T_QK, it, ks, col, q), Vb[ks], a);
            o[it] = a; }
#pragma unroll
        for (int rt = 0; rt < 4; ++rt) { f32x4 a = S[rt] * dl;
#pragma unroll
            for (int ks = 0; ks < 2; ++ks) a = MFMA16(afrag(lds, T_KDT, rt, ks, col, q), Vb[ks], a);
            S[rt] = a; }
#pragma unroll
        for (int it = 0; it < 4; ++it)
#pragma unroll
            for (int i = 0; i < 4; ++i) { float s = o[it][i] * o[it][i]; s += __shfl_xor(s, 1); s += __shfl_xor(s, 2); s += __shfl_xor(s, 4); s += __shfl_xor(s, 8);
                if (col == 0) ssx[(chain * 4 + w) * 64 + 16 * it + 4 * q + i] = s; }
        __syncthreads();
#pragma unroll
        for (int it = 0; it < 4; ++it)
#pragma unroll
            for (int i = 0; i < 4; ++i) { const int tk = 16 * it + 4 * q + i;
                const float tot = ssx[(chain * 4 + 0) * 64 + tk] + ssx[(chain * 4 + 1) * 64 + tk] + ssx[(chain * 4 + 2) * 64 + tk] + ssx[(chain * 4 + 3) * 64 + tk];
                const float y = o[it][i] * rsqrtf(tot * (1.f / 64.f) + EPS) * onw * silu_f(bf2f(gt[it][i]));
                mix0[(size_t)(c * 64 + tk) * MIXW] = f2bf(y); }
        if (c < 63) {
#pragma unroll
            for (int k = 0; k < 9; ++k) *(LAS u32x4*)(lds + (k < 5 ? k * 9216 : 46080 + (k - 5) * 9216) + dst0) = regs[k];
        }
        __syncthreads();
    }
    float* so = p.out + (chain ? O_PCREC : O_PBREC) + (size_t)((l * NBAT + n) * NH + h) * 4096 + 16 * w + col;
#pragma unroll
    for (int rt = 0; rt < 4; ++rt)
#pragma unroll
        for (int i = 0; i < 4; ++i) so[(16 * rt + 4 * q + i) * 64] = S[rt][i];
}

DI void attn_task(const Params& p, int task) {
    const int nh = task >> 3, tile = task & 7, n = nh / NH, h = nh % NH, T0 = tile * 512;
    const int tid = opaque_tid(), wid = tid >> 6, lane = tid & 63, r = lane & 31, hh = lane >> 5;
    const bf16_t* qa = (const bf16_t*)(p.ws + WS_QA) + (size_t)nh * T_ * HD;
    const bf16_t* ka = (const bf16_t*)(p.ws + WS_KA) + (size_t)nh * T_ * HD;
    float* opart = (float*)(p.ws + WS_OPART); float* lse = (float*)(p.ws + WS_LSE);
    for (int u = wid; u < 48; u += 8) {
        const int br = u >> 4, within = u & 15;
        const int d = br == 0 ? 1 : (br == 1 ? 4 : 16), res = br == 0 ? 0 : (br == 1 ? (within >> 2) : within), qb = br == 0 ? within : (br == 1 ? (within & 3) : 0);
        const int L = T_ / d, Iq0 = T0 / d + 32 * qb;
        const int tq = (Iq0 + r) * d + res;
        bf16x8 Qf[4];
#pragma unroll
        for (int s = 0; s < 4; ++s) Qf[s] = *(const bf16x8*)(qa + (size_t)tq * HD + 16 * s + 8 * hh);
        f32x16 sacc[5];
#pragma unroll
        for (int kt = 0; kt < 5; ++kt) {
            const int kidx = Iq0 - 128 + 32 * kt + r; const bool ok = kidx >= 0; const size_t tk = ok ? (size_t)(kidx * d + res) : 0;
            f32x16 a; for (int i = 0; i < 16; ++i) a[i] = 0.f;
#pragma unroll
            for (int s = 0; s < 4; ++s) { bf16x8 kf = *(const bf16x8*)(ka + tk * HD + 16 * s + 8 * hh); if (!ok) kf = (bf16x8){0, 0, 0, 0, 0, 0, 0, 0}; a = MFMA32(kf, Qf[s], a); }
            sacc[kt] = a; }
        float m = -1e30f;
#pragma unroll
        for (int kt = 0; kt < 5; ++kt)
#pragma unroll
            for (int i = 0; i < 16; ++i) { const int kk = 32 * kt + crow(i, hh); const bool valid = (kk >= r) && (kk <= r + 128) && (Iq0 - 128 + kk >= 0);
                const float s = valid ? sacc[kt][i] : -1e30f; sacc[kt][i] = s; m = fmaxf(m, s); }
        m = fmaxf(m, __shfl_xor(m, 32));
        float lsum = 0.f;
#pragma unroll
        for (int kt = 0; kt < 5; ++kt)
#pragma unroll
            for (int i = 0; i < 16; ++i) { const float pe = __expf(sacc[kt][i] - m); sacc[kt][i] = pe; lsum += pe; }
        lsum += __shfl_xor(lsum, 32);
        const bf16_t* vt = (const bf16_t*)(p.ws + WS_VT) + (size_t)br * (SZ_HEADBUF / 2) + (size_t)nh * HD * T_ + (size_t)res * L;
        f32x16 oacc[2];
#pragma unroll
        for (int dt = 0; dt < 2; ++dt) for (int i = 0; i < 16; ++i) oacc[dt][i] = 0.f;
#pragma unroll
        for (int kt = 0; kt < 5; ++kt)
#pragma unroll
            for (int s = 0; s < 2; ++s) {
                const bf16x8 pf = mk8(pack2(sacc[kt][8 * s], sacc[kt][8 * s + 1]), pack2(sacc[kt][8 * s + 2], sacc[kt][8 * s + 3]), pack2(sacc[kt][8 * s + 4], sacc[kt][8 * s + 5]), pack2(sacc[kt][8 * s + 6], sacc[kt][8 * s + 7]));
                const int idx0 = Iq0 - 128 + 32 * kt + 16 * s + 4 * hh;
#pragma unroll
                for (int dt = 0; dt < 2; ++dt) { const bf16_t* vp = vt + (size_t)(32 * dt + r) * T_;
                    uint2 lo = make_uint2(0u, 0u), hi = make_uint2(0u, 0u);
                    if (idx0 >= 0) lo = *(const uint2*)(vp + idx0);
                    if (idx0 + 8 >= 0) hi = *(const uint2*)(vp + idx0 + 8);
                    oacc[dt] = MFMA32(mk8(lo.x, lo.y, hi.x, hi.y), pf, oacc[dt]); } }
        const float inv = 1.f / lsum;
        float* op = opart + ((size_t)(br * 24 + nh) * T_ + tq) * HD;
#pragma unroll
        for (int dt = 0; dt < 2; ++dt)
#pragma unroll
            for (int g = 0; g < 4; ++g) *(float4*)(op + 32 * dt + 8 * g + 4 * hh) = make_float4(oacc[dt][4 * g] * inv, oacc[dt][4 * g + 1] * inv, oacc[dt][4 * g + 2] * inv, oacc[dt][4 * g + 3] * inv);
        if (hh == 0) lse[(size_t)(br * 24 + nh) * T_ + tq] = m + __logf(lsum);
    }
    __syncthreads();
    for (int it = 0; it < 8; ++it) { const int item = it * 512 + tid, t = T0 + (item >> 3), seg = item & 7;
        const float l0 = lse[(size_t)(0 * 24 + nh) * T_ + t], l1 = lse[(size_t)(1 * 24 + nh) * T_ + t], l2 = lse[(size_t)(2 * 24 + nh) * T_ + t];
        const float mx = fmaxf(l0, fmaxf(l1, l2)); float w0 = __expf(l0 - mx), w1 = __expf(l1 - mx), w2 = __expf(l2 - mx); const float iv = 1.f / (w0 + w1 + w2); w0 *= iv; w1 *= iv; w2 *= iv;
        float acc[8];
#pragma unroll
        for (int e = 0; e < 8; ++e) acc[e] = 0.f;
#pragma unroll
        for (int g = 0; g < 3; ++g) { const float wg = g == 0 ? w0 : (g == 1 ? w1 : w2); const float* op = opart + ((size_t)(g * 24 + nh) * T_ + t) * HD + 8 * seg;
            const float4 a = *(const float4*)op, b = *(const float4*)(op + 4);
            acc[0] += wg * a.x; acc[1] += wg * a.y; acc[2] += wg * a.z; acc[3] += wg * a.w; acc[4] += wg * b.x; acc[5] += wg * b.y; acc[6] += wg * b.z; acc[7] += wg * b.w; }
        *(uint4*)((bf16_t*)(p.ws + WS_MIX) + (size_t)(n * T_ + t) * MIXW + h * 64 + 8 * seg) = pack8(acc); }
    __syncthreads();
}
DI float rs_from_slots32(const float* p) { float s = 0.f;
#pragma unroll
    for (int i = 0; i < 32; ++i) s += p[i];
    return rsqrtf(s * (1.f / DM) + EPS); }

__global__ void __launch_bounds__(512, 2) mega_fwd(Params p) {
    extern __shared__ __attribute__((aligned(16))) unsigned char smem[];
    cg::grid_group grid = cg::this_grid();
    const int G = gridDim.x, b = blockIdx.x, tid = threadIdx.x;
    PG8_LAS unsigned char* glds = (PG8_LAS unsigned char*)smem;
    unsigned char* ws = p.ws;
    static_assert(sizeof(Params) <= 256, "tab");
    if (tid == 0) *(Params*)(p.ws + WS_TAB) = p;
#ifndef NO_P0
    phase0(smem, p);
#endif
    grid.sync();
#pragma unroll 1
    for (int l = 0; l < 2; ++l) {
        const Params& p = *(const Params*)(ws + WS_TAB);
        float* rowss = (float*)(ws + WS_ROWSS); float* rowssS = (float*)(ws + WS_ROWSS_S);
        { float* zd = (float*)(ws + WS_ZD); const float* rsS = rowssS + (size_t)(2 * l) * 32 * 32;
#ifndef NO_SKINNY
          skinny(smem, (const bf16_t*)(ws + WS_XSB), (const bf16_t*)(ws + WS_WT_IN + l * SZ_WT_IN), ZS / 32, DM, G - 1 - b, G,
                 [&](int row, int col, float v, int) { zd[(size_t)row * ZS + col] = v * rs_from_slots32(rsS + row * 32); });
#endif
          pg8::Gemm g{(const bf16_t*)(ws + WS_XB), (const bf16_t*)(ws + WS_WT_IN + l * SZ_WT_IN), MP, ZS, DM}; pg8::StaticOrder S; S.init(MP, ZS, G, b);
          EpiZ<0> E{(bf16_t*)(ws + WS_R1), ZS, rowss + (size_t)(2 * l) * MP * 16};
#if !defined(NO_GEMM) && !defined(NO_G1)
          pg8::gemm_phase<EpiZ<0>, pg8::StaticOrder, false>(glds, g, S, E, nullptr);
#endif
          }
        grid.sync();
        for (int task = b; task < 1536 * 3 + 256 + 32; task += G) {
            if (task < 1536) {
#ifndef NO_BPREP
                chunk_prep<true>(smem, p, l, task);
#endif
            } else if (task < 3072) {
#ifndef NO_CPREP
                chunk_prep<false>(smem, p, l, task - 1536);
#endif
            } else if (task < 4608) {
#ifndef NO_APREP
                aprep_task(smem, p, l, task - 3072);
#endif
            } else if (task < 4864) {
#ifndef NO_DMIX
                dmix_task(p, l, task - 4608);
#endif
            } else {
#ifndef NO_DEC
                decode_task(smem, p, l, task - 4864); __syncthreads();
#endif
            }
        }
        grid.sync();
        { const int nchain = 24;
          if (b < nchain) {
#ifndef NO_CHAIN
              chain_phase(smem, p, l, b);
#endif
          } else for (int task = b - nchain; task < 192; task += G - nchain) {
#ifndef NO_ATTN
              attn_task(p, task);
#endif
          } }
        grid.sync();
        { const float* xsf = l == 0 ? p.in[I_XS] : (const float*)(ws + WS_XSF); float* hsf = (float*)(ws + WS_HSF); bf16_t* hsb = (bf16_t*)(ws + WS_HSB);
          float* ssS = rowssS + (size_t)(2 * l + 1) * 32 * 32;
#ifndef NO_SKINNY
          skinny(smem, (const bf16_t*)(ws + WS_MIXS), (const bf16_t*)(ws + WS_WT_OUT + l * SZ_WT_OUT), DM / 32, MIXW, G - 1 - b, G,
                 [&](int row, int col, float v, int tile) { const float y = v + xsf[row * DM + col]; hsf[row * DM + col] = y; hsb[row * DM + col] = f2bf(y);
                     float s = y * y; s += __shfl_xor(s, 1); s += __shfl_xor(s, 2); s += __shfl_xor(s, 4); s += __shfl_xor(s, 8); s += __shfl_xor(s, 16);
                     if ((col & 31) == 0) ssS[row * 32 + tile] = s; });
#endif
          pg8::Gemm g{(const bf16_t*)(ws + WS_MIX), (const bf16_t*)(ws + WS_WT_OUT + l * SZ_WT_OUT), MP, DM, MIXW}; pg8::StaticOrder S; S.init(MP, DM, G, b);
          EpiRes E{l == 0 ? p.in[I_XP] : (const float*)(ws + WS_XF), (float*)(ws + WS_HF), (bf16_t*)(ws + WS_HB), rowss + (size_t)(2 * l + 1) * MP * 16};
#if !defined(NO_GEMM) && !defined(NO_G2)
          pg8::gemm_phase<EpiRes, pg8::StaticOrder, false>(glds, g, S, E, nullptr);
#endif
          }
        grid.sync();
        { bf16_t* us = (bf16_t*)(ws + WS_US); const float* rsS = rowssS + (size_t)(2 * l + 1) * 32 * 32;
#ifndef NO_SKINNY
          skinny(smem, (const bf16_t*)(ws + WS_HSB), (const bf16_t*)(ws + WS_WT_UP + l * SZ_WT_UP), DFF / 32, DM, G - 1 - b, G,
                 [&](int row, int col, float v, int) { const float y = fmaxf(v * rs_from_slots32(rsS + row * 32), 0.f); us[(size_t)row * DFF + col] = f2bf(y * y); });
#endif
          pg8::Gemm g{(const bf16_t*)(ws + WS_HB), (const bf16_t*)(ws + WS_WT_UP + l * SZ_WT_UP), MP, DFF, DM}; pg8::StaticOrder S; S.init(MP, DFF, G, b);
          EpiZ<1> E{(bf16_t*)(ws + WS_R1), DFF, rowss + (size_t)(2 * l + 1) * MP * 16};
#if !defined(NO_GEMM) && !defined(NO_G3)
          pg8::gemm_phase<EpiZ<1>, pg8::StaticOrder, false>(glds, g, S, E, nullptr);
#endif
          }
        grid.sync();
        { const float* hsf = (const float*)(ws + WS_HSF); float* xo = l == 0 ? (float*)(ws + WS_XSF) : p.out + O_YS; bf16_t* xsb = (bf16_t*)(ws + WS_XSB);
          float* ssS = rowssS + (size_t)(2 * l + 2) * 32 * 32;
#ifndef NO_SKINNY
          skinny(smem, (const bf16_t*)(ws + WS_US), (const bf16_t*)(ws + WS_WT_DOWN + l * SZ_WT_DOWN), DM / 32, DFF, G - 1 - b, G,
                 [&](int row, int col, float v, int tile) { const float y = v + hsf[row * DM + col]; xo[row * DM + col] = y; xsb[row * DM + col] = f2bf(y);
                     float s = y * y; s += __shfl_xor(s, 1); s += __shfl_xor(s, 2); s += __shfl_xor(s, 4); s += __shfl_xor(s, 8); s += __shfl_xor(s, 16);
                     if ((col & 31) == 0) ssS[row * 32 + tile] = s; });
#endif
          pg8::Gemm g{(const bf16_t*)(ws + WS_R1), (const bf16_t*)(ws + WS_WT_DOWN + l * SZ_WT_DOWN), MP, DM, DFF}; pg8::StaticOrder S; S.init(MP, DM, G, b);
          EpiRes E{(const float*)(ws + WS_HF), l == 0 ? (float*)(ws + WS_XF) : p.out + O_YP, (bf16_t*)(ws + WS_XB), rowss + (size_t)(2 * l + 2) * MP * 16};
#if !defined(NO_GEMM) && !defined(NO_G4)
          pg8::gemm_phase<EpiRes, pg8::StaticOrder, false>(glds, g, S, E, nullptr);
#endif
          }
        if (l == 0) grid.sync();
    }
}

extern "C" void kernel_launch(void* const* d_in, const int* in_sizes, int n_in, void* d_out, int out_size, void* d_ws, size_t ws_size, hipStream_t stream) {
    static int grid = 0;
    if (grid == 0) {
        if (n_in != 22 || (size_t)out_size != O_END || ws_size < WS_END) { fprintf(stderr, "kernel_launch: unexpected shapes: n_in %d out %d (want %zu) ws %zu (want %zu)\n", n_in, out_size, (size_t)O_END, ws_size, (size_t)WS_END); grid = -1; return; }
        int dev = 0, cus = 0, per_cu = 0;
        hipGetDevice(&dev); hipDeviceGetAttribute(&cus, hipDeviceAttributeMultiprocessorCount, dev);
        if (hipFuncSetAttribute((const void*)mega_fwd, hipFuncAttributeMaxDynamicSharedMemorySize, LDS_BYTES) != hipSuccess) { fprintf(stderr, "kernel_launch: hipFuncSetAttribute failed\n"); grid = -1; return; }
        if (hipOccupancyMaxActiveBlocksPerMultiprocessor(&per_cu, (const void*)mega_fwd, 512, LDS_BYTES) != hipSuccess || per_cu < 1) { fprintf(stderr, "kernel_launch: occupancy query says %d\n", per_cu); per_cu = 1; }
        (void)hipGetLastError();
        grid = cus;
    }
    if (grid < 0) return;
    Params p{};
    for (int i = 0; i < 22; ++i) p.in[i] = (const float*)d_in[i];
    p.out = (float*)d_out; p.ws = (unsigned char*)d_ws;
    void* args[] = {&p};
    hipError_t e = hipLaunchCooperativeKernel((const void*)mega_fwd, dim3(grid), dim3(512), args, LDS_BYTES, stream);
    if (e != hipSuccess) fprintf(stderr, "cooperative launch failed: %s (grid %d)\n", hipGetErrorString(e), grid);
}
```

```cpp
#include <hip/hip_runtime.h>
#include <hip/hip_cooperative_groups.h>
#include <cstdio>
namespace cg = cooperative_groups;
namespace pg8 {
#define PG8_LAS __attribute__((address_space(3)))
typedef unsigned short bf16_t;
typedef short bf16x8 __attribute__((ext_vector_type(8)));
typedef float f32x4 __attribute__((ext_vector_type(4)));
typedef unsigned u32x4 __attribute__((ext_vector_type(4)));
constexpr int BM = 256, BK = 64, HALF = 128, HTB = HALF * BK * 2  , STAGE_BYTES = 8 * HTB, NXCD = 8, WGM = 8;

__host__ __device__ __forceinline__ int lds_byte(int r, int c) { const int st = (r >> 4) * 2 + (c >> 5), rr = r & 15, cc = c & 31, ob = rr * 64 + cc * 2; return st * 1024 + (ob ^ (((ob >> 9) & 1) << 5)); }
__host__ __device__ __forceinline__ void stage_rc(int b, int& R, int& C) { const int st = b / 1024, sb = b % 1024, swz = sb ^ (((sb >> 9) & 1) << 5); R = (st >> 1) * 16 + swz / 64; C = (st & 1) * 32 + (swz % 64) / 2; }
__host__ __device__ __forceinline__ int perm32(int rho) { const int n = rho >> 4, i = rho & 15; return 8 * (i >> 2) + 4 * n + (i & 3); }

struct Unit { int pm, pn; };
struct Gemm { const bf16_t* A; const bf16_t* Bt; int M, N, K; };

struct StaticOrder {
    int nM, nN, nwg, G, c;
    __host__ __device__ void init(int M, int N, int G_, int c_) { nM = M / BM; nN = N / BM; nwg = nM * nN; G = G_; c = c_; }
    __host__ __device__ bool next(int i, Unit& u) const {
        const long L = (long)i * G + c; if (L >= nwg) return false;
        int wgid = (int)L; { const int q = nwg / NXCD, r = nwg % NXCD, xcd = wgid % NXCD, off = wgid / NXCD; wgid = (xcd < r ? xcd * (q + 1) : r * (q + 1) + (xcd - r) * q) + off; }
        const int nig = WGM * nN, gid = wgid / nig, fm = gid * WGM, gsz = (nM - fm) < WGM ? (nM - fm) : WGM;
        u.pm = fm + ((wgid % nig) % gsz); u.pn = (wgid % nig) / gsz; return true;
    }
    __device__ __forceinline__ void a_ready(const Unit&) const {}
    __device__ __forceinline__ void done(const Unit&) const {}
};
__device__ __forceinline__ unsigned cvt_pk_bf16(float lo, float hi) { unsigned r; asm volatile("v_cvt_pk_bf16_f32 %0, %1, %2" : "=v"(r) : "v"(lo), "v"(hi)); return r; }
template <class Epi, class Sched, bool STAMP = false>
__device__ __forceinline__ void gemm_phase(PG8_LAS unsigned char* lds, const Gemm g, const Sched& S, const Epi& E, unsigned long long* stamps) {
    int tid_ = threadIdx.x; asm volatile("" : "+v"(tid_));
    const int tid = tid_, wid = __builtin_amdgcn_readfirstlane(tid >> 6), lane = tid & 63, wr = wid >> 2, wc = wid & 3, fr = lane & 15, fq = lane >> 4;
    const int K = g.K, nt = K / BK;
    int ts_lo = 0, ts_hi = 0, nts = 0; const unsigned long long rt_entry = STAMP ? (unsigned long long)wall_clock64() : 0ull;
#define PG8_STAMP() do { if (STAMP && wid == 0 && nts < 64) { const unsigned long long _c = (unsigned long long)clock64(); \
        ts_lo = (lane == nts) ? (int)(unsigned)_c : ts_lo; ts_hi = (lane == nts) ? (int)(unsigned)(_c >> 32) : ts_hi; ++nts; } } while (0)
    PG8_STAMP();
    unsigned voffA[2], voffB[2];
#pragma unroll
    for (int i = 0; i < 2; ++i) { int R, C; stage_rc(tid * 16 + i * 8192, R, C); const int Rb = Epi::PERM ? ((R & ~31) + perm32(R & 31)) : R;
        voffA[i] = (unsigned)(R * K + C) * 2u; voffB[i] = (unsigned)(Rb * K + C) * 2u; }
    const size_t kstep = (size_t)(BK * 2);
    const size_t hstep = (size_t)HALF * K * 2;
    const size_t tstep = 2 * hstep;
    const unsigned ldsw = (unsigned)wid * 1024u;
    const int aoff = lds_byte(wr * 64 + fr, fq * 8), boff = lds_byte(wc * 32 + fr, fq * 8);
#define PG8_SA(b, h) (((b) * 2 + (h)) * HTB)
#define PG8_SB(b, h) ((4 + (b) * 2 + (h)) * HTB)
#define PG8_STAGE(bufoff, gbase, voff) do { _Pragma("unroll") for (int _i = 0; _i < 2; ++_i) \
        __builtin_amdgcn_global_load_lds((const unsigned*)((const char*)(gbase) + (voff)[_i]), (PG8_LAS unsigned*)(lds + (bufoff) + ldsw + _i * 8192), 16, 0, 0); } while (0)
#define PG8_LDA(dst, b, h) do { _Pragma("unroll") for (int m = 0; m < 4; ++m) _Pragma("unroll") for (int k = 0; k < 2; ++k) dst[m][k] = *(const PG8_LAS bf16x8*)(lds + PG8_SA(b, h) + aoff + m * 2048 + k * 1024); } while (0)
#define PG8_LDB(dst, b, h) do { _Pragma("unroll") for (int n = 0; n < 2; ++n) _Pragma("unroll") for (int k = 0; k < 2; ++k) dst[n][k] = *(const PG8_LAS bf16x8*)(lds + PG8_SB(b, h) + boff + n * 2048 + k * 1024); } while (0)
#define PG8_MMA(ai, bj, At, Bt) do { __builtin_amdgcn_s_setprio(1); _Pragma("unroll") for (int m = 0; m < 4; ++m) _Pragma("unroll") for (int n = 0; n < 2; ++n) _Pragma("unroll") for (int k = 0; k < 2; ++k) \
        acc[ai][bj][m][n] = __builtin_amdgcn_mfma_f32_16x16x32_bf16(Bt[n][k], At[m][k], acc[ai][bj][m][n], 0, 0, 0); __builtin_amdgcn_s_setprio(0); } while (0)
#define PG8_WAIT_V(n) asm volatile("s_waitcnt vmcnt(" #n ")" ::: "memory")
#define PG8_WAIT_L(n) asm volatile("s_waitcnt lgkmcnt(" #n ")" ::: "memory")
#define PG8_BAR __builtin_amdgcn_s_barrier()
#define PG8_SCHED __builtin_amdgcn_sched_barrier(0)
    Unit cur, nxt; int ui = 0;
    if (!S.next(0, cur)) return;
    f32x4 acc[2][2][4][2];
#pragma unroll
    for (int a = 0; a < 2; ++a)
#pragma unroll
        for (int b = 0; b < 2; ++b)
#pragma unroll
            for (int m = 0; m < 4; ++m)
#pragma unroll
                for (int n = 0; n < 2; ++n) acc[a][b][m][n] = (f32x4){0.f, 0.f, 0.f, 0.f};
    bf16x8 At[4][2], B0[2][2], B1[2][2];
    const char* cA = (const char*)g.A + (size_t)cur.pm * tstep; const char* cB = (const char*)g.Bt + (size_t)cur.pn * tstep;
    S.a_ready(cur);
    PG8_STAGE(PG8_SB(0, 0), cB, voffB); PG8_STAGE(PG8_SA(0, 0), cA, voffA); PG8_STAGE(PG8_SB(0, 1), cB + hstep, voffB); PG8_STAGE(PG8_SA(0, 1), cA + hstep, voffA);
    if (wr == 1) PG8_BAR;
    PG8_WAIT_V(4); PG8_BAR;
    PG8_STAGE(PG8_SB(1, 0), cB + kstep, voffB); PG8_STAGE(PG8_SA(1, 0), cA + kstep, voffA); PG8_STAGE(PG8_SB(1, 1), cB + hstep + kstep, voffB);
    PG8_WAIT_V(6); PG8_BAR;
    PG8_STAMP();
    for (;;) {
        const bool has_next = S.next(ui + 1, nxt);
        const char* nA = has_next ? (const char*)g.A + (size_t)nxt.pm * tstep : cA; const char* nB = has_next ? (const char*)g.Bt + (size_t)nxt.pn * tstep : cB;
        for (int t = 0; t < nt; t += 2) {
            const bool last = (t == nt - 2);
            const char* a1 = cA + (size_t)(t + 1) * kstep;
            const char* a2 = last ? nA : cA + (size_t)(t + 2) * kstep; const char* b2 = last ? nB : cB + (size_t)(t + 2) * kstep;
            const char* a3 = a2 + kstep; const char* b3 = b2 + kstep;
            if (last && has_next) S.a_ready(nxt);
            PG8_LDB(B0, 0, 0); PG8_SCHED; PG8_LDA(At, 0, 0); PG8_STAGE(PG8_SA(1, 1), a1 + hstep, voffA);
            PG8_WAIT_L(8); PG8_BAR; PG8_WAIT_L(0); PG8_MMA(0, 0, At, B0); PG8_BAR; PG8_SCHED;
            PG8_LDB(B1, 0, 1); PG8_STAGE(PG8_SB(0, 0), b2, voffB);
            PG8_BAR; PG8_WAIT_L(0); PG8_MMA(0, 1, At, B1); PG8_BAR;
            PG8_LDA(At, 0, 1); PG8_STAGE(PG8_SA(0, 0), a2, voffA);
            PG8_BAR; PG8_WAIT_L(0); PG8_MMA(1, 0, At, B0); PG8_BAR; PG8_SCHED;
            PG8_STAGE(PG8_SB(0, 1), b2 + hstep, voffB);
            PG8_WAIT_V(6); PG8_BAR; PG8_MMA(1, 1, At, B1); PG8_BAR;
            PG8_LDB(B0, 1, 0); PG8_SCHED; PG8_LDA(At, 1, 0); PG8_STAGE(PG8_SA(0, 1), a2 + hstep, voffA);
            PG8_WAIT_L(8); PG8_BAR; PG8_WAIT_L(0); PG8_MMA(0, 0, At, B0); PG8_BAR; PG8_SCHED;
            PG8_LDB(B1, 1, 1); PG8_STAGE(PG8_SB(1, 0), b3, voffB);
            PG8_BAR; PG8_WAIT_L(0); PG8_MMA(0, 1, At, B1); PG8_BAR;
            PG8_LDA(At, 1, 1); PG8_STAGE(PG8_SA(1, 0), a3, voffA);
            PG8_BAR; PG8_WAIT_L(0); PG8_MMA(1, 0, At, B0); PG8_BAR; PG8_SCHED;
            PG8_STAGE(PG8_SB(1, 1), b3 + hstep, voffB);
            PG8_WAIT_V(6); PG8_BAR; PG8_MMA(1, 1, At, B1); PG8_BAR;
        }
        PG8_STAMP();
        if constexpr (!Epi::AFTER_DRAIN) { E(acc, cur, wr, wc, fr, fq); S.done(cur); }
        PG8_STAMP();
        if (!has_next) break;
#pragma unroll
        for (int a = 0; a < 2; ++a)
#pragma unroll
            for (int b = 0; b < 2; ++b)
#pragma unroll
                for (int m = 0; m < 4; ++m)
#pragma unroll
                    for (int n = 0; n < 2; ++n) acc[a][b][m][n] = (f32x4){0.f, 0.f, 0.f, 0.f};
        cur = nxt; cA = nA; cB = nB; ++ui;
    }
    PG8_WAIT_V(0);
    if (wr == 0) PG8_BAR;
    PG8_BAR;
    if constexpr (Epi::AFTER_DRAIN) { E.fused(acc, cur, wr, wc, fr, fq, lds, wid, lane); S.done(cur); }
    PG8_STAMP();
    if (STAMP && wid == 0) { stamps[lane] = lane < nts ? (((unsigned long long)(unsigned)ts_hi << 32) | (unsigned)ts_lo) : 0ull;
        if (lane == 62) stamps[62] = rt_entry; if (lane == 63) stamps[63] = (unsigned long long)wall_clock64(); }
#undef PG8_STAMP
#undef PG8_SA
#undef PG8_SB
#undef PG8_STAGE
#undef PG8_LDA
#undef PG8_LDB
#undef PG8_MMA
#undef PG8_WAIT_V
#undef PG8_WAIT_L
#undef PG8_BAR
#undef PG8_SCHED
}
}
using pg8::bf16_t; using pg8::bf16x8; using pg8::f32x4; using pg8::u32x4;
typedef float f32x16 __attribute__((ext_vector_type(16)));
typedef unsigned u32x2 __attribute__((ext_vector_type(2)));
#define LAS __attribute__((address_space(3)))
#define DI __device__ __forceinline__

constexpr int T_ = 4096, NBAT = 4, MP = NBAT * T_, MD = 32, DM = 1024, NH = 6, HD = 64, GW = 384, MIXW = 1536, DFF = 4096, ZS = 5632, NIN = 5388;
constexpr int AQ = 0, AK = 384, AV = 768, BQ = 1152, BKo = 1536, BV = 1920, BZ = 2304, CQ = 2688, CK = 3072, CV = 3456, CG = 3840, DX = 4224, DC = 4608, DB = 4992, GA = 5376, GB = 5382;
constexpr float EPS = 1e-6f;
constexpr int LDS_BYTES = 147456;

constexpr size_t al256(size_t x) { return (x + 255) & ~(size_t)255; }
constexpr size_t SZ_WT_IN = (size_t)ZS * DM * 2, SZ_WT_OUT = (size_t)DM * MIXW * 2, SZ_WT_UP = (size_t)DFF * DM * 2, SZ_WT_DOWN = (size_t)DM * DFF * 2;
constexpr size_t WS_WT_IN = 0;
constexpr size_t WS_WT_OUT = WS_WT_IN + 2 * SZ_WT_IN;
constexpr size_t WS_WT_UP = WS_WT_OUT + 2 * SZ_WT_OUT;
constexpr size_t WS_WT_DOWN = WS_WT_UP + 2 * SZ_WT_UP;
constexpr size_t WS_XB = WS_WT_DOWN + 2 * SZ_WT_DOWN;
constexpr size_t WS_R1 = WS_XB + (size_t)MP * DM * 2;
constexpr size_t SZ_HEADBUF = (size_t)NBAT * NH * T_ * HD * 2;
constexpr size_t WS_QA = WS_R1 + (size_t)MP * ZS * 2;
constexpr size_t WS_KA = WS_QA + SZ_HEADBUF;
constexpr size_t WS_VT = WS_KA + SZ_HEADBUF;
constexpr size_t SZ_BBLK = (size_t)NBAT * NH * 64 * 40960, SZ_CBLK = (size_t)NBAT * NH * 64 * 32768;
constexpr size_t WS_R2 = WS_VT + 3 * SZ_HEADBUF;
constexpr size_t WS_BBLK = WS_R2, WS_CBLK = WS_R2 + SZ_BBLK;
constexpr size_t WS_HF = WS_R2, WS_HB = WS_R2 + (size_t)MP * DM * 4;
static_assert((size_t)MP * DM * 6 <= SZ_BBLK + SZ_CBLK, "alias");
constexpr size_t WS_OPART = WS_R2 + SZ_BBLK + SZ_CBLK;
constexpr size_t WS_LSE = WS_OPART + (size_t)3 * 24 * T_ * 64 * 4;
constexpr size_t WS_MIX = WS_LSE + (size_t)3 * 24 * T_ * 4;
constexpr size_t WS_XF = WS_MIX + (size_t)MP * MIXW * 2;
constexpr size_t WS_ROWSS = WS_XF + (size_t)MP * DM * 4;
constexpr size_t WS_DLB = WS_ROWSS + (size_t)5 * MP * 16 * 4;
constexpr size_t WS_XSB = al256(WS_DLB + 24 * 64 * 4);
constexpr size_t WS_XSF = WS_XSB + (size_t)MD * DM * 2;
constexpr size_t WS_ZD = WS_XSF + (size_t)MD * DM * 4;
constexpr size_t WS_MIXS = WS_ZD + (size_t)MD * ZS * 4;
constexpr size_t WS_HSF = WS_MIXS + (size_t)MD * MIXW * 2;
constexpr size_t WS_HSB = WS_HSF + (size_t)MD * DM * 4;
constexpr size_t WS_US = WS_HSB + (size_t)MD * DM * 2;
constexpr size_t WS_ROWSS_S = WS_US + (size_t)MD * DFF * 2;
constexpr size_t WS_TAB = al256(WS_ROWSS_S + (size_t)5 * 32 * 32 * 4);
constexpr size_t WS_STB = WS_TAB + 256;
constexpr size_t WS_STC = WS_STB + (size_t)24 * 64 * 8192;
constexpr size_t WS_VNB = WS_STC + (size_t)24 * 64 * 8192;
constexpr size_t WS_TRIG = WS_VNB + (size_t)24 * 64 * 8192;
constexpr size_t WS_BAR = WS_TRIG + (size_t)2 * T_ * 32 * 8;
constexpr size_t WS_END = WS_BAR + 16384;

constexpr size_t O_YP = 0;
constexpr size_t O_YS = O_YP + (size_t)MP * DM;
constexpr size_t O_PAK = O_YS + (size_t)MD * DM;
constexpr size_t O_PAV = O_PAK + (size_t)2 * NBAT * 2048 * GW;
constexpr size_t O_PBCONV = O_PAV + (size_t)2 * NBAT * 2048 * GW;
constexpr size_t O_PBREC = O_PBCONV + (size_t)2 * NBAT * 3 * 1152;
constexpr size_t O_PCREC = O_PBREC + (size_t)2 * NBAT * NH * 4096;
constexpr size_t O_PDCONV = O_PCREC + (size_t)2 * NBAT * NH * 4096;
constexpr size_t O_SAK = O_PDCONV + (size_t)2 * NBAT * 2 * GW;
constexpr size_t O_SAV = O_SAK + (size_t)2 * MD * 2048 * GW;
constexpr size_t O_SBCONV = O_SAV + (size_t)2 * MD * 2048 * GW;
constexpr size_t O_SBREC = O_SBCONV + (size_t)2 * MD * 3 * 1152;
constexpr size_t O_SCREC = O_SBREC + (size_t)2 * MD * NH * 4096;
constexpr size_t O_SDCONV = O_SCREC + (size_t)2 * MD * NH * 4096;
constexpr size_t O_END = O_SDCONV + (size_t)2 * MD * 2 * GW;

struct Params { const float* in[22]; float* out; unsigned char* ws; };
template <class T> DI T* as_global(T* q) { return (T*)(__attribute__((address_space(1))) T*)q; }
struct InProxy { const unsigned char* ws; DI const float* operator[](int i) const; };
struct PView { InProxy in; float* out; unsigned char* ws; };
typedef const float __attribute__((address_space(1)))* gcfptr;
DI const float* InProxy::operator[](int i) const { return (const float*)(((const gcfptr*)(ws + WS_TAB))[i]); }
enum { I_XP = 0, I_XS, I_CAK, I_CAV, I_SBCONV, I_SBREC, I_SCREC, I_SDCONV, I_NORM_MIX, I_W_IN, I_QNORM, I_KNORM, I_CONVB, I_ALOG, I_DTBIAS, I_ONORMB, I_ONORMC, I_CONVD, I_W_OUT, I_NORM_FFN, I_W_UP, I_W_DOWN };

DI int opaque_tid() { int t = threadIdx.x; asm volatile("" : "+v"(t)); return t; }
typedef float f32x2v __attribute__((ext_vector_type(2)));
typedef __bf16 bf16x2v __attribute__((ext_vector_type(2)));
DI unsigned short f2bf(float x) { return __builtin_bit_cast(unsigned short, (__bf16)x); }
DI float bf2f(unsigned short b) { return __uint_as_float(((unsigned)b) << 16); }
DI unsigned pack2(float lo, float hi) { f32x2v v; v.x = lo; v.y = hi; return __builtin_bit_cast(unsigned, __builtin_convertvector(v, bf16x2v)); }
DI float bflo(unsigned w) { return __uint_as_float(w << 16); }
DI float bfhi(unsigned w) { return __uint_as_float(w & 0xffff0000u); }
DI void unpack8(const uint4& v, float* f) { f[0] = bflo(v.x); f[1] = bfhi(v.x); f[2] = bflo(v.y); f[3] = bfhi(v.y); f[4] = bflo(v.z); f[5] = bfhi(v.z); f[6] = bflo(v.w); f[7] = bfhi(v.w); }
DI uint4 pack8(const float* f) { uint4 v; v.x = pack2(f[0], f[1]); v.y = pack2(f[2], f[3]); v.z = pack2(f[4], f[5]); v.w = pack2(f[6], f[7]); return v; }
DI float silu_f(float x) { return x / (1.f + __expf(-x)); }
DI float wave_sum(float v) { for (int m = 32; m >= 1; m >>= 1) v += __shfl_xor(v, m); return v; }
DI float wave_max(float v) { for (int m = 32; m >= 1; m >>= 1) v = fmaxf(v, __shfl_xor(v, m)); return v; }
DI int crow(int reg, int h) { return (reg & 3) + 8 * (reg >> 2) + 4 * h; }
#define MFMA32(a, b, c) __builtin_amdgcn_mfma_f32_32x32x16_bf16((a), (b), (c), 0, 0, 0)
#define MFMA16(a, b, c) __builtin_amdgcn_mfma_f32_16x16x32_bf16((a), (b), (c), 0, 0, 0)
DI bf16x8 mk8(unsigned a, unsigned b, unsigned c, unsigned d) { u32x4 v; v.x = a; v.y = b; v.z = c; v.w = d; return __builtin_bit_cast(bf16x8, v); }
DI float rs_from_slots16(const float* p) { const float4 a = *(const float4*)p, b = *(const float4*)(p + 4), c = *(const float4*)(p + 8), d = *(const float4*)(p + 12);
    const float s = (a.x + a.y + a.z + a.w) + (b.x + b.y + b.z + b.w) + (c.x + c.y + c.z + c.w) + (d.x + d.y + d.z + d.w); return rsqrtf(s * (1.f / DM) + EPS); }

template <int ACT> struct EpiZ {
    static constexpr bool PERM = true, AFTER_DRAIN = false;
    bf16_t* O; int ldc; const float* rowss;
    DI void operator()(const f32x4 (&acc)[2][2][4][2], const pg8::Unit& u, int wr, int wc, int fr, int fq) const {
        const int row0 = u.pm * 256 + wr * 64 + fr, col0 = u.pn * 256 + wc * 32 + 8 * fq;
#pragma unroll
        for (int ai = 0; ai < 2; ++ai) {
#pragma unroll
          for (int mh = 0; mh < 2; ++mh) {
            f32x4 sl[2][4];
#pragma unroll
            for (int m2 = 0; m2 < 2; ++m2)
#pragma unroll
                for (int k = 0; k < 4; ++k) sl[m2][k] = *(const f32x4*)(rowss + (size_t)(row0 + ai * 128 + (2 * mh + m2) * 16) * 16 + 4 * k);
            __builtin_amdgcn_sched_barrier(0);
#pragma unroll
            for (int m2 = 0; m2 < 2; ++m2) { const int m = 2 * mh + m2;
                const int row = row0 + ai * 128 + m * 16;
                const f32x4 t = (sl[m2][0] + sl[m2][1]) + (sl[m2][2] + sl[m2][3]);
                const float rs = rsqrtf((t[0] + t[1] + t[2] + t[3]) * (1.f / DM) + EPS);
                bf16_t* rowp = O + (size_t)row * ldc + col0;
#pragma unroll
                for (int bj = 0; bj < 2; ++bj) {
                    f32x4 v0 = acc[ai][bj][m][0] * rs, v1 = acc[ai][bj][m][1] * rs;
                    if (ACT == 1) {
#pragma unroll
                        for (int j = 0; j < 4; ++j) { float a = fmaxf(v0[j], 0.f), b = fmaxf(v1[j], 0.f); v0[j] = a * a; v1[j] = b * b; } }
                    u32x4 w; w.x = pg8::cvt_pk_bf16(v0[0], v0[1]); w.y = pg8::cvt_pk_bf16(v0[2], v0[3]); w.z = pg8::cvt_pk_bf16(v1[0], v1[1]); w.w = pg8::cvt_pk_bf16(v1[2], v1[3]);
                    *(u32x4*)(rowp + bj * 128) = w; } } } }
    }
};
struct EpiRes {
    static constexpr bool PERM = false, AFTER_DRAIN = false;
    const float* resid_f; const bf16_t* resid_b; float* outf; bf16_t* outb; float* ssout;
    DI void operator()(const f32x4 (&acc)[2][2][4][2], const pg8::Unit& u, int wr, int wc, int fr, int fq) const {
        const int row0 = u.pm * 256 + wr * 64 + fr, col0 = u.pn * 256 + wc * 32 + 4 * fq;
#pragma unroll
        for (int ai = 0; ai < 2; ++ai)
#pragma unroll
          for (int mh = 0; mh < 2; ++mh) {
            f32x4 rv[2][2][2];
            if (resid_f) {
#pragma unroll
                for (int m2 = 0; m2 < 2; ++m2)
#pragma unroll
                    for (int bj = 0; bj < 2; ++bj)
#pragma unroll
                        for (int n = 0; n < 2; ++n) rv[m2][bj][n] = *(const f32x4*)(resid_f + (size_t)(row0 + ai * 128 + (2 * mh + m2) * 16) * DM + col0 + bj * 128 + n * 16);
            } else {
                u32x2 rb[2][2][2];
#pragma unroll
                for (int m2 = 0; m2 < 2; ++m2)
#pragma unroll
                    for (int bj = 0; bj < 2; ++bj)
#pragma unroll
                        for (int n = 0; n < 2; ++n) rb[m2][bj][n] = *(const u32x2*)(resid_b + (size_t)(row0 + ai * 128 + (2 * mh + m2) * 16) * DM + col0 + bj * 128 + n * 16);
#pragma unroll
                for (int m2 = 0; m2 < 2; ++m2)
#pragma unroll
                    for (int bj = 0; bj < 2; ++bj)
#pragma unroll
                        for (int n = 0; n < 2; ++n) { const u32x2 w = rb[m2][bj][n]; rv[m2][bj][n] = (f32x4){bflo(w.x), bfhi(w.x), bflo(w.y), bfhi(w.y)}; }
            }
            __builtin_amdgcn_sched_barrier(0);
#pragma unroll
            for (int m2 = 0; m2 < 2; ++m2) { const int m = 2 * mh + m2;
                const int row = row0 + ai * 128 + m * 16; float ss = 0.f;
#pragma unroll
                for (int bj = 0; bj < 2; ++bj)
#pragma unroll
                    for (int n = 0; n < 2; ++n) {
                        const size_t o = (size_t)row * DM + col0 + bj * 128 + n * 16;
                        const f32x4 v = acc[ai][bj][m][n] + rv[m2][bj][n];
                        if (outf) *(f32x4*)(outf + o) = v;
                        if (outb) { uint2 w; w.x = pg8::cvt_pk_bf16(v[0], v[1]); w.y = pg8::cvt_pk_bf16(v[2], v[3]);
                            *(uint2*)(outb + o) = w; }
                        ss += v[0] * v[0] + v[1] * v[1] + v[2] * v[2] + v[3] * v[3]; }
                if (outb) { ss += __shfl_xor(ss, 16); ss += __shfl_xor(ss, 32);
                    if (fq == 0) ssout[(size_t)row * 16 + u.pn * 4 + wc] = ss; } } }
    }
};

template <int K, class F> DI void skinny(unsigned char* smem, const bf16_t* A, const bf16_t* Bt, int ntiles, int first, int stride, F f) {
    float* red = (float*)smem;
    const int tid = opaque_tid(), wid = tid >> 6, lane = tid & 63, r = lane & 31, h = lane >> 5;
    constexpr int kw = K >> 3, NS = kw / 16, BS = NS <= 12 ? NS : 8;
    static_assert(NS % BS == 0, "batch");
    for (int tile = first; tile < ntiles; tile += stride) {
        f32x16 acc; for (int i = 0; i < 16; ++i) acc[i] = 0.f;
        const bf16_t* ap = A + (size_t)r * K + wid * kw + 8 * h;
        const bf16_t* bp = Bt + (size_t)(tile * 32 + r) * K + wid * kw + 8 * h;
#pragma unroll 1
        for (int k = 0; k < kw; k += 16 * BS) { bf16x8 av[BS], bv[BS];
#pragma unroll
            for (int j = 0; j < BS; ++j) { av[j] = *(const bf16x8*)(ap + k + 16 * j); bv[j] = *(const bf16x8*)(bp + k + 16 * j); }
            __builtin_amdgcn_sched_barrier(0);
#pragma unroll
            for (int j = 0; j < BS; ++j) acc = MFMA32(av[j], bv[j], acc); }
#pragma unroll
        for (int i = 0; i < 16; ++i) red[wid * 1024 + crow(i, h) * 32 + r] = acc[i];
        __syncthreads();
        for (int o = tid; o < 1024; o += 512) { float s = 0.f;
#pragma unroll
            for (int w = 0; w < 8; ++w) s += red[w * 1024 + o];
            f(o >> 5, tile * 32 + (o & 31), s, tile); }
        __syncthreads();
    }
}
#define XB_TMO      128
#define XB_XCNT(j)  (256  + 64 * (j))
#define XB_XSUB(j)  (1280 + 64 * (j))
#define XB_XGEN(j)  (2304 + 64 * (j))
#define XB_TOP      3328
#define XB_TOPGEN   3392
#define XCD_BAR_WORDS 3456
#define XB_SPIN_CAP (1u << 18)

__device__ __forceinline__ unsigned xb_ld(unsigned* p)              { return __hip_atomic_load(p, __ATOMIC_RELAXED, __HIP_MEMORY_SCOPE_AGENT); }
__device__ __forceinline__ unsigned xb_add(unsigned* p, unsigned v) { return __hip_atomic_fetch_add(p, v, __ATOMIC_RELAXED, __HIP_MEMORY_SCOPE_AGENT); }
__device__ __forceinline__ unsigned xb_xcc_id() { return (unsigned)__builtin_amdgcn_s_getreg((3 << 11) | 20) & 0xFu; }
#define XB_SPIN(cond, bar) do { unsigned _sp = 0; while (cond) { __builtin_amdgcn_s_sleep(1); \
    if ((++_sp & 255u) == 0u) { if (xb_ld(&(bar)[XB_TMO])) break; if (_sp > XB_SPIN_CAP) { atomicAdd(&(bar)[XB_TMO], 1u); break; } } } } while (0)

struct XcdBarrier {
    unsigned* bar; unsigned x;
    volatile LAS unsigned* st;
};

__device__ __forceinline__ XcdBarrier xcd_barrier_post(unsigned* bar, volatile LAS unsigned* st) {
    XcdBarrier b; b.bar = bar; b.x = xb_xcc_id(); b.st = st;
    if (threadIdx.x == 0) (void)xb_add(&bar[XB_XCNT(b.x)], 1u);
    return b;
}
__device__ __forceinline__ void xcd_barrier_complete(unsigned* bar, unsigned x, unsigned& nloc, unsigned& nx) {
    const unsigned G = gridDim.x * gridDim.y * gridDim.z;
    unsigned sum, cnt, mine, sp = 0u;
    for (;;) {
        sum = 0u; cnt = 0u; mine = 0u;
#pragma unroll
        for (unsigned j = 0; j < 16; ++j) { const unsigned c = xb_ld(&bar[XB_XCNT(j)]); sum += c; cnt += (c > 0u) ? 1u : 0u; mine = (j == x) ? c : mine; }
        if (sum == G) break;
        __builtin_amdgcn_s_sleep(1);
        if ((++sp & 255u) == 0u) { if (xb_ld(&bar[XB_TMO])) break; if (sp > XB_SPIN_CAP) { atomicAdd(&bar[XB_TMO], 1u); break; } }
    }
    nloc = mine > 0u ? mine : 1u; nx = cnt > 0u ? cnt : 1u;
}

__device__ __forceinline__ void xcd_barrier(const XcdBarrier& b) {
    asm volatile("s_waitcnt vmcnt(0)" ::: "memory");
    __syncthreads();
    if (threadIdx.x == 0) {
        unsigned* bar = b.bar;
        __builtin_amdgcn_s_waitcnt(0);
        unsigned nloc = b.st[0], nx = b.st[1];
        if (nloc == 0u) { xcd_barrier_complete(bar, b.x, nloc, nx); b.st[0] = nloc; b.st[1] = nx; }
        const unsigned old = xb_add(&bar[XB_XSUB(b.x)], 1u);
        const unsigned gen = old / nloc;
        if (old + 1u == (gen + 1u) * nloc) {
            __builtin_amdgcn_fence(__ATOMIC_RELEASE, "agent");
            asm volatile("s_waitcnt vmcnt(0)" ::: "memory");
            const unsigned og = xb_add(&bar[XB_TOP], 1u);
            const unsigned tg = og / nx;
            if (og + 1u == (tg + 1u) * nx) xb_add(&bar[XB_TOPGEN], 1u);
            else XB_SPIN(xb_ld(&bar[XB_TOPGEN]) == tg, bar);
            __builtin_amdgcn_fence(__ATOMIC_ACQUIRE, "agent");
            xb_add(&bar[XB_XGEN(b.x)], 1u);
            asm volatile("s_waitcnt vmcnt(0)" ::: "memory");
        } else {
            XB_SPIN(xb_ld(&bar[XB_XGEN(b.x)]) == gen, bar);
            __builtin_amdgcn_fence(__ATOMIC_ACQUIRE, "agent");
            asm volatile("s_waitcnt vmcnt(0)" ::: "memory");
        }
    }
    __syncthreads();
}
DI void transpose_tile(float* tl, const float* W, int ldw, int k0, int nsrc0, int nvalid, const float* gain, bf16_t* Bt, int K, int ndst0) {
    const int tid = opaque_tid(), col = tid & 63, rb = tid >> 6;
    float v[32];
#pragma unroll
    for (int i = 0; i < 32; ++i) { const int kk = rb + 8 * i; v[i] = (col < nvalid) ? W[(size_t)(k0 + kk) * ldw + nsrc0 + col] : 0.f; }
#pragma unroll
    for (int i = 0; i < 32; ++i) { const int kk = rb + 8 * i; tl[kk * 65 + col] = gain ? v[i] * gain[k0 + kk] : v[i]; }
    __syncthreads();
    { const int n = tid >> 3, ks = (tid & 7) * 32;
#pragma unroll
      for (int g = 0; g < 4; ++g) { float f[8];
#pragma unroll
          for (int j = 0; j < 8; ++j) f[j] = tl[(ks + 8 * g + j) * 65 + n];
          *(uint4*)(Bt + (size_t)(ndst0 + n) * K + k0 + ks + 8 * g) = pack8(f); } }
    __syncthreads();
}

DI float rope_inv_freq(int fi) { return exp2f(-(float)(2 * fi) * (13.287712379549449f / 64.f)); }
DI float ret_inv_freq(int fi) { return exp2f(-(float)fi * (13.287712379549449f / 31.f)); }
template <class PT> DI void copy_cache(const PT& p, unsigned first, unsigned stride) {
    const unsigned per = 2047u * GW / 4, tot = per * 64 * 2;
    for (unsigned i0 = first; i0 < tot; i0 += 8 * stride) {
        f32x4 v[8]; f32x4* dp[8];
#pragma unroll
        for (int k = 0; k < 8; ++k) { const unsigned i = i0 + k * stride; dp[k] = nullptr;
            if (i < tot) { const unsigned which = i / (per * 64), rem = i % (per * 64); const size_t ln = rem / per, off = rem % per;
                const f32x4* src = (const f32x4*)(p.in[which ? I_CAV : I_CAK] + ln * 2048 * GW + GW) + off;
                dp[k] = (f32x4*)(p.out + (which ? O_SAV : O_SAK) + ln * 2048 * GW) + off;
                v[k] = __builtin_nontemporal_load(src); } }
#pragma unroll
        for (int k = 0; k < 8; ++k) if (dp[k]) __builtin_nontemporal_store(v[k], dp[k]); }
}
DI unsigned copy_idx(unsigned slot, int k, unsigned tid) { const unsigned tot = (2047u * GW / 4) * 128u; const unsigned i = slot * 4096u + (unsigned)k * 512u + tid; return i < tot ? i : tot - 1u; }
template <class PT> DI void copy_slot_load(const PT& p, unsigned slot, f32x4 (&v)[8]) {
    const unsigned per = 2047u * GW / 4, tid = (unsigned)opaque_tid();
#pragma unroll
    for (int k = 0; k < 8; ++k) { const unsigned i = copy_idx(slot, k, tid), which = i / (per * 64), rem = i % (per * 64); const size_t ln = rem / per, off = rem % per;
        v[k] = __builtin_nontemporal_load((const f32x4*)(p.in[which ? I_CAV : I_CAK] + ln * 2048 * GW + GW) + off); }
}
template <class PT> DI void copy_slot_store(const PT& p, unsigned slot, const f32x4 (&v)[8]) {
    const unsigned per = 2047u * GW / 4, tid = (unsigned)opaque_tid();
#pragma unroll
    for (int k = 0; k < 8; ++k) { const unsigned i = copy_idx(slot, k, tid), which = i / (per * 64), rem = i % (per * 64); const size_t ln = rem / per, off = rem % per;
        __builtin_nontemporal_store(v[k], (f32x4*)(p.out + (which ? O_SAV : O_SAK) + ln * 2048 * GW) + off); }
}
template <class PT> DI void weight_tile(float* tl, const PT& p, int l, int t) {
    if (t < 352) { const int kt = t / 88, nt = t % 88, nd = nt * 64; int ns, nv;
        if (nd < 2688) { ns = nd; nv = 64; } else if (nd < 5376) { ns = nd + 12; nv = 64; } else if (nd == 5376) { ns = 2688; nv = 12; } else { ns = 0; nv = 0; }
        transpose_tile(tl, p.in[I_W_IN] + (size_t)l * DM * NIN, NIN, kt * 256, ns, nv, p.in[I_NORM_MIX] + l * DM, (bf16_t*)(p.ws + WS_WT_IN + l * SZ_WT_IN), DM, nd); }
    else if (t < 352 + 96) { t -= 352; const int kt = t / 16, nt = t % 16;
        transpose_tile(tl, p.in[I_W_OUT] + (size_t)l * MIXW * DM, DM, kt * 256, nt * 64, 64, (const float*)nullptr, (bf16_t*)(p.ws + WS_WT_OUT + l * SZ_WT_OUT), MIXW, nt * 64); }
    else if (t < 352 + 96 + 256) { t -= 352 + 96; const int kt = t / 64, nt = t % 64;
        transpose_tile(tl, p.in[I_W_UP] + (size_t)l * DM * DFF, DFF, kt * 256, nt * 64, 64, p.in[I_NORM_FFN] + l * DM, (bf16_t*)(p.ws + WS_WT_UP + l * SZ_WT_UP), DM, nt * 64); }
    else { t -= 352 + 96 + 256; const int kt = t / 16, nt = t % 16;
        transpose_tile(tl, p.in[I_W_DOWN] + (size_t)l * DFF * DM, DM, kt * 256, nt * 64, 64, (const float*)nullptr, (bf16_t*)(p.ws + WS_WT_DOWN + l * SZ_WT_DOWN), DFF, nt * 64); }
}
template <class PT> DI void deferred_weight_tiles(unsigned char* smem, const PT& p, int list, int first, int stride) {
    float* tl = (float*)smem; const int n = list == 0 ? 960 : 608;
    for (int i = first; i < n; i += stride) { if (list == 0) { if (i < 608) weight_tile(tl, p, 0, 352 + i); else weight_tile(tl, p, 1, i - 608); } else weight_tile(tl, p, 1, 352 + i); }
}
template <class PT> DI void phase0(unsigned char* smem, const PT& p) {
    const int G = gridDim.x, b = blockIdx.x, tid = opaque_tid(), wid = tid >> 6, lane = tid & 63;
    float* tl = (float*)smem;
    for (int task = b; task < 352; task += G) weight_tile(tl, p, 0, task);
    for (int row = b * 8 + wid; row < MP + MD; row += G * 8) {
        const bool dec = row >= MP; const int r = dec ? row - MP : row;
        const float* src = dec ? p.in[I_XS] + (size_t)r * DM : p.in[I_XP] + (size_t)r * DM;
        bf16_t* dst = dec ? (bf16_t*)(p.ws + WS_XSB) + (size_t)r * DM : (bf16_t*)(p.ws + WS_XB) + (size_t)r * DM;
        float ss = 0.f;
#pragma unroll
        for (int i = 0; i < 4; ++i) { const float4 v = *(const float4*)(src + i * 256 + lane * 4); ss += v.x * v.x + v.y * v.y + v.z * v.z + v.w * v.w;
            uint2 w; w.x = pack2(v.x, v.y); w.y = pack2(v.z, v.w); *(uint2*)(dst + i * 256 + lane * 4) = w; }
        ss = wave_sum(ss);
        if (dec) { float* s = (float*)(p.ws + WS_ROWSS_S) + (size_t)r * 32; if (lane < 32) s[lane] = lane == 0 ? ss : 0.f; }
        else { float* s = (float*)(p.ws + WS_ROWSS) + (size_t)r * 16; if (lane < 16) s[lane] = lane == 0 ? ss : 0.f; }
    }
    for (int i = b * 512 + tid; i < 2 * T_ * 32; i += G * 512) { const int which = i / (T_ * 32), t = (i / 32) % T_, fi = i & 31;
        float sn, cs; sincosf((float)t * (which ? ret_inv_freq(fi) : rope_inv_freq(fi)), &sn, &cs);
        ((float2*)(p.ws + WS_TRIG))[i] = make_float2(cs, sn); }
#ifdef COPY_IN_P0
    copy_cache(p, (unsigned)b * 512 + tid, (unsigned)G * 512);
#endif
}

template <class PT> DI void aprep_task(unsigned char* smem, const PT& p, int l, int task) {
    const int n = task / (NH * 64), h = (task / 64) % NH, tile = task % 64;
    const int tid = opaque_tid(), i = tid >> 3, seg = tid & 7, t = tile * 64 + i;
    const bf16_t* zrow = (const bf16_t*)(p.ws + WS_R1) + (size_t)(n * T_ + t) * ZS;
    const size_t hoff = ((size_t)(n * NH + h) * T_ + t) * HD + 8 * seg;
    const uint4 rawq = *(const uint4*)(zrow + AQ + h * 64 + 8 * seg), rawk = *(const uint4*)(zrow + AK + h * 64 + 8 * seg), rawv = *(const uint4*)(zrow + AV + h * 64 + 8 * seg);
    float gq[8], gk[8];
    { const float* g0 = p.in[I_QNORM] + l * HD + 8 * seg; const float* g1 = p.in[I_KNORM] + l * HD + 8 * seg;
#pragma unroll
      for (int j = 0; j < 8; ++j) { gq[j] = g0[j]; gk[j] = g1[j]; } }
    float cs[8], sn[8];
    { const float4* tp = (const float4*)((const float2*)(p.ws + WS_TRIG) + (size_t)t * 32 + ((8 * seg) & 31));
#pragma unroll
      for (int j = 0; j < 4; ++j) { const float4 v = tp[j]; cs[2 * j] = v.x; sn[2 * j] = v.y; cs[2 * j + 1] = v.z; sn[2 * j + 1] = v.w; } }
#pragma unroll
    for (int which = 0; which < 2; ++which) {
        float x[8]; unpack8(which ? rawk : rawq, x);
        float ss = 0.f;
#pragma unroll
        for (int j = 0; j < 8; ++j) ss += x[j] * x[j];
        ss += __shfl_xor(ss, 1); ss += __shfl_xor(ss, 2); ss += __shfl_xor(ss, 4);
        const float r = rsqrtf(ss * (1.f / 64.f) + EPS);
        float y[8], o[8];
#pragma unroll
        for (int j = 0; j < 8; ++j) y[j] = x[j] * r * (which ? gk[j] : gq[j]);
#pragma unroll
        for (int j = 0; j < 8; ++j) { const float pr = __shfl_xor(y[j], 4); o[j] = (seg < 4) ? (y[j] * cs[j] - pr * sn[j]) : (y[j] * cs[j] + pr * sn[j]); }
        if (which == 0) {
#pragma unroll
            for (int j = 0; j < 8; ++j) o[j] *= 0.125f;
            *(uint4*)((bf16_t*)(p.ws + WS_QA) + hoff) = pack8(o);
        } else {
            *(uint4*)((bf16_t*)(p.ws + WS_KA) + hoff) = pack8(o);
            if (t >= T_ - 2048) { float* d = p.out + O_PAK + (((size_t)(l * NBAT + n) * 2048 + (t - (T_ - 2048))) * NH + h) * HD + 8 * seg;
                *(float4*)d = make_float4(o[0], o[1], o[2], o[3]); *(float4*)(d + 4) = make_float4(o[4], o[5], o[6], o[7]); }
        }
    }
    unsigned short* vt = (unsigned short*)smem;
    { float x[8]; unpack8(rawv, x);
      if (t >= T_ - 2048) { float* d = p.out + O_PAV + (((size_t)(l * NBAT + n) * 2048 + (t - (T_ - 2048))) * NH + h) * HD + 8 * seg;
          *(float4*)d = make_float4(x[0], x[1], x[2], x[3]); *(float4*)(d + 4) = make_float4(x[4], x[5], x[6], x[7]); }
#pragma unroll
      for (int j = 0; j < 8; ++j) vt[i * 66 + 8 * seg + j] = f2bf(x[j]); }
    __syncthreads();
    { const int dim = tid >> 3, ts = tid & 7; unsigned short e[8];
#pragma unroll
      for (int j = 0; j < 8; ++j) e[j] = vt[(8 * ts + j) * 66 + dim];
      const int tb = tile * 64 + 8 * ts;
      bf16_t* base = (bf16_t*)(p.ws + WS_VT) + ((size_t)(n * NH + h) * HD + dim) * T_;
      uint4 w; w.x = e[0] | ((unsigned)e[1] << 16); w.y = e[2] | ((unsigned)e[3] << 16); w.z = e[4] | ((unsigned)e[5] << 16); w.w = e[6] | ((unsigned)e[7] << 16);
      *(uint4*)(base + tb) = w;
      bf16_t* b4 = base + SZ_HEADBUF / 2;
#pragma unroll
      for (int rr = 0; rr < 4; ++rr) *(unsigned*)(b4 + rr * 1024 + tb / 4) = e[rr] | ((unsigned)e[rr + 4] << 16);
      bf16_t* b16 = base + SZ_HEADBUF;
#pragma unroll
      for (int j = 0; j < 8; ++j) b16[(8 * (ts & 1) + j) * 256 + tb / 16] = e[j]; }
    __syncthreads();
}

template <class PT> DI void dmix_task(const PT& p, int l, int task) {
    const int n = task / 64, tile = task % 64, tid = opaque_tid();
    const bf16_t* zb = (const bf16_t*)(p.ws + WS_R1) + (size_t)n * T_ * ZS;
    const float* cw = p.in[I_CONVD] + (size_t)l * 3 * GW;
    for (int item = tid; item < 64 * 48; item += 512) {
        const int i = item / 48, cg8 = (item % 48) * 8, t = tile * 64 + i;
        float prod[3][8];
#pragma unroll
        for (int j = 0; j < 3; ++j) { const int tt = t - 2 + j;
            if (tt >= 0) { float a[8], c[8]; unpack8(*(const uint4*)(zb + (size_t)tt * ZS + DX + cg8), a); unpack8(*(const uint4*)(zb + (size_t)tt * ZS + DC + cg8), c);
#pragma unroll
                for (int e = 0; e < 8; ++e) prod[j][e] = a[e] * c[e]; }
            else {
#pragma unroll
                for (int e = 0; e < 8; ++e) prod[j][e] = 0.f; } }
        float bb[8], o[8]; unpack8(*(const uint4*)(zb + (size_t)t * ZS + DB + cg8), bb);
#pragma unroll
        for (int e = 0; e < 8; ++e) o[e] = bb[e] * (prod[0][e] * cw[cg8 + e] + prod[1][e] * cw[GW + cg8 + e] + prod[2][e] * cw[2 * GW + cg8 + e]);
        *(uint4*)((bf16_t*)(p.ws + WS_MIX) + (size_t)(n * T_ + t) * MIXW + 3 * GW + cg8) = pack8(o);
        if (t >= T_ - 2) { float* d = p.out + O_PDCONV + ((size_t)(l * NBAT + n) * 2 + (t - (T_ - 2))) * GW + cg8;
#pragma unroll
            for (int e = 0; e < 8; ++e) d[e] = prod[2][e]; }
    }
    if (tile == 63) for (int item = tid; item < 3 * 1152; item += 512) { const int rr = item / 1152, c = item % 1152;
        p.out[O_PBCONV + ((size_t)(l * NBAT + n) * 3 + rr) * 1152 + c] = bf2f(zb[(size_t)(T_ - 3 + rr) * ZS + BQ + c]); }
}

template <bool IS_B, class PT> DI void chunk_prep(unsigned char* smem, const PT& p, int l, int task) {
    const int nh = task / 64, ch = task % 64, n = nh / NH, h = nh % NH;
    float* qs = (float*)smem; float* ks = qs + 64 * 68; float* vs = ks + 64 * 68; float* As = vs + 64 * 68; float* Gs = As + 4096; float* betas = Gs + 64; float* graw = betas + 64;
    const int tid = opaque_tid(), i = tid >> 3, seg = tid & 7, t = ch * 64 + i;
    const bf16_t* zrow = (const bf16_t*)(p.ws + WS_R1) + (size_t)(n * T_ + t) * ZS;
    bf16_t* blk = IS_B ? (bf16_t*)(p.ws + WS_BBLK + (size_t)task * 40960) : (bf16_t*)(p.ws + WS_CBLK + (size_t)task * 32768);
    bf16_t* o_w = blk; bf16_t* o_kdt = IS_B ? blk + 4096 : blk; bf16_t* o_qg = o_kdt + 4096; bf16_t* o_qk = o_qg + 4096; bf16_t* o_ut = o_qk + 4096;
    const float lg = IS_B ? 0.f : __logf(1.f - exp2f(-5.f - (float)h));
    if (IS_B) {
        const float* cwb = p.in[I_CONVB] + (size_t)l * 4 * 1152;
        float res[3][8];
        uint4 zr[3][4];
#pragma unroll
        for (int which = 0; which < 3; ++which)
#pragma unroll
            for (int j = 0; j < 4; ++j) { const int back = (t - 3 + j >= 0) ? (j - 3) : 0;
                zr[which][j] = *(const uint4*)(zrow + (ptrdiff_t)back * ZS + BQ + which * GW + h * 64 + 8 * seg); }
#pragma unroll
        for (int which = 0; which < 3; ++which) {
            float a[8];
#pragma unroll
            for (int e = 0; e < 8; ++e) a[e] = 0.f;
            const int co = which * GW + h * 64 + 8 * seg;
            float4 w0[4], w1[4];
#pragma unroll
            for (int j = 0; j < 4; ++j) { w0[j] = *(const float4*)(cwb + j * 1152 + co); w1[j] = *(const float4*)(cwb + j * 1152 + co + 4); }
#pragma unroll
            for (int j = 0; j < 4; ++j) { const float mk = (t - 3 + j >= 0) ? 1.f : 0.f; float x[8]; unpack8(zr[which][j], x);
                a[0] += mk * x[0] * w0[j].x; a[1] += mk * x[1] * w0[j].y; a[2] += mk * x[2] * w0[j].z; a[3] += mk * x[3] * w0[j].w;
                a[4] += mk * x[4] * w1[j].x; a[5] += mk * x[5] * w1[j].y; a[6] += mk * x[6] * w1[j].z; a[7] += mk * x[7] * w1[j].w; }
#pragma unroll
            for (int e = 0; e < 8; ++e) a[e] = silu_f(a[e]);
            if (which < 2) { float ss = 0.f;
#pragma unroll
                for (int e = 0; e < 8; ++e) ss += a[e] * a[e];
                ss += __shfl_xor(ss, 1); ss += __shfl_xor(ss, 2); ss += __shfl_xor(ss, 4);
                const float r = rsqrtf(ss + EPS) * (which == 0 ? 0.125f : 1.f);
#pragma unroll
                for (int e = 0; e < 8; ++e) a[e] *= r; }
#pragma unroll
            for (int e = 0; e < 8; ++e) res[which][e] = a[e];
        }
        float gA = 0.f, gB = 0.f;
        if (seg == 0) { const float za = bf2f(zrow[GA + h]), zb = bf2f(zrow[GB + h]);
            const float xx = za + p.in[I_DTBIAS][l * NH + h]; const float sp = xx > 20.f ? xx : __logf(1.f + __expf(xx));
            gA = -__expf(p.in[I_ALOG][l * NH + h]) * sp; gB = 1.f / (1.f + __expf(-zb)); }
#pragma unroll
        for (int which = 0; which < 3; ++which) { float* dst = (which == 0 ? qs : which == 1 ? ks : vs) + i * 68 + 8 * seg;
            *(float4*)dst = make_float4(res[which][0], res[which][1], res[which][2], res[which][3]); *(float4*)(dst + 4) = make_float4(res[which][4], res[which][5], res[which][6], res[which][7]); }
        if (seg == 0) { graw[i] = gA; betas[i] = gB; }
        __syncthreads();
        if (tid < 64) { float v = graw[tid];
#pragma unroll
            for (int off = 1; off < 64; off <<= 1) { const float u = __shfl_up(v, off); if (tid >= off) v += u; }
            Gs[tid] = v; }
        __syncthreads();
    } else {
        const uint4 rawq = *(const uint4*)(zrow + CQ + h * 64 + 8 * seg), rawk = *(const uint4*)(zrow + CK + h * 64 + 8 * seg), rawv = *(const uint4*)(zrow + CV + h * 64 + 8 * seg);
        float cs[8], sn[8];
        { const float4* tp = (const float4*)((const float2*)(p.ws + WS_TRIG) + (size_t)(T_ + t) * 32 + ((8 * seg) & 31));
#pragma unroll
          for (int j = 0; j < 4; ++j) { const float4 v = tp[j]; cs[2 * j] = v.x; sn[2 * j] = v.y; cs[2 * j + 1] = v.z; sn[2 * j + 1] = v.w; } }
#pragma unroll
        for (int which = 0; which < 2; ++which) {
            float y[8], o[8]; unpack8(which ? rawk : rawq, y);
#pragma unroll
            for (int j = 0; j < 8; ++j) { const float pr = __shfl_xor(y[j], 4); o[j] = (seg < 4) ? (y[j] * cs[j] - pr * sn[j]) : (y[j] * cs[j] + pr * sn[j]); if (which) o[j] *= 0.125f; }
            float* dst = (which ? ks : qs) + i * 68 + 8 * seg;
            *(float4*)dst = make_float4(o[0], o[1], o[2], o[3]); *(float4*)(dst + 4) = make_float4(o[4], o[5], o[6], o[7]);
        }
        { float x[8]; unpack8(rawv, x); float* dst = vs + i * 68 + 8 * seg;
          *(float4*)dst = make_float4(x[0], x[1], x[2], x[3]); *(float4*)(dst + 4) = make_float4(x[4], x[5], x[6], x[7]); }
        if (tid < 64) Gs[tid] = (float)(tid + 1) * lg;
        __syncthreads();
    }
    { unsigned short* QH = (unsigned short*)(graw + 64 + 8192); unsigned short* KH = QH + 64 * 72; unsigned short* KL = KH + 64 * 72;
      { float a[8], b8[8];
        { const float4 x0 = *(const float4*)(qs + i * 68 + 8 * seg), x1 = *(const float4*)(qs + i * 68 + 8 * seg + 4); a[0] = x0.x; a[1] = x0.y; a[2] = x0.z; a[3] = x0.w; a[4] = x1.x; a[5] = x1.y; a[6] = x1.z; a[7] = x1.w; }
        *(uint4*)(QH + i * 72 + 8 * seg) = pack8(a);
        { const float4 x0 = *(const float4*)(ks + i * 68 + 8 * seg), x1 = *(const float4*)(ks + i * 68 + 8 * seg + 4); a[0] = x0.x; a[1] = x0.y; a[2] = x0.z; a[3] = x0.w; a[4] = x1.x; a[5] = x1.y; a[6] = x1.z; a[7] = x1.w; }
        const uint4 kh = pack8(a); *(uint4*)(KH + i * 72 + 8 * seg) = kh;
        if (IS_B) { float hf[8]; unpack8(kh, hf);
#pragma unroll
            for (int e = 0; e < 8; ++e) b8[e] = a[e] - hf[e];
            *(uint4*)(KL + i * 72 + 8 * seg) = pack8(b8); } }
      __syncthreads();
      const int wid = tid >> 6, lane = tid & 63, col = lane & 15, quad = lane >> 4, it = wid >> 1;
      bf16x8 qa[2], ka[2], la[2];
#pragma unroll
      for (int ksx = 0; ksx < 2; ++ksx) { qa[ksx] = *(const bf16x8*)(QH + (16 * it + col) * 72 + 32 * ksx + 8 * quad); ka[ksx] = *(const bf16x8*)(KH + (16 * it + col) * 72 + 32 * ksx + 8 * quad);
          if (IS_B) la[ksx] = *(const bf16x8*)(KL + (16 * it + col) * 72 + 32 * ksx + 8 * quad); }
#pragma unroll
      for (int jj = 0; jj < 2; ++jj) { const int jt = (wid & 1) * 2 + jj;
          f32x4 aqk = (f32x4){0.f, 0.f, 0.f, 0.f}, akk = (f32x4){0.f, 0.f, 0.f, 0.f};
#pragma unroll
          for (int ksx = 0; ksx < 2; ++ksx) { const bf16x8 kb = *(const bf16x8*)(KH + (16 * jt + col) * 72 + 32 * ksx + 8 * quad);
              aqk = MFMA16(qa[ksx], kb, aqk);
              if (IS_B) { const bf16x8 lb = *(const bf16x8*)(KL + (16 * jt + col) * 72 + 32 * ksx + 8 * quad);
                  akk = MFMA16(ka[ksx], kb, akk); akk = MFMA16(ka[ksx], lb, akk); akk = MFMA16(la[ksx], kb, akk); } }
          const int j = 16 * jt + col; const float Gj = Gs[j];
          const float4 g4 = *(const float4*)(Gs + 16 * it + 4 * quad); const float gi[4] = {g4.x, g4.y, g4.z, g4.w};
          float bt[4] = {0.f, 0.f, 0.f, 0.f};
          if (IS_B) { const float4 b4 = *(const float4*)(betas + 16 * it + 4 * quad); bt[0] = b4.x; bt[1] = b4.y; bt[2] = b4.z; bt[3] = b4.w; }
#pragma unroll
          for (int r = 0; r < 4; ++r) { const int ii = 16 * it + 4 * quad + r; const float ex = __expf(fminf(gi[r] - Gj, 0.f)); const float dec = (ii >= j) ? ex : 0.f;
              o_qk[ii * 64 + j] = f2bf(aqk[r] * dec);
              if (IS_B) As[ii * 64 + j] = (ii > j) ? bt[r] * akk[r] * dec : 0.f; } } }
    { const float eg = __expf(Gs[i]); float o[8];
#pragma unroll
      for (int e = 0; e < 8; ++e) o[e] = qs[i * 68 + 8 * seg + e] * eg;
      *(uint4*)(o_qg + i * 64 + 8 * seg) = pack8(o);
      const int d = i; const float G63 = Gs[63];
#pragma unroll
      for (int e = 0; e < 8; ++e) { const int j = 8 * seg + e; o[e] = ks[j * 68 + d] * __expf(G63 - Gs[j]); }
      *(uint4*)(o_kdt + d * 64 + 8 * seg) = pack8(o);
      if (!IS_B) {
#pragma unroll
          for (int e = 0; e < 8; ++e) o[e] = vs[(8 * seg + e) * 68 + d];
          *(uint4*)(o_ut + d * 64 + 8 * seg) = pack8(o); }
      if (IS_B && tid == 0) ((float*)(p.ws + WS_DLB))[task] = __expf(G63); }
    __syncthreads();
    if (IS_B) {
        float* Xs = graw + 64;
        float* TMP = Xs + 8192 + 6912;
        float* Ti = TMP + 2048;
        { const int c = tid & 127, pt = tid >> 7;
#pragma unroll 4
          for (int k = 0; k < 16; ++k) { const int i2 = pt * 16 + k;
              Xs[i2 * 128 + c] = (c < 64) ? betas[i2] * vs[i2 * 68 + c] : betas[i2] * __expf(Gs[i2]) * ks[i2 * 68 + (c - 64)]; } }
        if (tid < 64) { const int bb = tid >> 4, c = tid & 15; float t[16];
#pragma unroll
            for (int i2 = 0; i2 < 16; ++i2) { float sx = (i2 == c) ? 1.f : 0.f;
#pragma unroll
                for (int j = 0; j < i2; ++j) sx -= As[(16 * bb + i2) * 64 + 16 * bb + j] * t[j];
                t[i2] = sx; }
#pragma unroll
            for (int i2 = 0; i2 < 16; ++i2) Ti[bb * 256 + i2 * 16 + c] = t[i2]; }
        __syncthreads();
#pragma unroll 1
        for (int rb = 0; rb < 4; ++rb) {
            const int c = tid & 127, pt = tid >> 7, r0 = 16 * rb + 4 * pt;
            { float a0 = 0.f, a1 = 0.f, a2 = 0.f, a3 = 0.f;
#pragma unroll 4
              for (int j = 0; j < 16 * rb; ++j) { const float x = Xs[j * 128 + c];
                  a0 += As[(r0 + 0) * 64 + j] * x; a1 += As[(r0 + 1) * 64 + j] * x; a2 += As[(r0 + 2) * 64 + j] * x; a3 += As[(r0 + 3) * 64 + j] * x; }
              TMP[(4 * pt + 0) * 128 + c] = Xs[(r0 + 0) * 128 + c] - a0; TMP[(4 * pt + 1) * 128 + c] = Xs[(r0 + 1) * 128 + c] - a1;
              TMP[(4 * pt + 2) * 128 + c] = Xs[(r0 + 2) * 128 + c] - a2; TMP[(4 * pt + 3) * 128 + c] = Xs[(r0 + 3) * 128 + c] - a3; }
            __syncthreads();
            { float o0 = 0.f, o1 = 0.f, o2 = 0.f, o3 = 0.f; const float* tr = Ti + rb * 256 + (4 * pt) * 16;
#pragma unroll
              for (int j = 0; j < 16; ++j) { const float x = TMP[j * 128 + c];
                  o0 += tr[j] * x; o1 += tr[16 + j] * x; o2 += tr[32 + j] * x; o3 += tr[48 + j] * x; }
              Xs[(r0 + 0) * 128 + c] = o0; Xs[(r0 + 1) * 128 + c] = o1; Xs[(r0 + 2) * 128 + c] = o2; Xs[(r0 + 3) * 128 + c] = o3; }
            __syncthreads();
        }
        { const int e = tid >> 3, g = tid & 7; float o[8];
#pragma unroll
          for (int k = 0; k < 8; ++k) o[k] = Xs[(8 * g + k) * 128 + e];
          *(uint4*)(o_ut + e * 64 + 8 * g) = pack8(o);
#pragma unroll
          for (int k = 0; k < 8; ++k) o[k] = Xs[e * 128 + 64 + 8 * g + k];
          *(uint4*)(o_w + e * 64 + 8 * g) = pack8(o); }
    }
    __syncthreads();
}
template <class PT> DI void decode_task(unsigned char* smem, const PT& p, int l, int bt) {
    const int tid = opaque_tid(), wid = tid >> 6, lane = tid & 63;
    float* wl = (float*)smem + wid * 576;
    const int gw = bt * 8 + wid;
    const float pos = 16384.f;
    if (gw < 192) {
        const int n = gw / 6, h = gw % 6; const int fi = lane & 31;
        const float* zr = (const float*)(p.ws + WS_ZD) + (size_t)n * ZS; bf16_t* mixs = (bf16_t*)(p.ws + WS_MIXS) + (size_t)n * MIXW;
        float sn, cs; sincosf(pos * rope_inv_freq(fi), &sn, &cs);
        float q = zr[AQ + h * 64 + lane], k = zr[AK + h * 64 + lane]; const float v = zr[AV + h * 64 + lane];
        { const float r = rsqrtf(wave_sum(q * q) * (1.f / 64.f) + EPS); q = q * r * p.in[I_QNORM][l * HD + lane];
          const float pr = __shfl_xor(q, 32); q = (lane < 32) ? (q * cs - pr * sn) : (q * cs + pr * sn); q *= 0.125f; }
        { const float r = rsqrtf(wave_sum(k * k) * (1.f / 64.f) + EPS); k = k * r * p.in[I_KNORM][l * HD + lane];
          const float pr = __shfl_xor(k, 32); k = (lane < 32) ? (k * cs - pr * sn) : (k * cs + pr * sn); }
        p.out[O_SAK + (((size_t)(l * MD + n) * 2048 + 2047) * NH + h) * HD + lane] = k;
        p.out[O_SAV + (((size_t)(l * MD + n) * 2048 + 2047) * NH + h) * HD + lane] = v;
        wl[lane] = q; wl[512 + lane] = v;
        const float snew = wave_sum(q * k);
        const float* ck = p.in[I_CAK] + (size_t)(l * MD + n) * 2048 * GW + h * HD;
        const float* cv = p.in[I_CAV] + (size_t)(l * MD + n) * 2048 * GW + h * HD;
        float mx = snew;
#pragma unroll 1
        for (int it = 0; it < 7; ++it) { const int e = it * 64 + lane; float s = -1e30f;
            if (e < 387) { const int br = e / 129, j = e % 129; const int dil = br == 0 ? 1 : (br == 1 ? 4 : 16);
                if (j == 0) s = snew; else { const float* kr = ck + (size_t)(2048 - dil * j) * GW; float4 kv[16];
#pragma unroll
                    for (int d4 = 0; d4 < 16; ++d4) kv[d4] = *(const float4*)(kr + 4 * d4);
                    float a = 0.f;
#pragma unroll
                    for (int d4 = 0; d4 < 16; ++d4) a += kv[d4].x * wl[4 * d4] + kv[d4].y * wl[4 * d4 + 1] + kv[d4].z * wl[4 * d4 + 2] + kv[d4].w * wl[4 * d4 + 3];
                    s = a; } }
            wl[64 + e] = s; mx = fmaxf(mx, s); }
        mx = wave_max(mx); float sum = 0.f;
#pragma unroll 1
        for (int it = 0; it < 7; ++it) { const int e = it * 64 + lane; const float pe = (e < 387) ? __expf(wl[64 + e] - mx) : 0.f; sum += pe; wl[64 + e] = pe; }
        sum = wave_sum(sum);
        const int g = lane >> 4, dl4 = (lane & 15) * 4;
        float4 acc = make_float4(0.f, 0.f, 0.f, 0.f);
#pragma unroll 8
        for (int it = 0; it < 97; ++it) { const int e = 4 * it + g; const int ee = e < 387 ? e : 386; const int br = ee / 129, j = ee % 129; const int dil = br == 0 ? 1 : (br == 1 ? 4 : 16);
            const float pe = (e < 387 && j != 0) ? wl[64 + ee] : 0.f; const int row = j != 0 ? 2048 - dil * j : 0;
            const float4 vv = *(const float4*)(cv + (size_t)row * GW + dl4);
            acc.x += pe * vv.x; acc.y += pe * vv.y; acc.z += pe * vv.z; acc.w += pe * vv.w; }
        acc.x += __shfl_xor(acc.x, 16); acc.y += __shfl_xor(acc.y, 16); acc.z += __shfl_xor(acc.z, 16); acc.w += __shfl_xor(acc.w, 16);
        acc.x += __shfl_xor(acc.x, 32); acc.y += __shfl_xor(acc.y, 32); acc.z += __shfl_xor(acc.z, 32); acc.w += __shfl_xor(acc.w, 32);
        if (lane < 16) { const float pn = wl[64] + wl[64 + 129] + wl[64 + 258], inv = 1.f / sum;
            uint2 w; w.x = pack2((acc.x + pn * wl[512 + dl4]) * inv, (acc.y + pn * wl[512 + dl4 + 1]) * inv); w.y = pack2((acc.z + pn * wl[512 + dl4 + 2]) * inv, (acc.w + pn * wl[512 + dl4 + 3]) * inv);
            *(uint2*)(mixs + h * 64 + dl4) = w; }
    } else if (gw < 384) {
        const int n = (gw - 192) / 6, h = (gw - 192) % 6; float qkv[3];
        const float* zr = (const float*)(p.ws + WS_ZD) + (size_t)n * ZS; bf16_t* mixs = (bf16_t*)(p.ws + WS_MIXS) + (size_t)n * MIXW;
        const float* sb = p.in[I_SBCONV] + (size_t)(l * MD + n) * 3 * 1152; const float* cwb = p.in[I_CONVB] + (size_t)l * 4 * 1152;
        float* sbo = p.out + O_SBCONV + (size_t)(l * MD + n) * 3 * 1152;
#pragma unroll
        for (int which = 0; which < 3; ++which) { const int c = which * GW + h * 64 + lane; const float xn = zr[BQ + c];
            const float s0 = sb[c], s1 = sb[1152 + c], s2 = sb[2 * 1152 + c];
            qkv[which] = silu_f(s0 * cwb[c] + s1 * cwb[1152 + c] + s2 * cwb[2 * 1152 + c] + xn * cwb[3 * 1152 + c]);
            sbo[c] = s1; sbo[1152 + c] = s2; sbo[2 * 1152 + c] = xn; }
        const float q = qkv[0] * rsqrtf(wave_sum(qkv[0] * qkv[0]) + EPS) * 0.125f, k = qkv[1] * rsqrtf(wave_sum(qkv[1] * qkv[1]) + EPS), v = qkv[2];
        const float beta = 1.f / (1.f + __expf(-zr[GB + h])); const float xx = zr[GA + h] + p.in[I_DTBIAS][l * NH + h];
        const float sp = xx > 20.f ? xx : __logf(1.f + __expf(xx)); const float eg = __expf(-__expf(p.in[I_ALOG][l * NH + h]) * sp);
        const float* S0 = p.in[I_SBREC] + (size_t)((l * MD + n) * NH + h) * 4096; float* S1 = p.out + O_SBREC + (size_t)((l * MD + n) * NH + h) * 4096;
        float kS = 0.f;
#pragma unroll 16
        for (int d = 0; d < 64; ++d) kS += __shfl(k, d) * S0[d * 64 + lane];
        const float vn = beta * (v - eg * kS); float o = 0.f;
#pragma unroll 16
        for (int d = 0; d < 64; ++d) { const float sv = eg * S0[d * 64 + lane] + __shfl(k, d) * vn; S1[d * 64 + lane] = sv; o += __shfl(q, d) * sv; }
        const float r = rsqrtf(wave_sum(o * o) * (1.f / 64.f) + EPS);
        mixs[GW + h * 64 + lane] = f2bf(o * r * p.in[I_ONORMB][l * HD + lane] * silu_f(zr[BZ + h * 64 + lane]));
    } else if (gw < 576) {
        const int n = (gw - 384) / 6, h = (gw - 384) % 6; const int fi = lane & 31;
        const float* zr = (const float*)(p.ws + WS_ZD) + (size_t)n * ZS; bf16_t* mixs = (bf16_t*)(p.ws + WS_MIXS) + (size_t)n * MIXW;
        float sn, cs; sincosf(pos * ret_inv_freq(fi), &sn, &cs);
        float q = zr[CQ + h * 64 + lane], k = zr[CK + h * 64 + lane]; const float v = zr[CV + h * 64 + lane];
        { const float pr = __shfl_xor(q, 32); q = (lane < 32) ? (q * cs - pr * sn) : (q * cs + pr * sn); }
        { const float pr = __shfl_xor(k, 32); k = (lane < 32) ? (k * cs - pr * sn) : (k * cs + pr * sn); k *= 0.125f; }
        const float gam = 1.f - exp2f(-5.f - (float)h);
        const float* S0 = p.in[I_SCREC] + (size_t)((l * MD + n) * NH + h) * 4096; float* S1 = p.out + O_SCREC + (size_t)((l * MD + n) * NH + h) * 4096;
        float o = 0.f;
#pragma unroll 16
        for (int d = 0; d < 64; ++d) { const float sv = gam * S0[d * 64 + lane] + __shfl(k, d) * v; S1[d * 64 + lane] = sv; o += __shfl(q, d) * sv; }
        const float r = rsqrtf(wave_sum(o * o) * (1.f / 64.f) + EPS);
        mixs[2 * GW + h * 64 + lane] = f2bf(o * r * p.in[I_ONORMC][l * HD + lane] * silu_f(zr[CG + h * 64 + lane]));
    } else if (gw < 608) {
        const int n = gw - 576;
        const float* zr = (const float*)(p.ws + WS_ZD) + (size_t)n * ZS; bf16_t* mixs = (bf16_t*)(p.ws + WS_MIXS) + (size_t)n * MIXW;
        const float* sd = p.in[I_SDCONV] + (size_t)(l * MD + n) * 2 * GW; const float* cw = p.in[I_CONVD] + (size_t)l * 3 * GW;
        float* sdo = p.out + O_SDCONV + (size_t)(l * MD + n) * 2 * GW;
        for (int c = lane; c < GW; c += 64) { const float pr = zr[DC + c] * zr[DX + c]; const float s0 = sd[c], s1 = sd[GW + c];
            mixs[3 * GW + c] = f2bf(zr[DB + c] * (s0 * cw[c] + s1 * cw[GW + c] + pr * cw[2 * GW + c]));
            sdo[c] = s1; sdo[GW + c] = pr; }
    }
    __syncthreads();
}
DI bf16x8 packB(const f32x4& x0, const f32x4& x1) { return mk8(pack2(x0[0], x0[1]), pack2(x0[2], x0[3]), pack2(x1[0], x1[1]), pack2(x1[2], x1[3])); }
DI bf16x8 afrag(LAS unsigned char* lds, unsigned tilebase, int it, int ks, int col, int q) {
    const unsigned a = tilebase + (unsigned)(16 * it + col) * 144u + (unsigned)(32 * ks + 4 * q) * 2u;
    const u32x2 lo = *(const LAS u32x2*)(lds + a), hi = *(const LAS u32x2*)(lds + a + 32);
    return mk8(lo.x, lo.y, hi.x, hi.y);
}
template <int ROLE, class PT> DI void chain_phase(unsigned char* smem, const PT& p, int l, int nh) {
    LAS unsigned char* lds = (LAS unsigned char*)smem;
#define CH_BAR() do { asm volatile("s_waitcnt lgkmcnt(0)" ::: "memory"); __builtin_amdgcn_s_barrier(); asm volatile("" ::: "memory"); } while (0)
    const int tid = opaque_tid(), wid = tid >> 6, lane = tid & 63, col = lane & 15, q = lane >> 4, chain = wid >> 2, w = wid & 3;
    const int n = nh / NH, h = nh % NH;
    const unsigned T_W = 0u, T_KDT = chain ? 27648u : 9216u, T_UT = chain ? 36864u : 18432u;
    const float* dlb = (const float*)(p.ws + WS_DLB) + nh * 64;
    bf16_t* stp = (bf16_t*)(p.ws + (chain ? WS_STC : WS_STB)) + (size_t)nh * 64 * 4096 + (16 * w + col) * 64 + 4 * q;
    bf16_t* vnp = (bf16_t*)(p.ws + WS_VNB) + (size_t)nh * 64 * 4096 + (16 * w + col) * 64 + 4 * q;
    if (chain != ROLE) {
        constexpr int NPC = ROLE == 0 ? 6 : 4;
        const int ht = tid & 255;
        const unsigned char* src = ROLE == 0 ? p.ws + WS_BBLK + (size_t)nh * 64 * 40960 : p.ws + WS_CBLK + (size_t)nh * 64 * 32768;
        constexpr size_t CST = ROLE == 0 ? 40960 : 32768;
        u32x4 rA[NPC], rB[NPC], rC[NPC], rD[NPC];
#define CH_SRC(j) ((ROLE == 0 ? ((j) >> 1) == 0 ? 0u : ((j) >> 1) == 1 ? 8192u : 32768u : ((j) >> 1) == 0 ? 0u : 24576u) + (unsigned)(ht + 256 * ((j) & 1)) * 16u)
#define CH_DST(j) ((ROLE == 0 ? 0u : 27648u) + (unsigned)((j) >> 1) * 9216u + (unsigned)((ht + 256 * ((j) & 1)) >> 3) * 144u + (unsigned)((ht + 256 * ((j) & 1)) & 7) * 16u)
#define CH_LOAD(R, cc) do { _Pragma("unroll") for (int j = 0; j < NPC; ++j) R[j] = *(const u32x4*)(src + (size_t)(cc) * CST + CH_SRC(j)); } while (0)
#define CH_STORE(R, bo) do { _Pragma("unroll") for (int j = 0; j < NPC; ++j) *(LAS u32x4*)(lds + (bo) + CH_DST(j)) = R[j]; } while (0)
        CH_LOAD(rA, 0); CH_STORE(rA, 0u);
        CH_LOAD(rB, 1); CH_LOAD(rC, 2); CH_LOAD(rD, 3); CH_LOAD(rA, 4);
        CH_BAR();
#pragma unroll 1
        for (int c = 0; c < 64; c += 4) {
            CH_STORE(rB, 46080u); if (c + 5 < 64) CH_LOAD(rB, c + 5);
            CH_BAR();
            CH_STORE(rC, 0u); if (c + 6 < 64) CH_LOAD(rC, c + 6);
            CH_BAR();
            CH_STORE(rD, 46080u); if (c + 7 < 64) CH_LOAD(rD, c + 7);
            CH_BAR();
            if (c + 4 < 64) CH_STORE(rA, 0u);
            if (c + 8 < 64) CH_LOAD(rA, c + 8);
            CH_BAR();
        }
#undef CH_SRC
#undef CH_DST
#undef CH_LOAD
#undef CH_STORE
        return;
    }
    __builtin_amdgcn_s_setprio(3);
    const float dlv = dlb[lane];
    CH_BAR();
    f32x4 S[4];
#pragma unroll
    for (int i = 0; i < 4; ++i) S[i] = (f32x4){0.f, 0.f, 0.f, 0.f};
    auto step = [&](const int c, const unsigned bo) {
        int hi_ = h; asm volatile("" : "+v"(hi_)); const float hf = (float)hi_;
        const float dl = chain ? __expf(64.f * __logf(1.f - exp2f(-5.f - hf))) : __int_as_float(__builtin_amdgcn_readlane(__float_as_int(dlv), c));
        u32x4 sb0, sb1; sb0.x = pack2(S[0][0], S[0][1]); sb0.y = pack2(S[0][2], S[0][3]); sb0.z = pack2(S[1][0], S[1][1]); sb0.w = pack2(S[1][2], S[1][3]);
        sb1.x = pack2(S[2][0], S[2][1]); sb1.y = pack2(S[2][2], S[2][3]); sb1.z = pack2(S[3][0], S[3][1]); sb1.w = pack2(S[3][2], S[3][3]);
        { bf16_t* sp = stp + (size_t)c * 4096; u32x2 t;
          t.x = sb0.x; t.y = sb0.y; *(u32x2*)(sp) = t; t.x = sb0.z; t.y = sb0.w; *(u32x2*)(sp + 16) = t;
          t.x = sb1.x; t.y = sb1.y; *(u32x2*)(sp + 32) = t; t.x = sb1.z; t.y = sb1.w; *(u32x2*)(sp + 48) = t; }
        bf16x8 Sb[2], Vb[2]; Sb[0] = __builtin_bit_cast(bf16x8, sb0); Sb[1] = __builtin_bit_cast(bf16x8, sb1);
        bf16x8 wf[4][2], kf[4][2]; u32x2 urr[4];
#pragma unroll
        for (int it = 0; it < 4; ++it) { urr[it] = *(const LAS u32x2*)(lds + bo + T_UT + (unsigned)(16 * w + col) * 144u + (unsigned)(16 * it + 4 * q) * 2u);
#pragma unroll
            for (int ks = 0; ks < 2; ++ks) { if (ROLE == 0) wf[it][ks] = afrag(lds, bo + T_W, it, ks, col, q); kf[it][ks] = afrag(lds, bo + T_KDT, it, ks, col, q); } }
        __builtin_amdgcn_sched_barrier(0);
        f32x4 vn[4];
#pragma unroll
        for (int it = 0; it < 4; ++it) {
            const u32x2 ur = urr[it];
            f32x4 u; u[0] = bflo(ur.x); u[1] = bfhi(ur.x); u[2] = bflo(ur.y); u[3] = bfhi(ur.y);
            if (ROLE == 0) { f32x4 a = (f32x4){0.f, 0.f, 0.f, 0.f};
#pragma unroll
                for (int ks = 0; ks < 2; ++ks) a = MFMA16(wf[it][ks], Sb[ks], a);
                u = u - a; }
            vn[it] = u; }
        u32x4 vb0, vb1; vb0.x = pack2(vn[0][0], vn[0][1]); vb0.y = pack2(vn[0][2], vn[0][3]); vb0.z = pack2(vn[1][0], vn[1][1]); vb0.w = pack2(vn[1][2], vn[1][3]);
        vb1.x = pack2(vn[2][0], vn[2][1]); vb1.y = pack2(vn[2][2], vn[2][3]); vb1.z = pack2(vn[3][0], vn[3][1]); vb1.w = pack2(vn[3][2], vn[3][3]);
        if (ROLE == 0) { bf16_t* vp = vnp + (size_t)c * 4096; u32x2 t;
          t.x = vb0.x; t.y = vb0.y; *(u32x2*)(vp) = t; t.x = vb0.z; t.y = vb0.w; *(u32x2*)(vp + 16) = t;
          t.x = vb1.x; t.y = vb1.y; *(u32x2*)(vp + 32) = t; t.x = vb1.z; t.y = vb1.w; *(u32x2*)(vp + 48) = t; }
        Vb[0] = __builtin_bit_cast(bf16x8, vb0); Vb[1] = __builtin_bit_cast(bf16x8, vb1);
#pragma unroll
        for (int rt = 0; rt < 4; ++rt) { f32x4 a = S[rt] * dl;
#pragma unroll
            for (int ks = 0; ks < 2; ++ks) a = MFMA16(kf[rt][ks], Vb[ks], a);
            S[rt] = a; }
    };
#pragma unroll 1
    for (int c = 0; c < 64; c += 2) {
        step(c, 0u);
        CH_BAR();
        step(c + 1, 46080u);
        CH_BAR();
    }
    __builtin_amdgcn_s_setprio(0);
    float* so = p.out + (chain ? O_PCREC : O_PBREC) + (size_t)((l * NBAT + n) * NH + h) * 4096 + 16 * w + col;
#pragma unroll
    for (int rt = 0; rt < 4; ++rt)
#pragma unroll
        for (int i = 0; i < 4; ++i) so[(16 * rt + 4 * q + i) * 64] = S[rt][i];
}
#undef CH_BAR

struct CoRegs { bf16x8 qgf[2], qkf[2], stf[4][2], vtf[4][2]; unsigned short gt[4][4]; };
template <class PT> DI void co_load(const PT& p, int task, CoRegs& R) {
    const int tid = opaque_tid(), wid = tid >> 6, lane = tid & 63, col = lane & 15, q = lane >> 4, chain = wid >> 2, it = wid & 3;
    const int nh = task >> 6, c = task & 63, n = nh / NH, h = nh % NH;
    const bf16_t* blk = chain ? (const bf16_t*)(p.ws + WS_CBLK + (size_t)task * 32768) : (const bf16_t*)(p.ws + WS_BBLK + (size_t)task * 40960);
    const bf16_t* qg = blk + (chain ? 4096 : 8192), *qk = qg + 4096;
    const bf16_t* st = (const bf16_t*)(p.ws + (chain ? WS_STC : WS_STB)) + (size_t)task * 4096;
    const bf16_t* vt = chain ? blk + 12288 : (const bf16_t*)(p.ws + WS_VNB) + (size_t)task * 4096;
#pragma unroll
    for (int ks = 0; ks < 2; ++ks) { R.qgf[ks] = *(const bf16x8*)(qg + (16 * it + col) * 64 + 32 * ks + 8 * q); R.qkf[ks] = *(const bf16x8*)(qk + (16 * it + col) * 64 + 32 * ks + 8 * q); }
#pragma unroll
    for (int ct = 0; ct < 4; ++ct)
#pragma unroll
        for (int ks = 0; ks < 2; ++ks) { R.stf[ct][ks] = *(const bf16x8*)(st + (16 * ct + col) * 64 + 32 * ks + 8 * q); R.vtf[ct][ks] = *(const bf16x8*)(vt + (16 * ct + col) * 64 + 32 * ks + 8 * q); }
    const int tok0 = c * 64 + 16 * it + 4 * q;
    const bf16_t* gate0 = (const bf16_t*)(p.ws + WS_R1) + (size_t)(n * T_ + tok0) * ZS + (chain ? CG : BZ) + h * 64 + col;
#pragma unroll
    for (int ct = 0; ct < 4; ++ct)
#pragma unroll
        for (int i = 0; i < 4; ++i) R.gt[ct][i] = gate0[(size_t)i * ZS + 16 * ct];
}
template <class PT> DI void co_compute(const PT& p, int l, int task, const CoRegs& R) {
    const int tid = opaque_tid(), wid = tid >> 6, lane = tid & 63, col = lane & 15, q = lane >> 4, chain = wid >> 2, it = wid & 3;
    const int nh = task >> 6, c = task & 63, n = nh / NH, h = nh % NH;
    const int tok0 = c * 64 + 16 * it + 4 * q;
    f32x4 o[4]; float ss[4] = {0.f, 0.f, 0.f, 0.f};
#pragma unroll
    for (int ct = 0; ct < 4; ++ct) { f32x4 a = (f32x4){0.f, 0.f, 0.f, 0.f};
#pragma unroll
        for (int ks = 0; ks < 2; ++ks) a = MFMA16(R.qgf[ks], R.stf[ct][ks], a);
#pragma unroll
        for (int ks = 0; ks < 2; ++ks) a = MFMA16(R.qkf[ks], R.vtf[ct][ks], a);
        o[ct] = a;
#pragma unroll
        for (int i = 0; i < 4; ++i) ss[i] += a[i] * a[i]; }
    const float* onp = p.in[chain ? I_ONORMC : I_ONORMB] + l * HD + col;
    bf16_t* mix0 = (bf16_t*)(p.ws + WS_MIX) + (size_t)(n * T_ + tok0) * MIXW + (chain ? 2 * GW : GW) + h * 64 + col;
#pragma unroll
    for (int i = 0; i < 4; ++i) { float s = ss[i]; s += __shfl_xor(s, 1); s += __shfl_xor(s, 2); s += __shfl_xor(s, 4); s += __shfl_xor(s, 8);
        const float r = rsqrtf(s * (1.f / 64.f) + EPS);
#pragma unroll
        for (int ct = 0; ct < 4; ++ct) mix0[(size_t)i * MIXW + 16 * ct] = f2bf(o[ct][i] * r * onp[16 * ct] * silu_f(bf2f(R.gt[ct][i]))); }
}
template <class PT> DI void chunk_out_phase(const PT& p, int l, int first, int stride) {
    constexpr int NT = 1536;
    if (first >= NT) return;
    CoRegs A, B;
    int t = first;
    co_load(p, t, A);
    for (;;) {
        const int t1 = t + stride; co_load(p, t1 < NT ? t1 : NT - 1, B);
        __builtin_amdgcn_sched_barrier(0);
        co_compute(p, l, t, A);
        if (t1 >= NT) break;
        const int t2 = t1 + stride; co_load(p, t2 < NT ? t2 : NT - 1, A);
        __builtin_amdgcn_sched_barrier(0);
        co_compute(p, l, t1, B);
        if (t2 >= NT) break;
        t = t2;
    }
}

template <class PT> DI void attn_task(const PT& p, int task) {
    const int nh = task >> 3, tile = task & 7, n = nh / NH, h = nh % NH, T0 = tile * 512;
    const int tid = opaque_tid(), wid = tid >> 6, lane = tid & 63, r = lane & 31, hh = lane >> 5;
    const bf16_t* qa = (const bf16_t*)(p.ws + WS_QA) + (size_t)nh * T_ * HD;
    const bf16_t* ka = (const bf16_t*)(p.ws + WS_KA) + (size_t)nh * T_ * HD;
    bf16_t* opart = (bf16_t*)(p.ws + WS_OPART); float* lse = (float*)(p.ws + WS_LSE);
    for (int u = wid; u < 48; u += 8) {
        const int br = u >> 4, within = u & 15;
        const int d = br == 0 ? 1 : (br == 1 ? 4 : 16), res = br == 0 ? 0 : (br == 1 ? (within >> 2) : within), qb = br == 0 ? within : (br == 1 ? (within & 3) : 0);
        const int L = T_ / d, Iq0 = T0 / d + 32 * qb;
        const int tq = (Iq0 + r) * d + res;
        bf16x8 Qf[4], KfA[2][4], KfB[2][4];
        f32x16 sacc[5];
#pragma unroll
        for (int s = 0; s < 4; ++s) Qf[s] = *(const bf16x8*)(qa + (size_t)tq * HD + 16 * s + 8 * hh);
#define ATT_KLOAD(KF, KT0, NKT) do { _Pragma("unroll") for (int kt = 0; kt < (NKT); ++kt) { const ptrdiff_t tk = (ptrdiff_t)(Iq0 - 128 + 32 * ((KT0) + kt) + r) * d + res;   \
            _Pragma("unroll") for (int s = 0; s < 4; ++s) KF[kt][s] = *(const bf16x8*)(ka + tk * HD + 16 * s + 8 * hh); } } while (0)
#define ATT_QK(KF, KT0, NKT) do { _Pragma("unroll") for (int kt = 0; kt < (NKT); ++kt) { const bool ok = (Iq0 - 128 + 32 * ((KT0) + kt) + r) >= 0; \
            f32x16 a; for (int i = 0; i < 16; ++i) a[i] = 0.f; \
            _Pragma("unroll") for (int s = 0; s < 4; ++s) { bf16x8 kf = KF[kt][s]; if (!ok) kf = (bf16x8){0, 0, 0, 0, 0, 0, 0, 0}; a = MFMA32(kf, Qf[s], a); } \
            sacc[(KT0) + kt] = a; } } while (0)
        const bf16_t* vt = (const bf16_t*)(p.ws + WS_VT) + (size_t)br * (SZ_HEADBUF / 2) + (size_t)nh * HD * T_ + (size_t)res * L;
        u32x2 VloA[2][2][2], VhiA[2][2][2], VloB[2][2][2], VhiB[2][2][2];
        const ptrdiff_t vi0 = (ptrdiff_t)(Iq0 - 128 + 4 * hh);
#define ATT_VLOAD(VLO, VHI, KT0, NKT) do { _Pragma("unroll") for (int kt = 0; kt < (NKT); ++kt) _Pragma("unroll") for (int s = 0; s < 2; ++s) _Pragma("unroll") for (int dt = 0; dt < 2; ++dt) { \
            const bf16_t* vp = vt + (size_t)(32 * dt + r) * T_ + vi0 + 32 * ((KT0) + kt) + 16 * s; VLO[kt][s][dt] = *(const u32x2*)(vp); VHI[kt][s][dt] = *(const u32x2*)(vp + 8); } } while (0)
#define ATT_PV(VLO, VHI, KT0, NKT) do { _Pragma("unroll") for (int kt = 0; kt < (NKT); ++kt) _Pragma("unroll") for (int s = 0; s < 2; ++s) { const int kx = (KT0) + kt; \
            const bf16x8 pf = mk8(pack2(sacc[kx][8 * s], sacc[kx][8 * s + 1]), pack2(sacc[kx][8 * s + 2], sacc[kx][8 * s + 3]), pack2(sacc[kx][8 * s + 4], sacc[kx][8 * s + 5]), pack2(sacc[kx][8 * s + 6], sacc[kx][8 * s + 7])); \
            const int idx0 = Iq0 - 128 + 32 * kx + 16 * s + 4 * hh; \
            _Pragma("unroll") for (int dt = 0; dt < 2; ++dt) { u32x2 lo = VLO[kt][s][dt], hi = VHI[kt][s][dt]; \
                if (idx0 < 0) { lo.x = 0u; lo.y = 0u; } if (idx0 + 8 < 0) { hi.x = 0u; hi.y = 0u; } \
                oacc[dt] = MFMA32(mk8(lo.x, lo.y, hi.x, hi.y), pf, oacc[dt]); } } } while (0)
        ATT_KLOAD(KfA, 0, 2); ATT_KLOAD(KfB, 2, 2);
        __builtin_amdgcn_sched_barrier(0);
        ATT_QK(KfA, 0, 2);
        __builtin_amdgcn_sched_barrier(0);
        ATT_KLOAD(KfA, 4, 1);
        __builtin_amdgcn_sched_barrier(0);
        ATT_QK(KfB, 2, 2);
        __builtin_amdgcn_sched_barrier(0);
        ATT_VLOAD(VloA, VhiA, 0, 2);
        __builtin_amdgcn_sched_barrier(0);
        ATT_QK(KfA, 4, 1);
        __builtin_amdgcn_sched_barrier(0);
        ATT_VLOAD(VloB, VhiB, 2, 2);
        __builtin_amdgcn_sched_barrier(0);
        float m = -1e30f;
        int rq = r - crow(0, hh); asm volatile("" : "+v"(rq));
        const int kmin = 128 - Iq0;
#pragma unroll
        for (int kt = 0; kt < 5; ++kt)
#pragma unroll
            for (int i = 0; i < 16; ++i) { const int kc = 32 * kt + crow(i, 0); const int kk = kc + 4 * hh; const bool valid = ((unsigned)(kc - rq) <= 128u) && (kk >= kmin);
                const float s = valid ? sacc[kt][i] : -1e30f; sacc[kt][i] = s; m = fmaxf(m, s); }
        m = fmaxf(m, __shfl_xor(m, 32));
        float lsum = 0.f;
#pragma unroll
        for (int kt = 0; kt < 5; ++kt)
#pragma unroll
            for (int i = 0; i < 16; ++i) { const float pe = __expf(sacc[kt][i] - m); sacc[kt][i] = pe; lsum += pe; }
        lsum += __shfl_xor(lsum, 32);
        f32x16 oacc[2];
#pragma unroll
        for (int dt = 0; dt < 2; ++dt) for (int i = 0; i < 16; ++i) oacc[dt][i] = 0.f;
        ATT_PV(VloA, VhiA, 0, 2);
        __builtin_amdgcn_sched_barrier(0);
        ATT_VLOAD(VloA, VhiA, 4, 1);
        __builtin_amdgcn_sched_barrier(0);
        ATT_PV(VloB, VhiB, 2, 2);
        __builtin_amdgcn_sched_barrier(0);
        ATT_PV(VloA, VhiA, 4, 1);
#undef ATT_KLOAD
#undef ATT_QK
#undef ATT_VLOAD
#undef ATT_PV
        const float inv = 1.f / lsum;
        bf16_t* op = opart + ((size_t)(br * 24 + nh) * T_ + tq) * HD;
#pragma unroll
        for (int dt = 0; dt < 2; ++dt)
#pragma unroll
            for (int g = 0; g < 4; ++g) { u32x2 w; w.x = pack2(oacc[dt][4 * g] * inv, oacc[dt][4 * g + 1] * inv); w.y = pack2(oacc[dt][4 * g + 2] * inv, oacc[dt][4 * g + 3] * inv);
                *(u32x2*)(op + 32 * dt + 8 * g + 4 * hh) = w; }
        if (hh == 0) lse[(size_t)(br * 24 + nh) * T_ + tq] = m + __logf(lsum);
    }
    __syncthreads();
    for (int it = 0; it < 8; ++it) { const int item = it * 512 + tid, t = T0 + (item >> 3), seg = item & 7;
        const float l0 = lse[(size_t)(0 * 24 + nh) * T_ + t], l1 = lse[(size_t)(1 * 24 + nh) * T_ + t], l2 = lse[(size_t)(2 * 24 + nh) * T_ + t];
        const float mx = fmaxf(l0, fmaxf(l1, l2)); float w0 = __expf(l0 - mx), w1 = __expf(l1 - mx), w2 = __expf(l2 - mx); const float iv = 1.f / (w0 + w1 + w2); w0 *= iv; w1 *= iv; w2 *= iv;
        float acc[8];
#pragma unroll
        for (int e = 0; e < 8; ++e) acc[e] = 0.f;
#pragma unroll
        for (int g = 0; g < 3; ++g) { const float wg = g == 0 ? w0 : (g == 1 ? w1 : w2); float x[8]; unpack8(*(const uint4*)(opart + ((size_t)(g * 24 + nh) * T_ + t) * HD + 8 * seg), x);
#pragma unroll
            for (int e = 0; e < 8; ++e) acc[e] += wg * x[e]; }
        *(uint4*)((bf16_t*)(p.ws + WS_MIX) + (size_t)(n * T_ + t) * MIXW + h * 64 + 8 * seg) = pack8(acc); }
    __syncthreads();
}
#define XB_MAKE() XcdBarrier xb_; xb_.bar = (unsigned*)(ws + WS_BAR); xb_.x = xb_xcc_id(); xb_.st = (volatile LAS unsigned*)((LAS unsigned char*)smem + LDS_BYTES - 16)
#if defined(PROBE_DUP) && PROBE_DUP == 6
#define GSYNC() do { XB_MAKE(); xcd_barrier(xb_); xcd_barrier(xb_); } while (0)
#else
#define GSYNC() do { XB_MAKE(); xcd_barrier(xb_); } while (0)
#endif
#ifndef PROBE_DUP
#define PROBE_DUP 0
#endif
DI float rs_from_slots32(const float* p) { float s = 0.f;
#pragma unroll
    for (int i = 0; i < 32; ++i) s += p[i];
    return rsqrtf(s * (1.f / DM) + EPS); }

__global__ void __launch_bounds__(512, 2) mega_fwd(Params p) {
    extern __shared__ __attribute__((aligned(16))) unsigned char smem[];
    cg::grid_group grid = cg::this_grid();
    const int G = gridDim.x, b = blockIdx.x, tid = threadIdx.x;
    PG8_LAS unsigned char* glds = (PG8_LAS unsigned char*)smem;
    unsigned char* ws = p.ws; float* out_g = p.out;
    static_assert(sizeof(Params) <= 256, "tab");
    volatile LAS unsigned* xst = (volatile LAS unsigned*)((LAS unsigned char*)smem + LDS_BYTES - 16);
    if (tid < 4) xst[tid] = 0u;
    __syncthreads();
    (void)xcd_barrier_post((unsigned*)(p.ws + WS_BAR), xst);
    { const unsigned long long* ka = (const unsigned long long*)__builtin_amdgcn_kernarg_segment_ptr();
      if (tid < (int)(sizeof(Params) / 8)) ((unsigned long long*)(p.ws + WS_TAB))[tid] = ka[tid]; }
#ifndef NO_P0
    phase0(smem, p);
#if PROBE_DUP == 3
    phase0(smem, p);
#endif
#endif
    grid.sync();
#pragma unroll 1
    for (int l = 0; l < 2; ++l) {
        PView p; p.in.ws = ws; p.out = out_g; p.ws = ws;
#define rowss ((float*)(ws + WS_ROWSS))
#define rowssS ((float*)(ws + WS_ROWSS_S))
        { float* zd = (float*)(ws + WS_ZD); const float* rsS = rowssS + (size_t)(2 * l) * 32 * 32;
#ifndef NO_SKINNY
          for (int skrep = 0; skrep < (PROBE_DUP == 35 ? 2 : 1); ++skrep)
          skinny<DM>(smem, (const bf16_t*)(ws + WS_XSB), (const bf16_t*)(ws + WS_WT_IN + l * SZ_WT_IN), ZS / 32, G - 1 - b, G,
                 [&](int row, int col, float v, int) { zd[(size_t)row * ZS + col] = v * rs_from_slots32(rsS + row * 32); });
#endif
          pg8::Gemm g{(const bf16_t*)(ws + WS_XB), (const bf16_t*)(ws + WS_WT_IN + l * SZ_WT_IN), MP, ZS, DM}; pg8::StaticOrder S; S.init(MP, ZS, G, b);
          EpiZ<0> E{(bf16_t*)(ws + WS_R1), ZS, rowss + (size_t)(2 * l) * MP * 16};
#if !defined(NO_GEMM) && !defined(NO_G1)
          pg8::gemm_phase<EpiZ<0>, pg8::StaticOrder, false>(glds, g, S, E, nullptr);
          { const int nfull = (MP / 256) * (ZS / 256) % G;
            if (nfull > 0 && b >= nfull) { __syncthreads(); deferred_weight_tiles(smem, p, l, b - nfull, G - nfull); } else if (nfull == 0) { __syncthreads(); deferred_weight_tiles(smem, p, l, b, G); } }
#if PROBE_DUP == 31
          __syncthreads();
          pg8::gemm_phase<EpiZ<0>, pg8::StaticOrder, false>(glds, g, S, E, nullptr);
#endif
#endif
          }
        GSYNC();
        if (b < 76) {
#ifndef NO_DEC
            decode_task(smem, p, l, b);
#if PROBE_DUP == 15
            decode_task(smem, p, l, b);
#endif
#endif
        }
#if PROBE_DUP == 1
        for (int rep = 0; rep < 2; ++rep)
#endif
        for (int k = 0;; ++k) {
            int task;
            if (G >= 256) {
                if (k < 2) { if (b < 72) continue; task = k * (G - 72) + (b - 72); }
                else if (k < 4) { if (b < 24) continue; task = 2 * (G - 72) + (k - 2) * (G - 24) + (b - 24); }
                else task = 2 * (G - 72) + 2 * (G - 24) + (k - 4) * G + b;
            } else task = k * G + b;
            if (task >= 1536 * 3 + 256) break;
            const unsigned cslot = (unsigned)(l * 3071 + task);
            if (task < 3071) {
                f32x4 cv[8]; copy_slot_load(p, cslot, cv);
                if (task < 1536) chunk_prep<true>(smem, p, l, task);
                else chunk_prep<false>(smem, p, l, task - 1536);
                copy_slot_store(p, cslot, cv);
            } else {
                if (task < 1536) chunk_prep<true>(smem, p, l, task);
                else if (task < 3072) chunk_prep<false>(smem, p, l, task - 1536);
                else if (task < 4608) aprep_task(smem, p, l, task - 3072);
                else dmix_task(p, l, task - 4608);
            }
        }
        GSYNC();
        { const int nchain = 48;
          if (b < nchain) {
#ifndef NO_CHAIN
              if (b < 24) chain_phase<0>(smem, p, l, b); else chain_phase<1>(smem, p, l, b - 24);
#if PROBE_DUP == 2 || PROBE_DUP == 21
              if (b < 24) chain_phase<0>(smem, p, l, b); else chain_phase<1>(smem, p, l, b - 24);
#endif
#endif
          } else { for (int task0 = b - nchain; task0 < 192; task0 += G - nchain) {
              int task = task0;
              if (G == 256) { const int a = b - nchain, x = a & 7, j = a >> 3; if (j >= 24) break; task = (x + 8 * (j >> 3)) * 8 + (j & 7); }
#ifndef NO_ATTN
              attn_task(p, task);
#if PROBE_DUP == 2 || PROBE_DUP == 22
              attn_task(p, task);
#endif
#endif
            }
          } }
        GSYNC();
#ifndef NO_COUT
#if PROBE_DUP == 4
#pragma unroll 1
        for (int rep = 0; rep < 2; ++rep)
#endif
        chunk_out_phase(p, l, b, G);
#endif
        GSYNC();
        { const float* xsf = l == 0 ? p.in[I_XS] : (const float*)(ws + WS_XSF); float* hsf = (float*)(ws + WS_HSF); bf16_t* hsb = (bf16_t*)(ws + WS_HSB);
          float* ssS = rowssS + (size_t)(2 * l + 1) * 32 * 32;
#ifndef NO_SKINNY
          for (int skrep = 0; skrep < (PROBE_DUP == 35 ? 2 : 1); ++skrep)
          skinny<MIXW>(smem, (const bf16_t*)(ws + WS_MIXS), (const bf16_t*)(ws + WS_WT_OUT + l * SZ_WT_OUT), DM / 32, G - 1 - b, G,
                 [&](int row, int col, float v, int tile) { const float y = v + xsf[row * DM + col]; hsf[row * DM + col] = y; hsb[row * DM + col] = f2bf(y);
                     float s = y * y; s += __shfl_xor(s, 1); s += __shfl_xor(s, 2); s += __shfl_xor(s, 4); s += __shfl_xor(s, 8); s += __shfl_xor(s, 16);
                     if ((col & 31) == 0) ssS[row * 32 + tile] = s; });
#endif
          pg8::Gemm g{(const bf16_t*)(ws + WS_MIX), (const bf16_t*)(ws + WS_WT_OUT + l * SZ_WT_OUT), MP, DM, MIXW}; pg8::StaticOrder S; S.init(MP, DM, G, b);
          EpiRes E{nullptr, (const bf16_t*)(ws + WS_XB), nullptr, (bf16_t*)(ws + WS_HB), rowss + (size_t)(2 * l + 1) * MP * 16};
#if !defined(NO_GEMM) && !defined(NO_G2)
          pg8::gemm_phase<EpiRes, pg8::StaticOrder, false>(glds, g, S, E, nullptr);
#if PROBE_DUP == 32
          __syncthreads();
          pg8::gemm_phase<EpiRes, pg8::StaticOrder, false>(glds, g, S, E, nullptr);
#endif
#endif
          }
        GSYNC();
        { bf16_t* us = (bf16_t*)(ws + WS_US); const float* rsS = rowssS + (size_t)(2 * l + 1) * 32 * 32;
#ifndef NO_SKINNY
          for (int skrep = 0; skrep < (PROBE_DUP == 35 ? 2 : 1); ++skrep)
          skinny<DM>(smem, (const bf16_t*)(ws + WS_HSB), (const bf16_t*)(ws + WS_WT_UP + l * SZ_WT_UP), DFF / 32, G - 1 - b, G,
                 [&](int row, int col, float v, int) { const float y = fmaxf(v * rs_from_slots32(rsS + row * 32), 0.f); us[(size_t)row * DFF + col] = f2bf(y * y); });
#endif
          pg8::Gemm g{(const bf16_t*)(ws + WS_HB), (const bf16_t*)(ws + WS_WT_UP + l * SZ_WT_UP), MP, DFF, DM}; pg8::StaticOrder S; S.init(MP, DFF, G, b);
          EpiZ<1> E{(bf16_t*)(ws + WS_R1), DFF, rowss + (size_t)(2 * l + 1) * MP * 16};
#if !defined(NO_GEMM) && !defined(NO_G3)
          pg8::gemm_phase<EpiZ<1>, pg8::StaticOrder, false>(glds, g, S, E, nullptr);
#if PROBE_DUP == 5
          __syncthreads();
          pg8::gemm_phase<EpiZ<1>, pg8::StaticOrder, false>(glds, g, S, E, nullptr);
#endif
#endif
          }
        GSYNC();
        { const float* hsf = (const float*)(ws + WS_HSF); float* xo = l == 0 ? (float*)(ws + WS_XSF) : p.out + O_YS; bf16_t* xsb = (bf16_t*)(ws + WS_XSB);
          float* ssS = rowssS + (size_t)(2 * l + 2) * 32 * 32;
#ifndef NO_SKINNY
          for (int skrep = 0; skrep < (PROBE_DUP == 35 ? 2 : 1); ++skrep)
          skinny<DFF>(smem, (const bf16_t*)(ws + WS_US), (const bf16_t*)(ws + WS_WT_DOWN + l * SZ_WT_DOWN), DM / 32, G - 1 - b, G,
                 [&](int row, int col, float v, int tile) { const float y = v + hsf[row * DM + col]; xo[row * DM + col] = y; xsb[row * DM + col] = f2bf(y);
                     float s = y * y; s += __shfl_xor(s, 1); s += __shfl_xor(s, 2); s += __shfl_xor(s, 4); s += __shfl_xor(s, 8); s += __shfl_xor(s, 16);
                     if ((col & 31) == 0) ssS[row * 32 + tile] = s; });
#endif
          pg8::Gemm g{(const bf16_t*)(ws + WS_R1), (const bf16_t*)(ws + WS_WT_DOWN + l * SZ_WT_DOWN), MP, DM, DFF}; pg8::StaticOrder S; S.init(MP, DM, G, b);
          EpiRes E{nullptr, (const bf16_t*)(ws + WS_HB), l == 0 ? nullptr : p.out + O_YP, l == 0 ? (bf16_t*)(ws + WS_XB) : nullptr, rowss + (size_t)(2 * l + 2) * MP * 16};
#if !defined(NO_GEMM) && !defined(NO_G4)
          pg8::gemm_phase<EpiRes, pg8::StaticOrder, false>(glds, g, S, E, nullptr);
#if PROBE_DUP == 34
          __syncthreads();
          pg8::gemm_phase<EpiRes, pg8::StaticOrder, false>(glds, g, S, E, nullptr);
#endif
#endif
          }
        if (l == 0) GSYNC();
    }
}

extern "C" void kernel_launch(void* const* d_in, const int* in_sizes, int n_in, void* d_out, int out_size, void* d_ws, size_t ws_size, hipStream_t stream) {
    static int grid = 0;
    if (grid == 0) {
        if (n_in != 22 || (size_t)out_size != O_END || ws_size < WS_END) { fprintf(stderr, "kernel_launch: unexpected shapes: n_in %d out %d (want %zu) ws %zu (want %zu)\n", n_in, out_size, (size_t)O_END, ws_size, (size_t)WS_END); grid = -1; return; }
        int dev = 0, cus = 0, per_cu = 0;
        hipGetDevice(&dev); hipDeviceGetAttribute(&cus, hipDeviceAttributeMultiprocessorCount, dev);
        if (hipFuncSetAttribute((const void*)mega_fwd, hipFuncAttributeMaxDynamicSharedMemorySize, LDS_BYTES) != hipSuccess) { fprintf(stderr, "kernel_launch: hipFuncSetAttribute failed\n"); grid = -1; return; }
        if (hipOccupancyMaxActiveBlocksPerMultiprocessor(&per_cu, (const void*)mega_fwd, 512, LDS_BYTES) != hipSuccess || per_cu < 1) { fprintf(stderr, "kernel_launch: occupancy query says %d\n", per_cu); per_cu = 1; }
        (void)hipGetLastError();
        grid = cus;
    }
    if (grid < 0) return;
    if (hipMemsetAsync((char*)d_ws + WS_BAR, 0, 16384, stream) != hipSuccess) { fprintf(stderr, "kernel_launch: memset of barrier words failed\n"); return; }
    Params p{};
    for (int i = 0; i < 22; ++i) p.in[i] = (const float*)d_in[i];
    p.out = (float*)d_out; p.ws = (unsigned char*)d_ws;
    void* args[] = {&p};
    hipError_t e = hipLaunchCooperativeKernel((const void*)mega_fwd, dim3(grid), dim3(512), args, LDS_BYTES, stream);
    if (e != hipSuccess) fprintf(stderr, "cooperative launch failed: %s (grid %d)\n", hipGetErrorString(e), grid);
}
```

```cpp
#include <hip/hip_runtime.h>
#include <hip/hip_cooperative_groups.h>
#include <cstdio>
namespace cg = cooperative_groups;
namespace pg8 {
#define PG8_LAS __attribute__((address_space(3)))
typedef unsigned short bf16_t;
typedef short bf16x8 __attribute__((ext_vector_type(8)));
typedef float f32x4 __attribute__((ext_vector_type(4)));
typedef unsigned u32x4 __attribute__((ext_vector_type(4)));
constexpr int BM = 256, BK = 64, HALF = 128, HTB = HALF * BK * 2  , STAGE_BYTES = 8 * HTB, NXCD = 8, WGM = 8;

__host__ __device__ __forceinline__ int lds_byte(int r, int c) { const int st = (r >> 4) * 2 + (c >> 5), rr = r & 15, cc = c & 31, ob = rr * 64 + cc * 2; return st * 1024 + (ob ^ (((ob >> 9) & 1) << 5)); }
__host__ __device__ __forceinline__ void stage_rc(int b, int& R, int& C) { const int st = b / 1024, sb = b % 1024, swz = sb ^ (((sb >> 9) & 1) << 5); R = (st >> 1) * 16 + swz / 64; C = (st & 1) * 32 + (swz % 64) / 2; }
__host__ __device__ __forceinline__ int perm32(int rho) { const int n = rho >> 4, i = rho & 15; return 8 * (i >> 2) + 4 * n + (i & 3); }

struct Unit { int pm, pn; };
struct Gemm { const bf16_t* A; const bf16_t* Bt; int M, N, K; };

struct StaticOrder {
    int nM, nN, nwg, G, c;
    __host__ __device__ void init(int M, int N, int G_, int c_) { nM = M / BM; nN = N / BM; nwg = nM * nN; G = G_; c = c_; }
    __host__ __device__ bool next(int i, Unit& u) const {
        const long L = (long)i * G + c; if (L >= nwg) return false;
        int wgid = (int)L; { const int q = nwg / NXCD, r = nwg % NXCD, xcd = wgid % NXCD, off = wgid / NXCD; wgid = (xcd < r ? xcd * (q + 1) : r * (q + 1) + (xcd - r) * q) + off; }
        const int nig = WGM * nN, gid = wgid / nig, fm = gid * WGM, gsz = (nM - fm) < WGM ? (nM - fm) : WGM;
        u.pm = fm + ((wgid % nig) % gsz); u.pn = (wgid % nig) / gsz; return true;
    }
    __device__ __forceinline__ void a_ready(const Unit&) const {}
    __device__ __forceinline__ void done(const Unit&) const {}
};
__device__ __forceinline__ unsigned cvt_pk_bf16(float lo, float hi) { unsigned r; asm volatile("v_cvt_pk_bf16_f32 %0, %1, %2" : "=v"(r) : "v"(lo), "v"(hi)); return r; }
template <class Epi, class Sched, bool STAMP = false>
__device__ __forceinline__ void gemm_phase(PG8_LAS unsigned char* lds, const Gemm g, const Sched& S, const Epi& E, unsigned long long* stamps) {
    int tid_ = threadIdx.x; asm volatile("" : "+v"(tid_));
    const int tid = tid_, wid = __builtin_amdgcn_readfirstlane(tid >> 6), lane = tid & 63, wr = wid >> 2, wc = wid & 3, fr = lane & 15, fq = lane >> 4;
    const int K = g.K, nt = K / BK;
    int ts_lo = 0, ts_hi = 0, nts = 0; const unsigned long long rt_entry = STAMP ? (unsigned long long)wall_clock64() : 0ull;
#define PG8_STAMP() do { if (STAMP && wid == 0 && nts < 64) { const unsigned long long _c = (unsigned long long)clock64(); \
        ts_lo = (lane == nts) ? (int)(unsigned)_c : ts_lo; ts_hi = (lane == nts) ? (int)(unsigned)(_c >> 32) : ts_hi; ++nts; } } while (0)
    PG8_STAMP();
    unsigned voffA[2], voffB[2];
#pragma unroll
    for (int i = 0; i < 2; ++i) { int R, C; stage_rc(tid * 16 + i * 8192, R, C); const int Rb = Epi::PERM ? ((R & ~31) + perm32(R & 31)) : R;
        voffA[i] = (unsigned)(R * K + C) * 2u; voffB[i] = (unsigned)(Rb * K + C) * 2u; }
    const size_t kstep = (size_t)(BK * 2);
    const size_t hstep = (size_t)HALF * K * 2;
    const size_t tstep = 2 * hstep;
    const unsigned ldsw = (unsigned)wid * 1024u;
    const int aoff = lds_byte(wr * 64 + fr, fq * 8), boff = lds_byte(wc * 32 + fr, fq * 8);
#define PG8_SA(b, h) (((b) * 2 + (h)) * HTB)
#define PG8_SB(b, h) ((4 + (b) * 2 + (h)) * HTB)
#define PG8_STAGE(bufoff, gbase, voff) do { _Pragma("unroll") for (int _i = 0; _i < 2; ++_i) \
        __builtin_amdgcn_global_load_lds((const unsigned*)((const char*)(gbase) + (voff)[_i]), (PG8_LAS unsigned*)(lds + (bufoff) + ldsw + _i * 8192), 16, 0, 0); } while (0)
#define PG8_LDA(dst, b, h) do { _Pragma("unroll") for (int m = 0; m < 4; ++m) _Pragma("unroll") for (int k = 0; k < 2; ++k) dst[m][k] = *(const PG8_LAS bf16x8*)(lds + PG8_SA(b, h) + aoff + m * 2048 + k * 1024); } while (0)
#define PG8_LDB(dst, b, h) do { _Pragma("unroll") for (int n = 0; n < 2; ++n) _Pragma("unroll") for (int k = 0; k < 2; ++k) dst[n][k] = *(const PG8_LAS bf16x8*)(lds + PG8_SB(b, h) + boff + n * 2048 + k * 1024); } while (0)
#define PG8_MMA(ai, bj, At, Bt) do { __builtin_amdgcn_s_setprio(1); _Pragma("unroll") for (int m = 0; m < 4; ++m) _Pragma("unroll") for (int n = 0; n < 2; ++n) _Pragma("unroll") for (int k = 0; k < 2; ++k) \
        acc[ai][bj][m][n] = __builtin_amdgcn_mfma_f32_16x16x32_bf16(Bt[n][k], At[m][k], acc[ai][bj][m][n], 0, 0, 0); __builtin_amdgcn_s_setprio(0); } while (0)
#define PG8_WAIT_V(n) asm volatile("s_waitcnt vmcnt(" #n ")" ::: "memory")
#define PG8_WAIT_L(n) asm volatile("s_waitcnt lgkmcnt(" #n ")" ::: "memory")
#define PG8_BAR __builtin_amdgcn_s_barrier()
#define PG8_SCHED __builtin_amdgcn_sched_barrier(0)
    Unit cur, nxt; int ui = 0;
    if (!S.next(0, cur)) return;
    f32x4 acc[2][2][4][2];
#pragma unroll
    for (int a = 0; a < 2; ++a)
#pragma unroll
        for (int b = 0; b < 2; ++b)
#pragma unroll
            for (int m = 0; m < 4; ++m)
#pragma unroll
                for (int n = 0; n < 2; ++n) acc[a][b][m][n] = (f32x4){0.f, 0.f, 0.f, 0.f};
    bf16x8 At[4][2], B0[2][2], B1[2][2];
    const char* cA = (const char*)g.A + (size_t)cur.pm * tstep; const char* cB = (const char*)g.Bt + (size_t)cur.pn * tstep;
    S.a_ready(cur);
    PG8_STAGE(PG8_SB(0, 0), cB, voffB); PG8_STAGE(PG8_SA(0, 0), cA, voffA); PG8_STAGE(PG8_SB(0, 1), cB + hstep, voffB); PG8_STAGE(PG8_SA(0, 1), cA + hstep, voffA);
    if (wr == 1) PG8_BAR;
    PG8_WAIT_V(4); PG8_BAR;
    PG8_STAGE(PG8_SB(1, 0), cB + kstep, voffB); PG8_STAGE(PG8_SA(1, 0), cA + kstep, voffA); PG8_STAGE(PG8_SB(1, 1), cB + hstep + kstep, voffB);
    PG8_WAIT_V(6); PG8_BAR;
    PG8_STAMP();
    for (;;) {
        const bool has_next = S.next(ui + 1, nxt);
        const char* nA = has_next ? (const char*)g.A + (size_t)nxt.pm * tstep : cA; const char* nB = has_next ? (const char*)g.Bt + (size_t)nxt.pn * tstep : cB;
        for (int t = 0; t < nt; t += 2) {
            const bool last = (t == nt - 2);
            const char* a1 = cA + (size_t)(t + 1) * kstep;
            const char* a2 = last ? nA : cA + (size_t)(t + 2) * kstep; const char* b2 = last ? nB : cB + (size_t)(t + 2) * kstep;
            const char* a3 = a2 + kstep; const char* b3 = b2 + kstep;
            if (last && has_next) S.a_ready(nxt);
            PG8_LDB(B0, 0, 0); PG8_SCHED; PG8_LDA(At, 0, 0); PG8_STAGE(PG8_SA(1, 1), a1 + hstep, voffA);
            PG8_WAIT_L(8); PG8_BAR; PG8_WAIT_L(0); PG8_MMA(0, 0, At, B0); PG8_BAR; PG8_SCHED;
            PG8_LDB(B1, 0, 1); PG8_STAGE(PG8_SB(0, 0), b2, voffB);
            PG8_BAR; PG8_WAIT_L(0); PG8_MMA(0, 1, At, B1); PG8_BAR;
            PG8_LDA(At, 0, 1); PG8_STAGE(PG8_SA(0, 0), a2, voffA);
            PG8_BAR; PG8_WAIT_L(0); PG8_MMA(1, 0, At, B0); PG8_BAR; PG8_SCHED;
            PG8_STAGE(PG8_SB(0, 1), b2 + hstep, voffB);
            PG8_WAIT_V(6); PG8_BAR; PG8_MMA(1, 1, At, B1); PG8_BAR;
            PG8_LDB(B0, 1, 0); PG8_SCHED; PG8_LDA(At, 1, 0); PG8_STAGE(PG8_SA(0, 1), a2 + hstep, voffA);
            PG8_WAIT_L(8); PG8_BAR; PG8_WAIT_L(0); PG8_MMA(0, 0, At, B0); PG8_BAR; PG8_SCHED;
            PG8_LDB(B1, 1, 1); PG8_STAGE(PG8_SB(1, 0), b3, voffB);
            PG8_BAR; PG8_WAIT_L(0); PG8_MMA(0, 1, At, B1); PG8_BAR;
            PG8_LDA(At, 1, 1); PG8_STAGE(PG8_SA(1, 0), a3, voffA);
            PG8_BAR; PG8_WAIT_L(0); PG8_MMA(1, 0, At, B0); PG8_BAR; PG8_SCHED;
            PG8_STAGE(PG8_SB(1, 1), b3 + hstep, voffB);
            PG8_WAIT_V(6); PG8_BAR; PG8_MMA(1, 1, At, B1); PG8_BAR;
        }
        PG8_STAMP();
        if constexpr (!Epi::AFTER_DRAIN) { E(acc, cur, wr, wc, fr, fq); S.done(cur); }
        PG8_STAMP();
        if (!has_next) break;
#pragma unroll
        for (int a = 0; a < 2; ++a)
#pragma unroll
            for (int b = 0; b < 2; ++b)
#pragma unroll
                for (int m = 0; m < 4; ++m)
#pragma unroll
                    for (int n = 0; n < 2; ++n) acc[a][b][m][n] = (f32x4){0.f, 0.f, 0.f, 0.f};
        cur = nxt; cA = nA; cB = nB; ++ui;
    }
    PG8_WAIT_V(0);
    if (wr == 0) PG8_BAR;
    PG8_BAR;
    if constexpr (Epi::AFTER_DRAIN) { E.fused(acc, cur, wr, wc, fr, fq, lds, wid, lane); S.done(cur); }
    PG8_STAMP();
    if (STAMP && wid == 0) { stamps[lane] = lane < nts ? (((unsigned long long)(unsigned)ts_hi << 32) | (unsigned)ts_lo) : 0ull;
        if (lane == 62) stamps[62] = rt_entry; if (lane == 63) stamps[63] = (unsigned long long)wall_clock64(); }
#undef PG8_STAMP
#undef PG8_SA
#undef PG8_SB
#undef PG8_STAGE
#undef PG8_LDA
#undef PG8_LDB
#undef PG8_MMA
#undef PG8_WAIT_V
#undef PG8_WAIT_L
#undef PG8_BAR
#undef PG8_SCHED
}
}
using pg8::bf16_t; using pg8::bf16x8; using pg8::f32x4; using pg8::u32x4;
typedef float f32x16 __attribute__((ext_vector_type(16)));
typedef unsigned u32x2 __attribute__((ext_vector_type(2)));
#define LAS __attribute__((address_space(3)))
#define DI __device__ __forceinline__

constexpr int T_ = 4096, NBAT = 4, MP = NBAT * T_, MD = 32, DM = 1024, NH = 6, HD = 64, GW = 384, MIXW = 1536, DFF = 4096, ZS = 5632, NIN = 5388;
constexpr int AQ = 0, AK = 384, AV = 768, BQ = 1152, BKo = 1536, BV = 1920, BZ = 2304, CQ = 2688, CK = 3072, CV = 3456, CG = 3840, DX = 4224, DC = 4608, DB = 4992, GA = 5376, GB = 5382;
constexpr float EPS = 1e-6f;
constexpr int LDS_BYTES = 147456;

constexpr size_t al256(size_t x) { return (x + 255) & ~(size_t)255; }
constexpr size_t SZ_WT_IN = (size_t)ZS * DM * 2, SZ_WT_OUT = (size_t)DM * MIXW * 2, SZ_WT_UP = (size_t)DFF * DM * 2, SZ_WT_DOWN = (size_t)DM * DFF * 2;
constexpr size_t WS_WT_IN = 0;
constexpr size_t WS_WT_OUT = WS_WT_IN + 2 * SZ_WT_IN;
constexpr size_t WS_WT_UP = WS_WT_OUT + 2 * SZ_WT_OUT;
constexpr size_t WS_WT_DOWN = WS_WT_UP + 2 * SZ_WT_UP;
constexpr size_t WS_XB = WS_WT_DOWN + 2 * SZ_WT_DOWN;
constexpr size_t WS_R1 = WS_XB + (size_t)MP * DM * 2;
constexpr size_t SZ_HEADBUF = (size_t)NBAT * NH * T_ * HD * 2;
constexpr size_t WS_QA = WS_R1 + (size_t)MP * ZS * 2;
constexpr size_t WS_KA = WS_QA + SZ_HEADBUF;
constexpr size_t WS_VT = WS_KA + SZ_HEADBUF;
constexpr size_t SZ_BBLK = (size_t)NBAT * NH * 64 * 40960, SZ_CBLK = (size_t)NBAT * NH * 64 * 32768;
constexpr size_t WS_R2 = WS_VT + 3 * SZ_HEADBUF;
constexpr size_t WS_BBLK = WS_R2, WS_CBLK = WS_R2 + SZ_BBLK;
constexpr size_t WS_HF = WS_R2, WS_HB = WS_R2 + (size_t)MP * DM * 4;
static_assert((size_t)MP * DM * 6 <= SZ_BBLK + SZ_CBLK, "alias");
constexpr size_t WS_OPART = WS_R2 + SZ_BBLK + SZ_CBLK;
constexpr size_t WS_LSE = WS_OPART + (size_t)3 * 24 * T_ * 64 * 4;
constexpr size_t WS_MIX = WS_LSE + (size_t)3 * 24 * T_ * 4;
constexpr size_t WS_XF = WS_MIX + (size_t)MP * MIXW * 2;
constexpr size_t WS_ROWSS = WS_XF + (size_t)MP * DM * 4;
constexpr size_t WS_DLB = WS_ROWSS + (size_t)5 * MP * 16 * 4;
constexpr size_t WS_XSB = al256(WS_DLB + 24 * 64 * 4);
constexpr size_t WS_XSF = WS_XSB + (size_t)MD * DM * 2;
constexpr size_t WS_ZD = WS_XSF + (size_t)MD * DM * 4;
constexpr size_t WS_MIXS = WS_ZD + (size_t)MD * ZS * 4;
constexpr size_t WS_HSF = WS_MIXS + (size_t)MD * MIXW * 2;
constexpr size_t WS_HSB = WS_HSF + (size_t)MD * DM * 4;
constexpr size_t WS_US = WS_HSB + (size_t)MD * DM * 2;
constexpr size_t WS_ROWSS_S = WS_US + (size_t)MD * DFF * 2;
constexpr size_t WS_TAB = al256(WS_ROWSS_S + (size_t)5 * 32 * 32 * 4);
constexpr size_t WS_STB = WS_TAB + 256;
constexpr size_t WS_STC = WS_STB + (size_t)24 * 64 * 8192;
constexpr size_t WS_VNB = WS_STC + (size_t)24 * 64 * 8192;
constexpr size_t WS_TRIG = WS_VNB + (size_t)24 * 64 * 8192;
constexpr size_t WS_BAR = WS_TRIG + (size_t)2 * T_ * 32 * 8;
constexpr size_t WS_END = WS_BAR + 16384;

constexpr size_t O_YP = 0;
constexpr size_t O_YS = O_YP + (size_t)MP * DM;
constexpr size_t O_PAK = O_YS + (size_t)MD * DM;
constexpr size_t O_PAV = O_PAK + (size_t)2 * NBAT * 2048 * GW;
constexpr size_t O_PBCONV = O_PAV + (size_t)2 * NBAT * 2048 * GW;
constexpr size_t O_PBREC = O_PBCONV + (size_t)2 * NBAT * 3 * 1152;
constexpr size_t O_PCREC = O_PBREC + (size_t)2 * NBAT * NH * 4096;
constexpr size_t O_PDCONV = O_PCREC + (size_t)2 * NBAT * NH * 4096;
constexpr size_t O_SAK = O_PDCONV + (size_t)2 * NBAT * 2 * GW;
constexpr size_t O_SAV = O_SAK + (size_t)2 * MD * 2048 * GW;
constexpr size_t O_SBCONV = O_SAV + (size_t)2 * MD * 2048 * GW;
constexpr size_t O_SBREC = O_SBCONV + (size_t)2 * MD * 3 * 1152;
constexpr size_t O_SCREC = O_SBREC + (size_t)2 * MD * NH * 4096;
constexpr size_t O_SDCONV = O_SCREC + (size_t)2 * MD * NH * 4096;
constexpr size_t O_END = O_SDCONV + (size_t)2 * MD * 2 * GW;

struct Params { const float* in[22]; float* out; unsigned char* ws; };
template <class T> DI T* as_global(T* q) { return (T*)(__attribute__((address_space(1))) T*)q; }
struct InProxy { const unsigned char* ws; DI const float* operator[](int i) const; };
struct PView { InProxy in; float* out; unsigned char* ws; };
typedef const float __attribute__((address_space(1)))* gcfptr;
DI const float* InProxy::operator[](int i) const { return (const float*)(((const gcfptr*)(ws + WS_TAB))[i]); }
enum { I_XP = 0, I_XS, I_CAK, I_CAV, I_SBCONV, I_SBREC, I_SCREC, I_SDCONV, I_NORM_MIX, I_W_IN, I_QNORM, I_KNORM, I_CONVB, I_ALOG, I_DTBIAS, I_ONORMB, I_ONORMC, I_CONVD, I_W_OUT, I_NORM_FFN, I_W_UP, I_W_DOWN };

DI int opaque_tid() { int t = threadIdx.x; asm volatile("" : "+v"(t)); return t; }
typedef float f32x2v __attribute__((ext_vector_type(2)));
typedef __bf16 bf16x2v __attribute__((ext_vector_type(2)));
DI unsigned short f2bf(float x) { return __builtin_bit_cast(unsigned short, (__bf16)x); }
DI float bf2f(unsigned short b) { return __uint_as_float(((unsigned)b) << 16); }
DI unsigned pack2(float lo, float hi) { f32x2v v; v.x = lo; v.y = hi; return __builtin_bit_cast(unsigned, __builtin_convertvector(v, bf16x2v)); }
DI float bflo(unsigned w) { return __uint_as_float(w << 16); }
DI float bfhi(unsigned w) { return __uint_as_float(w & 0xffff0000u); }
DI void unpack8(const uint4& v, float* f) { f[0] = bflo(v.x); f[1] = bfhi(v.x); f[2] = bflo(v.y); f[3] = bfhi(v.y); f[4] = bflo(v.z); f[5] = bfhi(v.z); f[6] = bflo(v.w); f[7] = bfhi(v.w); }
DI uint4 pack8(const float* f) { uint4 v; v.x = pack2(f[0], f[1]); v.y = pack2(f[2], f[3]); v.z = pack2(f[4], f[5]); v.w = pack2(f[6], f[7]); return v; }
DI float silu_f(float x) { return x / (1.f + __expf(-x)); }
DI float wave_sum(float v) { for (int m = 32; m >= 1; m >>= 1) v += __shfl_xor(v, m); return v; }
DI float wave_max(float v) { for (int m = 32; m >= 1; m >>= 1) v = fmaxf(v, __shfl_xor(v, m)); return v; }
DI int crow(int reg, int h) { return (reg & 3) + 8 * (reg >> 2) + 4 * h; }
#define MFMA32(a, b, c) __builtin_amdgcn_mfma_f32_32x32x16_bf16((a), (b), (c), 0, 0, 0)
#define MFMA16(a, b, c) __builtin_amdgcn_mfma_f32_16x16x32_bf16((a), (b), (c), 0, 0, 0)
DI bf16x8 mk8(unsigned a, unsigned b, unsigned c, unsigned d) { u32x4 v; v.x = a; v.y = b; v.z = c; v.w = d; return __builtin_bit_cast(bf16x8, v); }
DI float rs_from_slots16(const float* p) { const float4 a = *(const float4*)p, b = *(const float4*)(p + 4), c = *(const float4*)(p + 8), d = *(const float4*)(p + 12);
    const float s = (a.x + a.y + a.z + a.w) + (b.x + b.y + b.z + b.w) + (c.x + c.y + c.z + c.w) + (d.x + d.y + d.z + d.w); return rsqrtf(s * (1.f / DM) + EPS); }

template <int ACT> struct EpiZ {
    static constexpr bool PERM = true, AFTER_DRAIN = false;
    bf16_t* O; int ldc; const float* rowss;
    DI void operator()(const f32x4 (&acc)[2][2][4][2], const pg8::Unit& u, int wr, int wc, int fr, int fq) const {
        const int row0 = u.pm * 256 + wr * 64 + fr, col0 = u.pn * 256 + wc * 32 + 8 * fq;
#pragma unroll
        for (int ai = 0; ai < 2; ++ai) {
#pragma unroll
          for (int mh = 0; mh < 2; ++mh) {
            f32x4 sl[2][4];
#pragma unroll
            for (int m2 = 0; m2 < 2; ++m2)
#pragma unroll
                for (int k = 0; k < 4; ++k) sl[m2][k] = *(const f32x4*)(rowss + (size_t)(row0 + ai * 128 + (2 * mh + m2) * 16) * 16 + 4 * k);
            __builtin_amdgcn_sched_barrier(0);
#pragma unroll
            for (int m2 = 0; m2 < 2; ++m2) { const int m = 2 * mh + m2;
                const int row = row0 + ai * 128 + m * 16;
                const f32x4 t = (sl[m2][0] + sl[m2][1]) + (sl[m2][2] + sl[m2][3]);
                const float rs = rsqrtf((t[0] + t[1] + t[2] + t[3]) * (1.f / DM) + EPS);
                bf16_t* rowp = O + (size_t)row * ldc + col0;
#pragma unroll
                for (int bj = 0; bj < 2; ++bj) {
                    f32x4 v0 = acc[ai][bj][m][0] * rs, v1 = acc[ai][bj][m][1] * rs;
                    if (ACT == 1) {
#pragma unroll
                        for (int j = 0; j < 4; ++j) { float a = fmaxf(v0[j], 0.f), b = fmaxf(v1[j], 0.f); v0[j] = a * a; v1[j] = b * b; } }
                    u32x4 w; w.x = pg8::cvt_pk_bf16(v0[0], v0[1]); w.y = pg8::cvt_pk_bf16(v0[2], v0[3]); w.z = pg8::cvt_pk_bf16(v1[0], v1[1]); w.w = pg8::cvt_pk_bf16(v1[2], v1[3]);
                    *(u32x4*)(rowp + bj * 128) = w; } } } }
    }
};
struct EpiRes {
    static constexpr bool PERM = false, AFTER_DRAIN = false;
    const float* resid_f; const bf16_t* resid_b; float* outf; bf16_t* outb; float* ssout;
    DI void operator()(const f32x4 (&acc)[2][2][4][2], const pg8::Unit& u, int wr, int wc, int fr, int fq) const {
        const int row0 = u.pm * 256 + wr * 64 + fr, col0 = u.pn * 256 + wc * 32 + 4 * fq;
#pragma unroll
        for (int ai = 0; ai < 2; ++ai)
#pragma unroll
          for (int mh = 0; mh < 2; ++mh) {
            f32x4 rv[2][2][2];
            if (resid_f) {
#pragma unroll
                for (int m2 = 0; m2 < 2; ++m2)
#pragma unroll
                    for (int bj = 0; bj < 2; ++bj)
#pragma unroll
                        for (int n = 0; n < 2; ++n) rv[m2][bj][n] = *(const f32x4*)(resid_f + (size_t)(row0 + ai * 128 + (2 * mh + m2) * 16) * DM + col0 + bj * 128 + n * 16);
            } else {
                u32x2 rb[2][2][2];
#pragma unroll
                for (int m2 = 0; m2 < 2; ++m2)
#pragma unroll
                    for (int bj = 0; bj < 2; ++bj)
#pragma unroll
                        for (int n = 0; n < 2; ++n) rb[m2][bj][n] = *(const u32x2*)(resid_b + (size_t)(row0 + ai * 128 + (2 * mh + m2) * 16) * DM + col0 + bj * 128 + n * 16);
#pragma unroll
                for (int m2 = 0; m2 < 2; ++m2)
#pragma unroll
                    for (int bj = 0; bj < 2; ++bj)
#pragma unroll
                        for (int n = 0; n < 2; ++n) { const u32x2 w = rb[m2][bj][n]; rv[m2][bj][n] = (f32x4){bflo(w.x), bfhi(w.x), bflo(w.y), bfhi(w.y)}; }
            }
            __builtin_amdgcn_sched_barrier(0);
#pragma unroll
            for (int m2 = 0; m2 < 2; ++m2) { const int m = 2 * mh + m2;
                const int row = row0 + ai * 128 + m * 16; float ss = 0.f;
#pragma unroll
                for (int bj = 0; bj < 2; ++bj)
#pragma unroll
                    for (int n = 0; n < 2; ++n) {
                        const size_t o = (size_t)row * DM + col0 + bj * 128 + n * 16;
                        const f32x4 v = acc[ai][bj][m][n] + rv[m2][bj][n];
                        if (outf) *(f32x4*)(outf + o) = v;
                        if (outb) { uint2 w; w.x = pg8::cvt_pk_bf16(v[0], v[1]); w.y = pg8::cvt_pk_bf16(v[2], v[3]);
                            *(uint2*)(outb + o) = w; }
                        ss += v[0] * v[0] + v[1] * v[1] + v[2] * v[2] + v[3] * v[3]; }
                if (outb) { ss += __shfl_xor(ss, 16); ss += __shfl_xor(ss, 32);
                    if (fq == 0) ssout[(size_t)row * 16 + u.pn * 4 + wc] = ss; } } }
    }
};

template <int K, class F> DI void skinny(unsigned char* smem, const bf16_t* A, const bf16_t* Bt, int ntiles, int first, int stride, F f) {
    float* red = (float*)smem;
    const int tid = opaque_tid(), wid = tid >> 6, lane = tid & 63, r = lane & 31, h = lane >> 5;
    constexpr int kw = K >> 3, NS = kw / 16, BS = NS <= 12 ? NS : 8;
    static_assert(NS % BS == 0, "batch");
    for (int tile = first; tile < ntiles; tile += stride) {
        f32x16 acc; for (int i = 0; i < 16; ++i) acc[i] = 0.f;
        const bf16_t* ap = A + (size_t)r * K + wid * kw + 8 * h;
        const bf16_t* bp = Bt + (size_t)(tile * 32 + r) * K + wid * kw + 8 * h;
#pragma unroll 1
        for (int k = 0; k < kw; k += 16 * BS) { bf16x8 av[BS], bv[BS];
#pragma unroll
            for (int j = 0; j < BS; ++j) { av[j] = *(const bf16x8*)(ap + k + 16 * j); bv[j] = *(const bf16x8*)(bp + k + 16 * j); }
            __builtin_amdgcn_sched_barrier(0);
#pragma unroll
            for (int j = 0; j < BS; ++j) acc = MFMA32(av[j], bv[j], acc); }
#pragma unroll
        for (int i = 0; i < 16; ++i) red[wid * 1024 + crow(i, h) * 32 + r] = acc[i];
        __syncthreads();
        for (int o = tid; o < 1024; o += 512) { float s = 0.f;
#pragma unroll
            for (int w = 0; w < 8; ++w) s += red[w * 1024 + o];
            f(o >> 5, tile * 32 + (o & 31), s, tile); }
        __syncthreads();
    }
}
#define XB_TMO      128
#define XB_XCNT(j)  (256  + 64 * (j))
#define XB_XSUB(j)  (1280 + 64 * (j))
#define XB_XGEN(j)  (2304 + 64 * (j))
#define XB_TOP      3328
#define XB_TOPGEN   3392
#define XCD_BAR_WORDS 3456
#define XB_SPIN_CAP (1u << 18)

__device__ __forceinline__ unsigned xb_ld(unsigned* p)              { return __hip_atomic_load(p, __ATOMIC_RELAXED, __HIP_MEMORY_SCOPE_AGENT); }
__device__ __forceinline__ unsigned xb_add(unsigned* p, unsigned v) { return __hip_atomic_fetch_add(p, v, __ATOMIC_RELAXED, __HIP_MEMORY_SCOPE_AGENT); }
__device__ __forceinline__ unsigned xb_xcc_id() { return (unsigned)__builtin_amdgcn_s_getreg((3 << 11) | 20) & 0xFu; }
#define XB_SPIN(cond, bar) do { unsigned _sp = 0; while (cond) { __builtin_amdgcn_s_sleep(1); \
    if ((++_sp & 255u) == 0u) { if (xb_ld(&(bar)[XB_TMO])) break; if (_sp > XB_SPIN_CAP) { atomicAdd(&(bar)[XB_TMO], 1u); break; } } } } while (0)

struct XcdBarrier {
    unsigned* bar; unsigned x;
    volatile LAS unsigned* st;
};

__device__ __forceinline__ XcdBarrier xcd_barrier_post(unsigned* bar, volatile LAS unsigned* st) {
    XcdBarrier b; b.bar = bar; b.x = xb_xcc_id(); b.st = st;
    if (threadIdx.x == 0) (void)xb_add(&bar[XB_XCNT(b.x)], 1u);
    return b;
}
__device__ __forceinline__ void xcd_barrier_complete(unsigned* bar, unsigned x, unsigned& nloc, unsigned& nx) {
    const unsigned G = gridDim.x * gridDim.y * gridDim.z;
    unsigned sum, cnt, mine, sp = 0u;
    for (;;) {
        sum = 0u; cnt = 0u; mine = 0u;
#pragma unroll
        for (unsigned j = 0; j < 16; ++j) { const unsigned c = xb_ld(&bar[XB_XCNT(j)]); sum += c; cnt += (c > 0u) ? 1u : 0u; mine = (j == x) ? c : mine; }
        if (sum == G) break;
        __builtin_amdgcn_s_sleep(1);
        if ((++sp & 255u) == 0u) { if (xb_ld(&bar[XB_TMO])) break; if (sp > XB_SPIN_CAP) { atomicAdd(&bar[XB_TMO], 1u); break; } }
    }
    nloc = mine > 0u ? mine : 1u; nx = cnt > 0u ? cnt : 1u;
}

__device__ __forceinline__ void xcd_barrier(const XcdBarrier& b) {
    asm volatile("s_waitcnt vmcnt(0)" ::: "memory");
    __syncthreads();
    if (threadIdx.x == 0) {
        unsigned* bar = b.bar;
        __builtin_amdgcn_s_waitcnt(0);
        unsigned nloc = b.st[0], nx = b.st[1];
        if (nloc == 0u) { xcd_barrier_complete(bar, b.x, nloc, nx); b.st[0] = nloc; b.st[1] = nx; }
        const unsigned old = xb_add(&bar[XB_XSUB(b.x)], 1u);
        const unsigned gen = old / nloc;
        if (old + 1u == (gen + 1u) * nloc) {
            __builtin_amdgcn_fence(__ATOMIC_RELEASE, "agent");
            asm volatile("s_waitcnt vmcnt(0)" ::: "memory");
            const unsigned og = xb_add(&bar[XB_TOP], 1u);
            const unsigned tg = og / nx;
            if (og + 1u == (tg + 1u) * nx) xb_add(&bar[XB_TOPGEN], 1u);
            else XB_SPIN(xb_ld(&bar[XB_TOPGEN]) == tg, bar);
            __builtin_amdgcn_fence(__ATOMIC_ACQUIRE, "agent");
            xb_add(&bar[XB_XGEN(b.x)], 1u);
            asm volatile("s_waitcnt vmcnt(0)" ::: "memory");
        } else {
            XB_SPIN(xb_ld(&bar[XB_XGEN(b.x)]) == gen, bar);
            __builtin_amdgcn_fence(__ATOMIC_ACQUIRE, "agent");
            asm volatile("s_waitcnt vmcnt(0)" ::: "memory");
        }
    }
    __syncthreads();
}
DI void transpose_tile(float* tl, const float* W, int ldw, int k0, int nsrc0, int nvalid, const float* gain, bf16_t* Bt, int K, int ndst0) {
    const int tid = opaque_tid(), col = tid & 63, rb = tid >> 6;
    float v[32];
#pragma unroll
    for (int i = 0; i < 32; ++i) { const int kk = rb + 8 * i; v[i] = (col < nvalid) ? W[(size_t)(k0 + kk) * ldw + nsrc0 + col] : 0.f; }
#pragma unroll
    for (int i = 0; i < 32; ++i) { const int kk = rb + 8 * i; tl[kk * 65 + col] = gain ? v[i] * gain[k0 + kk] : v[i]; }
    __syncthreads();
    { const int n = tid >> 3, ks = (tid & 7) * 32;
#pragma unroll
      for (int g = 0; g < 4; ++g) { float f[8];
#pragma unroll
          for (int j = 0; j < 8; ++j) f[j] = tl[(ks + 8 * g + j) * 65 + n];
          *(uint4*)(Bt + (size_t)(ndst0 + n) * K + k0 + ks + 8 * g) = pack8(f); } }
    __syncthreads();
}

DI float rope_inv_freq(int fi) { return exp2f(-(float)(2 * fi) * (13.287712379549449f / 64.f)); }
DI float ret_inv_freq(int fi) { return exp2f(-(float)fi * (13.287712379549449f / 31.f)); }
template <class PT> DI void copy_cache(const PT& p, unsigned first, unsigned stride) {
    const unsigned per = 2047u * GW / 4, tot = per * 64 * 2;
    for (unsigned i0 = first; i0 < tot; i0 += 8 * stride) {
        f32x4 v[8]; f32x4* dp[8];
#pragma unroll
        for (int k = 0; k < 8; ++k) { const unsigned i = i0 + k * stride; dp[k] = nullptr;
            if (i < tot) { const unsigned which = i / (per * 64), rem = i % (per * 64); const size_t ln = rem / per, off = rem % per;
                const f32x4* src = (const f32x4*)(p.in[which ? I_CAV : I_CAK] + ln * 2048 * GW + GW) + off;
                dp[k] = (f32x4*)(p.out + (which ? O_SAV : O_SAK) + ln * 2048 * GW) + off;
                v[k] = __builtin_nontemporal_load(src); } }
#pragma unroll
        for (int k = 0; k < 8; ++k) if (dp[k]) __builtin_nontemporal_store(v[k], dp[k]); }
}
DI unsigned copy_idx(unsigned slot, int k, unsigned tid) { const unsigned tot = (2047u * GW / 4) * 128u; const unsigned i = slot * 4096u + (unsigned)k * 512u + tid; return i < tot ? i : tot - 1u; }
template <class PT> DI void copy_slot_load(const PT& p, unsigned slot, f32x4 (&v)[8]) {
    const unsigned per = 2047u * GW / 4, tid = (unsigned)opaque_tid();
#pragma unroll
    for (int k = 0; k < 8; ++k) { const unsigned i = copy_idx(slot, k, tid), which = i / (per * 64), rem = i % (per * 64); const size_t ln = rem / per, off = rem % per;
        v[k] = __builtin_nontemporal_load((const f32x4*)(p.in[which ? I_CAV : I_CAK] + ln * 2048 * GW + GW) + off); }
}
template <class PT> DI void copy_slot_store(const PT& p, unsigned slot, const f32x4 (&v)[8]) {
    const unsigned per = 2047u * GW / 4, tid = (unsigned)opaque_tid();
#pragma unroll
    for (int k = 0; k < 8; ++k) { const unsigned i = copy_idx(slot, k, tid), which = i / (per * 64), rem = i % (per * 64); const size_t ln = rem / per, off = rem % per;
        __builtin_nontemporal_store(v[k], (f32x4*)(p.out + (which ? O_SAV : O_SAK) + ln * 2048 * GW) + off); }
}
template <class PT> DI void weight_tile(float* tl, const PT& p, int l, int t) {
    if (t < 352) { const int kt = t / 88, nt = t % 88, nd = nt * 64; int ns, nv;
        if (nd < 2688) { ns = nd; nv = 64; } else if (nd < 5376) { ns = nd + 12; nv = 64; } else if (nd == 5376) { ns = 2688; nv = 12; } else { ns = 0; nv = 0; }
        transpose_tile(tl, p.in[I_W_IN] + (size_t)l * DM * NIN, NIN, kt * 256, ns, nv, p.in[I_NORM_MIX] + l * DM, (bf16_t*)(p.ws + WS_WT_IN + l * SZ_WT_IN), DM, nd); }
    else if (t < 352 + 96) { t -= 352; const int kt = t / 16, nt = t % 16;
        transpose_tile(tl, p.in[I_W_OUT] + (size_t)l * MIXW * DM, DM, kt * 256, nt * 64, 64, (const float*)nullptr, (bf16_t*)(p.ws + WS_WT_OUT + l * SZ_WT_OUT), MIXW, nt * 64); }
    else if (t < 352 + 96 + 256) { t -= 352 + 96; const int kt = t / 64, nt = t % 64;
        transpose_tile(tl, p.in[I_W_UP] + (size_t)l * DM * DFF, DFF, kt * 256, nt * 64, 64, p.in[I_NORM_FFN] + l * DM, (bf16_t*)(p.ws + WS_WT_UP + l * SZ_WT_UP), DM, nt * 64); }
    else { t -= 352 + 96 + 256; const int kt = t / 16, nt = t % 16;
        transpose_tile(tl, p.in[I_W_DOWN] + (size_t)l * DFF * DM, DM, kt * 256, nt * 64, 64, (const float*)nullptr, (bf16_t*)(p.ws + WS_WT_DOWN + l * SZ_WT_DOWN), DFF, nt * 64); }
}
template <class PT> DI void deferred_weight_tiles(unsigned char* smem, const PT& p, int list, int first, int stride) {
    float* tl = (float*)smem; const int n = list == 2 ? 352 : 608;
    for (int i = first; i < n; i += stride) { if (list == 0) weight_tile(tl, p, 0, 352 + i); else if (list == 1) weight_tile(tl, p, 1, 352 + i); else weight_tile(tl, p, 1, i); }
}
template <class PT> DI void phase0(unsigned char* smem, const PT& p) {
    const int G = gridDim.x, b = blockIdx.x, tid = opaque_tid(), wid = tid >> 6, lane = tid & 63;
    float* tl = (float*)smem;
    for (int task = b; task < 352; task += G) weight_tile(tl, p, 0, task);
    for (int row = b * 8 + wid; row < MP + MD; row += G * 8) {
        const bool dec = row >= MP; const int r = dec ? row - MP : row;
        const float* src = dec ? p.in[I_XS] + (size_t)r * DM : p.in[I_XP] + (size_t)r * DM;
        bf16_t* dst = dec ? (bf16_t*)(p.ws + WS_XSB) + (size_t)r * DM : (bf16_t*)(p.ws + WS_XB) + (size_t)r * DM;
        float ss = 0.f;
#pragma unroll
        for (int i = 0; i < 4; ++i) { const float4 v = *(const float4*)(src + i * 256 + lane * 4); ss += v.x * v.x + v.y * v.y + v.z * v.z + v.w * v.w;
            uint2 w; w.x = pack2(v.x, v.y); w.y = pack2(v.z, v.w); *(uint2*)(dst + i * 256 + lane * 4) = w; }
        ss = wave_sum(ss);
        if (dec) { float* s = (float*)(p.ws + WS_ROWSS_S) + (size_t)r * 32; if (lane < 32) s[lane] = lane == 0 ? ss : 0.f; }
        else { float* s = (float*)(p.ws + WS_ROWSS) + (size_t)r * 16; if (lane < 16) s[lane] = lane == 0 ? ss : 0.f; }
    }
    for (int i = b * 512 + tid; i < 2 * T_ * 32; i += G * 512) { const int which = i / (T_ * 32), t = (i / 32) % T_, fi = i & 31;
        float sn, cs; sincosf((float)t * (which ? ret_inv_freq(fi) : rope_inv_freq(fi)), &sn, &cs);
        ((float2*)(p.ws + WS_TRIG))[i] = make_float2(cs, sn); }
#ifdef COPY_IN_P0
    copy_cache(p, (unsigned)b * 512 + tid, (unsigned)G * 512);
#endif
}

template <class PT> DI void aprep_task(unsigned char* smem, const PT& p, int l, int task) {
    const int n = task / (NH * 64), h = (task / 64) % NH, tile = task % 64;
    const int tid = opaque_tid(), i = tid >> 3, seg = tid & 7, t = tile * 64 + i;
    const bf16_t* zrow = (const bf16_t*)(p.ws + WS_R1) + (size_t)(n * T_ + t) * ZS;
    const size_t hoff = ((size_t)(n * NH + h) * T_ + t) * HD + 8 * seg;
    const uint4 rawq = *(const uint4*)(zrow + AQ + h * 64 + 8 * seg), rawk = *(const uint4*)(zrow + AK + h * 64 + 8 * seg), rawv = *(const uint4*)(zrow + AV + h * 64 + 8 * seg);
    float gq[8], gk[8];
    { const float* g0 = p.in[I_QNORM] + l * HD + 8 * seg; const float* g1 = p.in[I_KNORM] + l * HD + 8 * seg;
#pragma unroll
      for (int j = 0; j < 8; ++j) { gq[j] = g0[j]; gk[j] = g1[j]; } }
    float cs[8], sn[8];
    { const float4* tp = (const float4*)((const float2*)(p.ws + WS_TRIG) + (size_t)t * 32 + ((8 * seg) & 31));
#pragma unroll
      for (int j = 0; j < 4; ++j) { const float4 v = tp[j]; cs[2 * j] = v.x; sn[2 * j] = v.y; cs[2 * j + 1] = v.z; sn[2 * j + 1] = v.w; } }
#pragma unroll
    for (int which = 0; which < 2; ++which) {
        float x[8]; unpack8(which ? rawk : rawq, x);
        float ss = 0.f;
#pragma unroll
        for (int j = 0; j < 8; ++j) ss += x[j] * x[j];
        ss += __shfl_xor(ss, 1); ss += __shfl_xor(ss, 2); ss += __shfl_xor(ss, 4);
        const float r = rsqrtf(ss * (1.f / 64.f) + EPS);
        float y[8], o[8];
#pragma unroll
        for (int j = 0; j < 8; ++j) y[j] = x[j] * r * (which ? gk[j] : gq[j]);
#pragma unroll
        for (int j = 0; j < 8; ++j) { const float pr = __shfl_xor(y[j], 4); o[j] = (seg < 4) ? (y[j] * cs[j] - pr * sn[j]) : (y[j] * cs[j] + pr * sn[j]); }
        if (which == 0) {
#pragma unroll
            for (int j = 0; j < 8; ++j) o[j] *= 0.125f;
            *(uint4*)((bf16_t*)(p.ws + WS_QA) + hoff) = pack8(o);
        } else {
            *(uint4*)((bf16_t*)(p.ws + WS_KA) + hoff) = pack8(o);
            if (t >= T_ - 2048) { float* d = p.out + O_PAK + (((size_t)(l * NBAT + n) * 2048 + (t - (T_ - 2048))) * NH + h) * HD + 8 * seg;
                *(float4*)d = make_float4(o[0], o[1], o[2], o[3]); *(float4*)(d + 4) = make_float4(o[4], o[5], o[6], o[7]); }
        }
    }
    unsigned short* vt = (unsigned short*)smem;
    { float x[8]; unpack8(rawv, x);
      if (t >= T_ - 2048) { float* d = p.out + O_PAV + (((size_t)(l * NBAT + n) * 2048 + (t - (T_ - 2048))) * NH + h) * HD + 8 * seg;
          *(float4*)d = make_float4(x[0], x[1], x[2], x[3]); *(float4*)(d + 4) = make_float4(x[4], x[5], x[6], x[7]); }
#pragma unroll
      for (int j = 0; j < 8; ++j) vt[i * 66 + 8 * seg + j] = f2bf(x[j]); }
    __syncthreads();
    { const int dim = tid >> 3, ts = tid & 7; unsigned short e[8];
#pragma unroll
      for (int j = 0; j < 8; ++j) e[j] = vt[(8 * ts + j) * 66 + dim];
      const int tb = tile * 64 + 8 * ts;
      bf16_t* base = (bf16_t*)(p.ws + WS_VT) + ((size_t)(n * NH + h) * HD + dim) * T_;
      uint4 w; w.x = e[0] | ((unsigned)e[1] << 16); w.y = e[2] | ((unsigned)e[3] << 16); w.z = e[4] | ((unsigned)e[5] << 16); w.w = e[6] | ((unsigned)e[7] << 16);
      *(uint4*)(base + tb) = w;
      bf16_t* b4 = base + SZ_HEADBUF / 2;
#pragma unroll
      for (int rr = 0; rr < 4; ++rr) *(unsigned*)(b4 + rr * 1024 + tb / 4) = e[rr] | ((unsigned)e[rr + 4] << 16);
      bf16_t* b16 = base + SZ_HEADBUF;
#pragma unroll
      for (int j = 0; j < 8; ++j) b16[(8 * (ts & 1) + j) * 256 + tb / 16] = e[j]; }
    __syncthreads();
}

template <class PT> DI void dmix_task(const PT& p, int l, int task) {
    const int n = task / 64, tile = task % 64, tid = opaque_tid();
    const bf16_t* zb = (const bf16_t*)(p.ws + WS_R1) + (size_t)n * T_ * ZS;
    const float* cw = p.in[I_CONVD] + (size_t)l * 3 * GW;
    for (int item = tid; item < 64 * 48; item += 512) {
        const int i = item / 48, cg8 = (item % 48) * 8, t = tile * 64 + i;
        float prod[3][8];
#pragma unroll
        for (int j = 0; j < 3; ++j) { const int tt = t - 2 + j;
            if (tt >= 0) { float a[8], c[8]; unpack8(*(const uint4*)(zb + (size_t)tt * ZS + DX + cg8), a); unpack8(*(const uint4*)(zb + (size_t)tt * ZS + DC + cg8), c);
#pragma unroll
                for (int e = 0; e < 8; ++e) prod[j][e] = a[e] * c[e]; }
            else {
#pragma unroll
                for (int e = 0; e < 8; ++e) prod[j][e] = 0.f; } }
        float bb[8], o[8]; unpack8(*(const uint4*)(zb + (size_t)t * ZS + DB + cg8), bb);
#pragma unroll
        for (int e = 0; e < 8; ++e) o[e] = bb[e] * (prod[0][e] * cw[cg8 + e] + prod[1][e] * cw[GW + cg8 + e] + prod[2][e] * cw[2 * GW + cg8 + e]);
        *(uint4*)((bf16_t*)(p.ws + WS_MIX) + (size_t)(n * T_ + t) * MIXW + 3 * GW + cg8) = pack8(o);
        if (t >= T_ - 2) { float* d = p.out + O_PDCONV + ((size_t)(l * NBAT + n) * 2 + (t - (T_ - 2))) * GW + cg8;
#pragma unroll
            for (int e = 0; e < 8; ++e) d[e] = prod[2][e]; }
    }
    if (tile == 63) for (int item = tid; item < 3 * 1152; item += 512) { const int rr = item / 1152, c = item % 1152;
        p.out[O_PBCONV + ((size_t)(l * NBAT + n) * 3 + rr) * 1152 + c] = bf2f(zb[(size_t)(T_ - 3 + rr) * ZS + BQ + c]); }
}

template <bool IS_B, class PT> DI void chunk_prep(unsigned char* smem, const PT& p, int l, int task) {
    const int nh = task / 64, ch = task % 64, n = nh / NH, h = nh % NH;
    float* qs = (float*)smem; float* ks = qs + 64 * 68; float* vs = ks + 64 * 68; float* As = vs + 64 * 68; float* Gs = As + 4096; float* betas = Gs + 64; float* graw = betas + 64;
    const int tid = opaque_tid(), i = tid >> 3, seg = tid & 7, t = ch * 64 + i;
    const bf16_t* zrow = (const bf16_t*)(p.ws + WS_R1) + (size_t)(n * T_ + t) * ZS;
    bf16_t* blk = IS_B ? (bf16_t*)(p.ws + WS_BBLK + (size_t)task * 40960) : (bf16_t*)(p.ws + WS_CBLK + (size_t)task * 32768);
    bf16_t* o_w = blk; bf16_t* o_kdt = IS_B ? blk + 4096 : blk; bf16_t* o_qg = o_kdt + 4096; bf16_t* o_qk = o_qg + 4096; bf16_t* o_ut = o_qk + 4096;
    const float lg = IS_B ? 0.f : __logf(1.f - exp2f(-5.f - (float)h));
    if (IS_B) {
        const float* cwb = p.in[I_CONVB] + (size_t)l * 4 * 1152;
        float res[3][8];
        uint4 zr[3][4];
#pragma unroll
        for (int which = 0; which < 3; ++which)
#pragma unroll
            for (int j = 0; j < 4; ++j) { const int back = (t - 3 + j >= 0) ? (j - 3) : 0;
                zr[which][j] = *(const uint4*)(zrow + (ptrdiff_t)back * ZS + BQ + which * GW + h * 64 + 8 * seg); }
#pragma unroll
        for (int which = 0; which < 3; ++which) {
            float a[8];
#pragma unroll
            for (int e = 0; e < 8; ++e) a[e] = 0.f;
            const int co = which * GW + h * 64 + 8 * seg;
            float4 w0[4], w1[4];
#pragma unroll
            for (int j = 0; j < 4; ++j) { w0[j] = *(const float4*)(cwb + j * 1152 + co); w1[j] = *(const float4*)(cwb + j * 1152 + co + 4); }
#pragma unroll
            for (int j = 0; j < 4; ++j) { const float mk = (t - 3 + j >= 0) ? 1.f : 0.f; float x[8]; unpack8(zr[which][j], x);
                a[0] += mk * x[0] * w0[j].x; a[1] += mk * x[1] * w0[j].y; a[2] += mk * x[2] * w0[j].z; a[3] += mk * x[3] * w0[j].w;
                a[4] += mk * x[4] * w1[j].x; a[5] += mk * x[5] * w1[j].y; a[6] += mk * x[6] * w1[j].z; a[7] += mk * x[7] * w1[j].w; }
#pragma unroll
            for (int e = 0; e < 8; ++e) a[e] = silu_f(a[e]);
            if (which < 2) { float ss = 0.f;
#pragma unroll
                for (int e = 0; e < 8; ++e) ss += a[e] * a[e];
                ss += __shfl_xor(ss, 1); ss += __shfl_xor(ss, 2); ss += __shfl_xor(ss, 4);
                const float r = rsqrtf(ss + EPS) * (which == 0 ? 0.125f : 1.f);
#pragma unroll
                for (int e = 0; e < 8; ++e) a[e] *= r; }
#pragma unroll
            for (int e = 0; e < 8; ++e) res[which][e] = a[e];
        }
        float gA = 0.f, gB = 0.f;
        if (seg == 0) { const float za = bf2f(zrow[GA + h]), zb = bf2f(zrow[GB + h]);
            const float xx = za + p.in[I_DTBIAS][l * NH + h]; const float sp = xx > 20.f ? xx : __logf(1.f + __expf(xx));
            gA = -__expf(p.in[I_ALOG][l * NH + h]) * sp; gB = 1.f / (1.f + __expf(-zb)); }
#pragma unroll
        for (int which = 0; which < 3; ++which) { float* dst = (which == 0 ? qs : which == 1 ? ks : vs) + i * 68 + 8 * seg;
            *(float4*)dst = make_float4(res[which][0], res[which][1], res[which][2], res[which][3]); *(float4*)(dst + 4) = make_float4(res[which][4], res[which][5], res[which][6], res[which][7]); }
        if (seg == 0) { graw[i] = gA; betas[i] = gB; }
        __syncthreads();
        if (tid < 64) { float v = graw[tid];
#pragma unroll
            for (int off = 1; off < 64; off <<= 1) { const float u = __shfl_up(v, off); if (tid >= off) v += u; }
            Gs[tid] = v; }
        __syncthreads();
    } else {
        const uint4 rawq = *(const uint4*)(zrow + CQ + h * 64 + 8 * seg), rawk = *(const uint4*)(zrow + CK + h * 64 + 8 * seg), rawv = *(const uint4*)(zrow + CV + h * 64 + 8 * seg);
        float cs[8], sn[8];
        { const float4* tp = (const float4*)((const float2*)(p.ws + WS_TRIG) + (size_t)(T_ + t) * 32 + ((8 * seg) & 31));
#pragma unroll
          for (int j = 0; j < 4; ++j) { const float4 v = tp[j]; cs[2 * j] = v.x; sn[2 * j] = v.y; cs[2 * j + 1] = v.z; sn[2 * j + 1] = v.w; } }
#pragma unroll
        for (int which = 0; which < 2; ++which) {
            float y[8], o[8]; unpack8(which ? rawk : rawq, y);
#pragma unroll
            for (int j = 0; j < 8; ++j) { const float pr = __shfl_xor(y[j], 4); o[j] = (seg < 4) ? (y[j] * cs[j] - pr * sn[j]) : (y[j] * cs[j] + pr * sn[j]); if (which) o[j] *= 0.125f; }
            float* dst = (which ? ks : qs) + i * 68 + 8 * seg;
            *(float4*)dst = make_float4(o[0], o[1], o[2], o[3]); *(float4*)(dst + 4) = make_float4(o[4], o[5], o[6], o[7]);
        }
        { float x[8]; unpack8(rawv, x); float* dst = vs + i * 68 + 8 * seg;
          *(float4*)dst = make_float4(x[0], x[1], x[2], x[3]); *(float4*)(dst + 4) = make_float4(x[4], x[5], x[6], x[7]); }
        if (tid < 64) Gs[tid] = (float)(tid + 1) * lg;
        __syncthreads();
    }
    { unsigned short* QH = (unsigned short*)(graw + 64 + 8192); unsigned short* KH = QH + 64 * 72; unsigned short* KL = KH + 64 * 72;
      { float a[8], b8[8];
        { const float4 x0 = *(const float4*)(qs + i * 68 + 8 * seg), x1 = *(const float4*)(qs + i * 68 + 8 * seg + 4); a[0] = x0.x; a[1] = x0.y; a[2] = x0.z; a[3] = x0.w; a[4] = x1.x; a[5] = x1.y; a[6] = x1.z; a[7] = x1.w; }
        *(uint4*)(QH + i * 72 + 8 * seg) = pack8(a);
        { const float4 x0 = *(const float4*)(ks + i * 68 + 8 * seg), x1 = *(const float4*)(ks + i * 68 + 8 * seg + 4); a[0] = x0.x; a[1] = x0.y; a[2] = x0.z; a[3] = x0.w; a[4] = x1.x; a[5] = x1.y; a[6] = x1.z; a[7] = x1.w; }
        const uint4 kh = pack8(a); *(uint4*)(KH + i * 72 + 8 * seg) = kh;
        if (IS_B) { float hf[8]; unpack8(kh, hf);
#pragma unroll
            for (int e = 0; e < 8; ++e) b8[e] = a[e] - hf[e];
            *(uint4*)(KL + i * 72 + 8 * seg) = pack8(b8); } }
      __syncthreads();
      const int wid = tid >> 6, lane = tid & 63, col = lane & 15, quad = lane >> 4, it = wid >> 1;
      bf16x8 qa[2], ka[2], la[2];
#pragma unroll
      for (int ksx = 0; ksx < 2; ++ksx) { qa[ksx] = *(const bf16x8*)(QH + (16 * it + col) * 72 + 32 * ksx + 8 * quad); ka[ksx] = *(const bf16x8*)(KH + (16 * it + col) * 72 + 32 * ksx + 8 * quad);
          if (IS_B) la[ksx] = *(const bf16x8*)(KL + (16 * it + col) * 72 + 32 * ksx + 8 * quad); }
#pragma unroll
      for (int jj = 0; jj < 2; ++jj) { const int jt = (wid & 1) * 2 + jj;
          f32x4 aqk = (f32x4){0.f, 0.f, 0.f, 0.f}, akk = (f32x4){0.f, 0.f, 0.f, 0.f};
#pragma unroll
          for (int ksx = 0; ksx < 2; ++ksx) { const bf16x8 kb = *(const bf16x8*)(KH + (16 * jt + col) * 72 + 32 * ksx + 8 * quad);
              aqk = MFMA16(qa[ksx], kb, aqk);
              if (IS_B) { const bf16x8 lb = *(const bf16x8*)(KL + (16 * jt + col) * 72 + 32 * ksx + 8 * quad);
                  akk = MFMA16(ka[ksx], kb, akk); akk = MFMA16(ka[ksx], lb, akk); akk = MFMA16(la[ksx], kb, akk); } }
          const int j = 16 * jt + col; const float Gj = Gs[j];
          const float4 g4 = *(const float4*)(Gs + 16 * it + 4 * quad); const float gi[4] = {g4.x, g4.y, g4.z, g4.w};
          float bt[4] = {0.f, 0.f, 0.f, 0.f};
          if (IS_B) { const float4 b4 = *(const float4*)(betas + 16 * it + 4 * quad); bt[0] = b4.x; bt[1] = b4.y; bt[2] = b4.z; bt[3] = b4.w; }
#pragma unroll
          for (int r = 0; r < 4; ++r) { const int ii = 16 * it + 4 * quad + r; const float ex = __expf(fminf(gi[r] - Gj, 0.f)); const float dec = (ii >= j) ? ex : 0.f;
              o_qk[ii * 64 + j] = f2bf(aqk[r] * dec);
              if (IS_B) As[ii * 64 + j] = (ii > j) ? bt[r] * akk[r] * dec : 0.f; } } }
    { const float eg = __expf(Gs[i]); float o[8];
#pragma unroll
      for (int e = 0; e < 8; ++e) o[e] = qs[i * 68 + 8 * seg + e] * eg;
      *(uint4*)(o_qg + i * 64 + 8 * seg) = pack8(o);
      const int d = i; const float G63 = Gs[63];
#pragma unroll
      for (int e = 0; e < 8; ++e) { const int j = 8 * seg + e; o[e] = ks[j * 68 + d] * __expf(G63 - Gs[j]); }
      *(uint4*)(o_kdt + d * 64 + 8 * seg) = pack8(o);
      if (!IS_B) {
#pragma unroll
          for (int e = 0; e < 8; ++e) o[e] = vs[(8 * seg + e) * 68 + d];
          *(uint4*)(o_ut + d * 64 + 8 * seg) = pack8(o); }
      if (IS_B && tid == 0) ((float*)(p.ws + WS_DLB))[task] = __expf(G63); }
    __syncthreads();
    if (IS_B) {
        float* Xs = graw + 64;
        float* TMP = Xs + 8192 + 6912;
        float* Ti = TMP + 2048;
        { const int c = tid & 127, pt = tid >> 7;
#pragma unroll 4
          for (int k = 0; k < 16; ++k) { const int i2 = pt * 16 + k;
              Xs[i2 * 128 + c] = (c < 64) ? betas[i2] * vs[i2 * 68 + c] : betas[i2] * __expf(Gs[i2]) * ks[i2 * 68 + (c - 64)]; } }
        if (tid < 64) { const int bb = tid >> 4, c = tid & 15; float t[16];
#pragma unroll
            for (int i2 = 0; i2 < 16; ++i2) { float sx = (i2 == c) ? 1.f : 0.f;
#pragma unroll
                for (int j = 0; j < i2; ++j) sx -= As[(16 * bb + i2) * 64 + 16 * bb + j] * t[j];
                t[i2] = sx; }
#pragma unroll
            for (int i2 = 0; i2 < 16; ++i2) Ti[bb * 256 + i2 * 16 + c] = t[i2]; }
        __syncthreads();
#pragma unroll 1
        for (int rb = 0; rb < 4; ++rb) {
            const int c = tid & 127, pt = tid >> 7, r0 = 16 * rb + 4 * pt;
            { float a0 = 0.f, a1 = 0.f, a2 = 0.f, a3 = 0.f;
#pragma unroll 4
              for (int j = 0; j < 16 * rb; ++j) { const float x = Xs[j * 128 + c];
                  a0 += As[(r0 + 0) * 64 + j] * x; a1 += As[(r0 + 1) * 64 + j] * x; a2 += As[(r0 + 2) * 64 + j] * x; a3 += As[(r0 + 3) * 64 + j] * x; }
              TMP[(4 * pt + 0) * 128 + c] = Xs[(r0 + 0) * 128 + c] - a0; TMP[(4 * pt + 1) * 128 + c] = Xs[(r0 + 1) * 128 + c] - a1;
              TMP[(4 * pt + 2) * 128 + c] = Xs[(r0 + 2) * 128 + c] - a2; TMP[(4 * pt + 3) * 128 + c] = Xs[(r0 + 3) * 128 + c] - a3; }
            __syncthreads();
            { float o0 = 0.f, o1 = 0.f, o2 = 0.f, o3 = 0.f; const float* tr = Ti + rb * 256 + (4 * pt) * 16;
#pragma unroll
              for (int j = 0; j < 16; ++j) { const float x = TMP[j * 128 + c];
                  o0 += tr[j] * x; o1 += tr[16 + j] * x; o2 += tr[32 + j] * x; o3 += tr[48 + j] * x; }
              Xs[(r0 + 0) * 128 + c] = o0; Xs[(r0 + 1) * 128 + c] = o1; Xs[(r0 + 2) * 128 + c] = o2; Xs[(r0 + 3) * 128 + c] = o3; }
            __syncthreads();
        }
        { const int e = tid >> 3, g = tid & 7; float o[8];
#pragma unroll
          for (int k = 0; k < 8; ++k) o[k] = Xs[(8 * g + k) * 128 + e];
          *(uint4*)(o_ut + e * 64 + 8 * g) = pack8(o);
#pragma unroll
          for (int k = 0; k < 8; ++k) o[k] = Xs[e * 128 + 64 + 8 * g + k];
          *(uint4*)(o_w + e * 64 + 8 * g) = pack8(o); }
    }
    __syncthreads();
}
template <class PT> DI void decode_task(unsigned char* smem, const PT& p, int l, int bt) {
    const int tid = opaque_tid(), wid = tid >> 6, lane = tid & 63;
    float* wl = (float*)smem + wid * 576;
    const int gw = bt * 8 + wid;
    const float pos = 16384.f;
    if (gw < 192) {
        const int n = gw / 6, h = gw % 6; const int fi = lane & 31;
        const float* zr = (const float*)(p.ws + WS_ZD) + (size_t)n * ZS; bf16_t* mixs = (bf16_t*)(p.ws + WS_MIXS) + (size_t)n * MIXW;
        float sn, cs; sincosf(pos * rope_inv_freq(fi), &sn, &cs);
        float q = zr[AQ + h * 64 + lane], k = zr[AK + h * 64 + lane]; const float v = zr[AV + h * 64 + lane];
        { const float r = rsqrtf(wave_sum(q * q) * (1.f / 64.f) + EPS); q = q * r * p.in[I_QNORM][l * HD + lane];
          const float pr = __shfl_xor(q, 32); q = (lane < 32) ? (q * cs - pr * sn) : (q * cs + pr * sn); q *= 0.125f; }
        { const float r = rsqrtf(wave_sum(k * k) * (1.f / 64.f) + EPS); k = k * r * p.in[I_KNORM][l * HD + lane];
          const float pr = __shfl_xor(k, 32); k = (lane < 32) ? (k * cs - pr * sn) : (k * cs + pr * sn); }
        p.out[O_SAK + (((size_t)(l * MD + n) * 2048 + 2047) * NH + h) * HD + lane] = k;
        p.out[O_SAV + (((size_t)(l * MD + n) * 2048 + 2047) * NH + h) * HD + lane] = v;
        wl[lane] = q; wl[512 + lane] = v;
        const float snew = wave_sum(q * k);
        const float* ck = p.in[I_CAK] + (size_t)(l * MD + n) * 2048 * GW + h * HD;
        const float* cv = p.in[I_CAV] + (size_t)(l * MD + n) * 2048 * GW + h * HD;
        float mx = snew;
#pragma unroll 1
        for (int it = 0; it < 7; ++it) { const int e = it * 64 + lane; float s = -1e30f;
            if (e < 387) { const int br = e / 129, j = e % 129; const int dil = br == 0 ? 1 : (br == 1 ? 4 : 16);
                if (j == 0) s = snew; else { const float* kr = ck + (size_t)(2048 - dil * j) * GW; float4 kv[16];
#pragma unroll
                    for (int d4 = 0; d4 < 16; ++d4) kv[d4] = *(const float4*)(kr + 4 * d4);
                    float a = 0.f;
#pragma unroll
                    for (int d4 = 0; d4 < 16; ++d4) a += kv[d4].x * wl[4 * d4] + kv[d4].y * wl[4 * d4 + 1] + kv[d4].z * wl[4 * d4 + 2] + kv[d4].w * wl[4 * d4 + 3];
                    s = a; } }
            wl[64 + e] = s; mx = fmaxf(mx, s); }
        mx = wave_max(mx); float sum = 0.f;
#pragma unroll 1
        for (int it = 0; it < 7; ++it) { const int e = it * 64 + lane; const float pe = (e < 387) ? __expf(wl[64 + e] - mx) : 0.f; sum += pe; wl[64 + e] = pe; }
        sum = wave_sum(sum);
        const int g = lane >> 4, dl4 = (lane & 15) * 4;
        float4 acc = make_float4(0.f, 0.f, 0.f, 0.f);
#pragma unroll 8
        for (int it = 0; it < 97; ++it) { const int e = 4 * it + g; const int ee = e < 387 ? e : 386; const int br = ee / 129, j = ee % 129; const int dil = br == 0 ? 1 : (br == 1 ? 4 : 16);
            const float pe = (e < 387 && j != 0) ? wl[64 + ee] : 0.f; const int row = j != 0 ? 2048 - dil * j : 0;
            const float4 vv = *(const float4*)(cv + (size_t)row * GW + dl4);
            acc.x += pe * vv.x; acc.y += pe * vv.y; acc.z += pe * vv.z; acc.w += pe * vv.w; }
        acc.x += __shfl_xor(acc.x, 16); acc.y += __shfl_xor(acc.y, 16); acc.z += __shfl_xor(acc.z, 16); acc.w += __shfl_xor(acc.w, 16);
        acc.x += __shfl_xor(acc.x, 32); acc.y += __shfl_xor(acc.y, 32); acc.z += __shfl_xor(acc.z, 32); acc.w += __shfl_xor(acc.w, 32);
        if (lane < 16) { const float pn = wl[64] + wl[64 + 129] + wl[64 + 258], inv = 1.f / sum;
            uint2 w; w.x = pack2((acc.x + pn * wl[512 + dl4]) * inv, (acc.y + pn * wl[512 + dl4 + 1]) * inv); w.y = pack2((acc.z + pn * wl[512 + dl4 + 2]) * inv, (acc.w + pn * wl[512 + dl4 + 3]) * inv);
            *(uint2*)(mixs + h * 64 + dl4) = w; }
    } else if (gw < 384) {
        const int n = (gw - 192) / 6, h = (gw - 192) % 6; float qkv[3];
        const float* zr = (const float*)(p.ws + WS_ZD) + (size_t)n * ZS; bf16_t* mixs = (bf16_t*)(p.ws + WS_MIXS) + (size_t)n * MIXW;
        const float* sb = p.in[I_SBCONV] + (size_t)(l * MD + n) * 3 * 1152; const float* cwb = p.in[I_CONVB] + (size_t)l * 4 * 1152;
        float* sbo = p.out + O_SBCONV + (size_t)(l * MD + n) * 3 * 1152;
#pragma unroll
        for (int which = 0; which < 3; ++which) { const int c = which * GW + h * 64 + lane; const float xn = zr[BQ + c];
            const float s0 = sb[c], s1 = sb[1152 + c], s2 = sb[2 * 1152 + c];
            qkv[which] = silu_f(s0 * cwb[c] + s1 * cwb[1152 + c] + s2 * cwb[2 * 1152 + c] + xn * cwb[3 * 1152 + c]);
            sbo[c] = s1; sbo[1152 + c] = s2; sbo[2 * 1152 + c] = xn; }
        const float q = qkv[0] * rsqrtf(wave_sum(qkv[0] * qkv[0]) + EPS) * 0.125f, k = qkv[1] * rsqrtf(wave_sum(qkv[1] * qkv[1]) + EPS), v = qkv[2];
        const float beta = 1.f / (1.f + __expf(-zr[GB + h])); const float xx = zr[GA + h] + p.in[I_DTBIAS][l * NH + h];
        const float sp = xx > 20.f ? xx : __logf(1.f + __expf(xx)); const float eg = __expf(-__expf(p.in[I_ALOG][l * NH + h]) * sp);
        const float* S0 = p.in[I_SBREC] + (size_t)((l * MD + n) * NH + h) * 4096; float* S1 = p.out + O_SBREC + (size_t)((l * MD + n) * NH + h) * 4096;
        float kS = 0.f;
#pragma unroll 16
        for (int d = 0; d < 64; ++d) kS += __shfl(k, d) * S0[d * 64 + lane];
        const float vn = beta * (v - eg * kS); float o = 0.f;
#pragma unroll 16
        for (int d = 0; d < 64; ++d) { const float sv = eg * S0[d * 64 + lane] + __shfl(k, d) * vn; S1[d * 64 + lane] = sv; o += __shfl(q, d) * sv; }
        const float r = rsqrtf(wave_sum(o * o) * (1.f / 64.f) + EPS);
        mixs[GW + h * 64 + lane] = f2bf(o * r * p.in[I_ONORMB][l * HD + lane] * silu_f(zr[BZ + h * 64 + lane]));
    } else if (gw < 576) {
        const int n = (gw - 384) / 6, h = (gw - 384) % 6; const int fi = lane & 31;
        const float* zr = (const float*)(p.ws + WS_ZD) + (size_t)n * ZS; bf16_t* mixs = (bf16_t*)(p.ws + WS_MIXS) + (size_t)n * MIXW;
        float sn, cs; sincosf(pos * ret_inv_freq(fi), &sn, &cs);
        float q = zr[CQ + h * 64 + lane], k = zr[CK + h * 64 + lane]; const float v = zr[CV + h * 64 + lane];
        { const float pr = __shfl_xor(q, 32); q = (lane < 32) ? (q * cs - pr * sn) : (q * cs + pr * sn); }
        { const float pr = __shfl_xor(k, 32); k = (lane < 32) ? (k * cs - pr * sn) : (k * cs + pr * sn); k *= 0.125f; }
        const float gam = 1.f - exp2f(-5.f - (float)h);
        const float* S0 = p.in[I_SCREC] + (size_t)((l * MD + n) * NH + h) * 4096; float* S1 = p.out + O_SCREC + (size_t)((l * MD + n) * NH + h) * 4096;
        float o = 0.f;
#pragma unroll 16
        for (int d = 0; d < 64; ++d) { const float sv = gam * S0[d * 64 + lane] + __shfl(k, d) * v; S1[d * 64 + lane] = sv; o += __shfl(q, d) * sv; }
        const float r = rsqrtf(wave_sum(o * o) * (1.f / 64.f) + EPS);
        mixs[2 * GW + h * 64 + lane] = f2bf(o * r * p.in[I_ONORMC][l * HD + lane] * silu_f(zr[CG + h * 64 + lane]));
    } else if (gw < 608) {
        const int n = gw - 576;
        const float* zr = (const float*)(p.ws + WS_ZD) + (size_t)n * ZS; bf16_t* mixs = (bf16_t*)(p.ws + WS_MIXS) + (size_t)n * MIXW;
        const float* sd = p.in[I_SDCONV] + (size_t)(l * MD + n) * 2 * GW; const float* cw = p.in[I_CONVD] + (size_t)l * 3 * GW;
        float* sdo = p.out + O_SDCONV + (size_t)(l * MD + n) * 2 * GW;
        for (int c = lane; c < GW; c += 64) { const float pr = zr[DC + c] * zr[DX + c]; const float s0 = sd[c], s1 = sd[GW + c];
            mixs[3 * GW + c] = f2bf(zr[DB + c] * (s0 * cw[c] + s1 * cw[GW + c] + pr * cw[2 * GW + c]));
            sdo[c] = s1; sdo[GW + c] = pr; }
    }
    __syncthreads();
}
DI bf16x8 packB(const f32x4& x0, const f32x4& x1) { return mk8(pack2(x0[0], x0[1]), pack2(x0[2], x0[3]), pack2(x1[0], x1[1]), pack2(x1[2], x1[3])); }
DI bf16x8 afrag(LAS unsigned char* lds, unsigned tilebase, int it, int ks, int col, int q) {
    const unsigned a = tilebase + (unsigned)(16 * it + col) * 144u + (unsigned)(32 * ks + 4 * q) * 2u;
    const u32x2 lo = *(const LAS u32x2*)(lds + a), hi = *(const LAS u32x2*)(lds + a + 32);
    return mk8(lo.x, lo.y, hi.x, hi.y);
}
template <int ROLE, class PT> DI void chain_phase(unsigned char* smem, const PT& p, int l, int nh) {
    LAS unsigned char* lds = (LAS unsigned char*)smem;
    const int tid = opaque_tid(), wid = tid >> 6, lane = tid & 63, col = lane & 15, q = lane >> 4, chain = wid >> 2, w = wid & 3;
    const int n = nh / NH, h = nh % NH;
    const unsigned T_W = 0u, T_KDT = chain ? 27648u : 9216u, T_UT = chain ? 36864u : 18432u;
    const float* dlb = (const float*)(p.ws + WS_DLB) + nh * 64;
    bf16_t* stp = (bf16_t*)(p.ws + (chain ? WS_STC : WS_STB)) + (size_t)nh * 64 * 4096 + (16 * w + col) * 64 + 4 * q;
    bf16_t* vnp = (bf16_t*)(p.ws + WS_VNB) + (size_t)nh * 64 * 4096 + (16 * w + col) * 64 + 4 * q;
    if (chain != ROLE) {
        constexpr int NPC = ROLE == 0 ? 6 : 4;
        const int ht = tid & 255;
        const unsigned char* src = ROLE == 0 ? p.ws + WS_BBLK + (size_t)nh * 64 * 40960 : p.ws + WS_CBLK + (size_t)nh * 64 * 32768;
        constexpr size_t CST = ROLE == 0 ? 40960 : 32768;
        u32x4 rA[NPC], rB[NPC], rC[NPC], rD[NPC];
#define CH_SRC(j) ((ROLE == 0 ? ((j) >> 1) == 0 ? 0u : ((j) >> 1) == 1 ? 8192u : 32768u : ((j) >> 1) == 0 ? 0u : 24576u) + (unsigned)(ht + 256 * ((j) & 1)) * 16u)
#define CH_DST(j) ((ROLE == 0 ? 0u : 27648u) + (unsigned)((j) >> 1) * 9216u + (unsigned)((ht + 256 * ((j) & 1)) >> 3) * 144u + (unsigned)((ht + 256 * ((j) & 1)) & 7) * 16u)
#define CH_LOAD(R, cc) do { _Pragma("unroll") for (int j = 0; j < NPC; ++j) R[j] = *(const u32x4*)(src + (size_t)(cc) * CST + CH_SRC(j)); } while (0)
#define CH_STORE(R, bo) do { _Pragma("unroll") for (int j = 0; j < NPC; ++j) *(LAS u32x4*)(lds + (bo) + CH_DST(j)) = R[j]; } while (0)
        CH_LOAD(rA, 0); CH_STORE(rA, 0u);
        CH_LOAD(rB, 1); CH_LOAD(rC, 2); CH_LOAD(rD, 3); CH_LOAD(rA, 4);
        __syncthreads();
#pragma unroll 1
        for (int c = 0; c < 64; c += 4) {
            CH_STORE(rB, 46080u); if (c + 5 < 64) CH_LOAD(rB, c + 5);
            __syncthreads();
            CH_STORE(rC, 0u); if (c + 6 < 64) CH_LOAD(rC, c + 6);
            __syncthreads();
            CH_STORE(rD, 46080u); if (c + 7 < 64) CH_LOAD(rD, c + 7);
            __syncthreads();
            if (c + 4 < 64) CH_STORE(rA, 0u);
            if (c + 8 < 64) CH_LOAD(rA, c + 8);
            __syncthreads();
        }
#undef CH_SRC
#undef CH_DST
#undef CH_LOAD
#undef CH_STORE
        return;
    }
    __builtin_amdgcn_s_setprio(3);
    const float dlv = dlb[lane];
    __syncthreads();
    f32x4 S[4];
#pragma unroll
    for (int i = 0; i < 4; ++i) S[i] = (f32x4){0.f, 0.f, 0.f, 0.f};
    auto step = [&](const int c, const unsigned bo) {
        int hi_ = h; asm volatile("" : "+v"(hi_)); const float hf = (float)hi_;
        const float dl = chain ? __expf(64.f * __logf(1.f - exp2f(-5.f - hf))) : __int_as_float(__builtin_amdgcn_readlane(__float_as_int(dlv), c));
        u32x4 sb0, sb1; sb0.x = pack2(S[0][0], S[0][1]); sb0.y = pack2(S[0][2], S[0][3]); sb0.z = pack2(S[1][0], S[1][1]); sb0.w = pack2(S[1][2], S[1][3]);
        sb1.x = pack2(S[2][0], S[2][1]); sb1.y = pack2(S[2][2], S[2][3]); sb1.z = pack2(S[3][0], S[3][1]); sb1.w = pack2(S[3][2], S[3][3]);
        { bf16_t* sp = stp + (size_t)c * 4096; u32x2 t;
          t.x = sb0.x; t.y = sb0.y; *(u32x2*)(sp) = t; t.x = sb0.z; t.y = sb0.w; *(u32x2*)(sp + 16) = t;
          t.x = sb1.x; t.y = sb1.y; *(u32x2*)(sp + 32) = t; t.x = sb1.z; t.y = sb1.w; *(u32x2*)(sp + 48) = t; }
        bf16x8 Sb[2], Vb[2]; Sb[0] = __builtin_bit_cast(bf16x8, sb0); Sb[1] = __builtin_bit_cast(bf16x8, sb1);
        bf16x8 wf[4][2], kf[4][2]; u32x2 urr[4];
#pragma unroll
        for (int it = 0; it < 4; ++it) { urr[it] = *(const LAS u32x2*)(lds + bo + T_UT + (unsigned)(16 * w + col) * 144u + (unsigned)(16 * it + 4 * q) * 2u);
#pragma unroll
            for (int ks = 0; ks < 2; ++ks) { if (ROLE == 0) wf[it][ks] = afrag(lds, bo + T_W, it, ks, col, q); kf[it][ks] = afrag(lds, bo + T_KDT, it, ks, col, q); } }
        __builtin_amdgcn_sched_barrier(0);
        f32x4 vn[4];
#pragma unroll
        for (int it = 0; it < 4; ++it) {
            const u32x2 ur = urr[it];
            f32x4 u; u[0] = bflo(ur.x); u[1] = bfhi(ur.x); u[2] = bflo(ur.y); u[3] = bfhi(ur.y);
            if (ROLE == 0) { f32x4 a = (f32x4){0.f, 0.f, 0.f, 0.f};
#pragma unroll
                for (int ks = 0; ks < 2; ++ks) a = MFMA16(wf[it][ks], Sb[ks], a);
                u = u - a; }
            vn[it] = u; }
        u32x4 vb0, vb1; vb0.x = pack2(vn[0][0], vn[0][1]); vb0.y = pack2(vn[0][2], vn[0][3]); vb0.z = pack2(vn[1][0], vn[1][1]); vb0.w = pack2(vn[1][2], vn[1][3]);
        vb1.x = pack2(vn[2][0], vn[2][1]); vb1.y = pack2(vn[2][2], vn[2][3]); vb1.z = pack2(vn[3][0], vn[3][1]); vb1.w = pack2(vn[3][2], vn[3][3]);
        if (ROLE == 0) { bf16_t* vp = vnp + (size_t)c * 4096; u32x2 t;
          t.x = vb0.x; t.y = vb0.y; *(u32x2*)(vp) = t; t.x = vb0.z; t.y = vb0.w; *(u32x2*)(vp + 16) = t;
          t.x = vb1.x; t.y = vb1.y; *(u32x2*)(vp + 32) = t; t.x = vb1.z; t.y = vb1.w; *(u32x2*)(vp + 48) = t; }
        Vb[0] = __builtin_bit_cast(bf16x8, vb0); Vb[1] = __builtin_bit_cast(bf16x8, vb1);
#pragma unroll
        for (int rt = 0; rt < 4; ++rt) { f32x4 a = S[rt] * dl;
#pragma unroll
            for (int ks = 0; ks < 2; ++ks) a = MFMA16(kf[rt][ks], Vb[ks], a);
            S[rt] = a; }
    };
#pragma unroll 1
    for (int c = 0; c < 64; c += 2) {
        step(c, 0u);
        __syncthreads();
        step(c + 1, 46080u);
        __syncthreads();
    }
    __builtin_amdgcn_s_setprio(0);
    float* so = p.out + (chain ? O_PCREC : O_PBREC) + (size_t)((l * NBAT + n) * NH + h) * 4096 + 16 * w + col;
#pragma unroll
    for (int rt = 0; rt < 4; ++rt)
#pragma unroll
        for (int i = 0; i < 4; ++i) so[(16 * rt + 4 * q + i) * 64] = S[rt][i];
}

struct CoRegs { bf16x8 qgf[2], qkf[2], stf[4][2], vtf[4][2]; unsigned short gt[4][4]; };
template <class PT> DI void co_load(const PT& p, int task, CoRegs& R) {
    const int tid = opaque_tid(), wid = tid >> 6, lane = tid & 63, col = lane & 15, q = lane >> 4, chain = wid >> 2, it = wid & 3;
    const int nh = task >> 6, c = task & 63, n = nh / NH, h = nh % NH;
    const bf16_t* blk = chain ? (const bf16_t*)(p.ws + WS_CBLK + (size_t)task * 32768) : (const bf16_t*)(p.ws + WS_BBLK + (size_t)task * 40960);
    const bf16_t* qg = blk + (chain ? 4096 : 8192), *qk = qg + 4096;
    const bf16_t* st = (const bf16_t*)(p.ws + (chain ? WS_STC : WS_STB)) + (size_t)task * 4096;
    const bf16_t* vt = chain ? blk + 12288 : (const bf16_t*)(p.ws + WS_VNB) + (size_t)task * 4096;
#pragma unroll
    for (int ks = 0; ks < 2; ++ks) { R.qgf[ks] = *(const bf16x8*)(qg + (16 * it + col) * 64 + 32 * ks + 8 * q); R.qkf[ks] = *(const bf16x8*)(qk + (16 * it + col) * 64 + 32 * ks + 8 * q); }
#pragma unroll
    for (int ct = 0; ct < 4; ++ct)
#pragma unroll
        for (int ks = 0; ks < 2; ++ks) { R.stf[ct][ks] = *(const bf16x8*)(st + (16 * ct + col) * 64 + 32 * ks + 8 * q); R.vtf[ct][ks] = *(const bf16x8*)(vt + (16 * ct + col) * 64 + 32 * ks + 8 * q); }
    const int tok0 = c * 64 + 16 * it + 4 * q;
    const bf16_t* gate0 = (const bf16_t*)(p.ws + WS_R1) + (size_t)(n * T_ + tok0) * ZS + (chain ? CG : BZ) + h * 64 + col;
#pragma unroll
    for (int ct = 0; ct < 4; ++ct)
#pragma unroll
        for (int i = 0; i < 4; ++i) R.gt[ct][i] = gate0[(size_t)i * ZS + 16 * ct];
}
template <class PT> DI void co_compute(const PT& p, int l, int task, const CoRegs& R) {
    const int tid = opaque_tid(), wid = tid >> 6, lane = tid & 63, col = lane & 15, q = lane >> 4, chain = wid >> 2, it = wid & 3;
    const int nh = task >> 6, c = task & 63, n = nh / NH, h = nh % NH;
    const int tok0 = c * 64 + 16 * it + 4 * q;
    f32x4 o[4]; float ss[4] = {0.f, 0.f, 0.f, 0.f};
#pragma unroll
    for (int ct = 0; ct < 4; ++ct) { f32x4 a = (f32x4){0.f, 0.f, 0.f, 0.f};
#pragma unroll
        for (int ks = 0; ks < 2; ++ks) a = MFMA16(R.qgf[ks], R.stf[ct][ks], a);
#pragma unroll
        for (int ks = 0; ks < 2; ++ks) a = MFMA16(R.qkf[ks], R.vtf[ct][ks], a);
        o[ct] = a;
#pragma unroll
        for (int i = 0; i < 4; ++i) ss[i] += a[i] * a[i]; }
    const float* onp = p.in[chain ? I_ONORMC : I_ONORMB] + l * HD + col;
    bf16_t* mix0 = (bf16_t*)(p.ws + WS_MIX) + (size_t)(n * T_ + tok0) * MIXW + (chain ? 2 * GW : GW) + h * 64 + col;
#pragma unroll
    for (int i = 0; i < 4; ++i) { float s = ss[i]; s += __shfl_xor(s, 1); s += __shfl_xor(s, 2); s += __shfl_xor(s, 4); s += __shfl_xor(s, 8);
        const float r = rsqrtf(s * (1.f / 64.f) + EPS);
#pragma unroll
        for (int ct = 0; ct < 4; ++ct) mix0[(size_t)i * MIXW + 16 * ct] = f2bf(o[ct][i] * r * onp[16 * ct] * silu_f(bf2f(R.gt[ct][i]))); }
}
template <class PT> DI void chunk_out_phase(const PT& p, int l, int first, int stride) {
    constexpr int NT = 1536;
    if (first >= NT) return;
    CoRegs A, B;
    int t = first;
    co_load(p, t, A);
    for (;;) {
        const int t1 = t + stride; co_load(p, t1 < NT ? t1 : NT - 1, B);
        __builtin_amdgcn_sched_barrier(0);
        co_compute(p, l, t, A);
        if (t1 >= NT) break;
        const int t2 = t1 + stride; co_load(p, t2 < NT ? t2 : NT - 1, A);
        __builtin_amdgcn_sched_barrier(0);
        co_compute(p, l, t1, B);
        if (t2 >= NT) break;
        t = t2;
    }
}

template <class PT> DI void attn_task(const PT& p, int task) {
    const int nh = task >> 3, tile = task & 7, n = nh / NH, h = nh % NH, T0 = tile * 512;
    const int tid = opaque_tid(), wid = tid >> 6, lane = tid & 63, r = lane & 31, hh = lane >> 5;
    const bf16_t* qa = (const bf16_t*)(p.ws + WS_QA) + (size_t)nh * T_ * HD;
    const bf16_t* ka = (const bf16_t*)(p.ws + WS_KA) + (size_t)nh * T_ * HD;
    bf16_t* opart = (bf16_t*)(p.ws + WS_OPART); float* lse = (float*)(p.ws + WS_LSE);
    for (int u = wid; u < 48; u += 8) {
        const int br = u >> 4, within = u & 15;
        const int d = br == 0 ? 1 : (br == 1 ? 4 : 16), res = br == 0 ? 0 : (br == 1 ? (within >> 2) : within), qb = br == 0 ? within : (br == 1 ? (within & 3) : 0);
        const int L = T_ / d, Iq0 = T0 / d + 32 * qb;
        const int tq = (Iq0 + r) * d + res;
        bf16x8 Qf[4], KfA[2][4], KfB[2][4];
        f32x16 sacc[5];
#pragma unroll
        for (int s = 0; s < 4; ++s) Qf[s] = *(const bf16x8*)(qa + (size_t)tq * HD + 16 * s + 8 * hh);
#define ATT_KLOAD(KF, KT0, NKT) do { _Pragma("unroll") for (int kt = 0; kt < (NKT); ++kt) { const ptrdiff_t tk = (ptrdiff_t)(Iq0 - 128 + 32 * ((KT0) + kt) + r) * d + res;   \
            _Pragma("unroll") for (int s = 0; s < 4; ++s) KF[kt][s] = *(const bf16x8*)(ka + tk * HD + 16 * s + 8 * hh); } } while (0)
#define ATT_QK(KF, KT0, NKT) do { _Pragma("unroll") for (int kt = 0; kt < (NKT); ++kt) { const bool ok = (Iq0 - 128 + 32 * ((KT0) + kt) + r) >= 0; \
            f32x16 a; for (int i = 0; i < 16; ++i) a[i] = 0.f; \
            _Pragma("unroll") for (int s = 0; s < 4; ++s) { bf16x8 kf = KF[kt][s]; if (!ok) kf = (bf16x8){0, 0, 0, 0, 0, 0, 0, 0}; a = MFMA32(kf, Qf[s], a); } \
            sacc[(KT0) + kt] = a; } } while (0)
        const bf16_t* vt = (const bf16_t*)(p.ws + WS_VT) + (size_t)br * (SZ_HEADBUF / 2) + (size_t)nh * HD * T_ + (size_t)res * L;
        u32x2 VloA[2][2][2], VhiA[2][2][2], VloB[2][2][2], VhiB[2][2][2];
        const ptrdiff_t vi0 = (ptrdiff_t)(Iq0 - 128 + 4 * hh);
#define ATT_VLOAD(VLO, VHI, KT0, NKT) do { _Pragma("unroll") for (int kt = 0; kt < (NKT); ++kt) _Pragma("unroll") for (int s = 0; s < 2; ++s) _Pragma("unroll") for (int dt = 0; dt < 2; ++dt) { \
            const bf16_t* vp = vt + (size_t)(32 * dt + r) * T_ + vi0 + 32 * ((KT0) + kt) + 16 * s; VLO[kt][s][dt] = *(const u32x2*)(vp); VHI[kt][s][dt] = *(const u32x2*)(vp + 8); } } while (0)
#define ATT_PV(VLO, VHI, KT0, NKT) do { _Pragma("unroll") for (int kt = 0; kt < (NKT); ++kt) _Pragma("unroll") for (int s = 0; s < 2; ++s) { const int kx = (KT0) + kt; \
            const bf16x8 pf = mk8(pack2(sacc[kx][8 * s], sacc[kx][8 * s + 1]), pack2(sacc[kx][8 * s + 2], sacc[kx][8 * s + 3]), pack2(sacc[kx][8 * s + 4], sacc[kx][8 * s + 5]), pack2(sacc[kx][8 * s + 6], sacc[kx][8 * s + 7])); \
            const int idx0 = Iq0 - 128 + 32 * kx + 16 * s + 4 * hh; \
            _Pragma("unroll") for (int dt = 0; dt < 2; ++dt) { u32x2 lo = VLO[kt][s][dt], hi = VHI[kt][s][dt]; \
                if (idx0 < 0) { lo.x = 0u; lo.y = 0u; } if (idx0 + 8 < 0) { hi.x = 0u; hi.y = 0u; } \
                oacc[dt] = MFMA32(mk8(lo.x, lo.y, hi.x, hi.y), pf, oacc[dt]); } } } while (0)
        ATT_KLOAD(KfA, 0, 2); ATT_KLOAD(KfB, 2, 2);
        __builtin_amdgcn_sched_barrier(0);
        ATT_QK(KfA, 0, 2);
        __builtin_amdgcn_sched_barrier(0);
        ATT_KLOAD(KfA, 4, 1);
        __builtin_amdgcn_sched_barrier(0);
        ATT_QK(KfB, 2, 2);
        __builtin_amdgcn_sched_barrier(0);
        ATT_VLOAD(VloA, VhiA, 0, 2);
        __builtin_amdgcn_sched_barrier(0);
        ATT_QK(KfA, 4, 1);
        __builtin_amdgcn_sched_barrier(0);
        ATT_VLOAD(VloB, VhiB, 2, 2);
        __builtin_amdgcn_sched_barrier(0);
        float m = -1e30f;
        int rq = r - crow(0, hh); asm volatile("" : "+v"(rq));
        const int kmin = 128 - Iq0;
#pragma unroll
        for (int kt = 0; kt < 5; ++kt)
#pragma unroll
            for (int i = 0; i < 16; ++i) { const int kc = 32 * kt + crow(i, 0); const int kk = kc + 4 * hh; const bool valid = ((unsigned)(kc - rq) <= 128u) && (kk >= kmin);
                const float s = valid ? sacc[kt][i] : -1e30f; sacc[kt][i] = s; m = fmaxf(m, s); }
        m = fmaxf(m, __shfl_xor(m, 32));
        float lsum = 0.f;
#pragma unroll
        for (int kt = 0; kt < 5; ++kt)
#pragma unroll
            for (int i = 0; i < 16; ++i) { const float pe = __expf(sacc[kt][i] - m); sacc[kt][i] = pe; lsum += pe; }
        lsum += __shfl_xor(lsum, 32);
        f32x16 oacc[2];
#pragma unroll
        for (int dt = 0; dt < 2; ++dt) for (int i = 0; i < 16; ++i) oacc[dt][i] = 0.f;
        ATT_PV(VloA, VhiA, 0, 2);
        __builtin_amdgcn_sched_barrier(0);
        ATT_VLOAD(VloA, VhiA, 4, 1);
        __builtin_amdgcn_sched_barrier(0);
        ATT_PV(VloB, VhiB, 2, 2);
        __builtin_amdgcn_sched_barrier(0);
        ATT_PV(VloA, VhiA, 4, 1);
#undef ATT_KLOAD
#undef ATT_QK
#undef ATT_VLOAD
#undef ATT_PV
        const float inv = 1.f / lsum;
        bf16_t* op = opart + ((size_t)(br * 24 + nh) * T_ + tq) * HD;
#pragma unroll
        for (int dt = 0; dt < 2; ++dt)
#pragma unroll
            for (int g = 0; g < 4; ++g) { u32x2 w; w.x = pack2(oacc[dt][4 * g] * inv, oacc[dt][4 * g + 1] * inv); w.y = pack2(oacc[dt][4 * g + 2] * inv, oacc[dt][4 * g + 3] * inv);
                *(u32x2*)(op + 32 * dt + 8 * g + 4 * hh) = w; }
        if (hh == 0) lse[(size_t)(br * 24 + nh) * T_ + tq] = m + __logf(lsum);
    }
    __syncthreads();
    for (int it = 0; it < 8; ++it) { const int item = it * 512 + tid, t = T0 + (item >> 3), seg = item & 7;
        const float l0 = lse[(size_t)(0 * 24 + nh) * T_ + t], l1 = lse[(size_t)(1 * 24 + nh) * T_ + t], l2 = lse[(size_t)(2 * 24 + nh) * T_ + t];
        const float mx = fmaxf(l0, fmaxf(l1, l2)); float w0 = __expf(l0 - mx), w1 = __expf(l1 - mx), w2 = __expf(l2 - mx); const float iv = 1.f / (w0 + w1 + w2); w0 *= iv; w1 *= iv; w2 *= iv;
        float acc[8];
#pragma unroll
        for (int e = 0; e < 8; ++e) acc[e] = 0.f;
#pragma unroll
        for (int g = 0; g < 3; ++g) { const float wg = g == 0 ? w0 : (g == 1 ? w1 : w2); float x[8]; unpack8(*(const uint4*)(opart + ((size_t)(g * 24 + nh) * T_ + t) * HD + 8 * seg), x);
#pragma unroll
            for (int e = 0; e < 8; ++e) acc[e] += wg * x[e]; }
        *(uint4*)((bf16_t*)(p.ws + WS_MIX) + (size_t)(n * T_ + t) * MIXW + h * 64 + 8 * seg) = pack8(acc); }
    __syncthreads();
}
#define XB_MAKE() XcdBarrier xb_; xb_.bar = (unsigned*)(ws + WS_BAR); xb_.x = xb_xcc_id(); xb_.st = (volatile LAS unsigned*)((LAS unsigned char*)smem + LDS_BYTES - 16)
#if defined(PROBE_DUP) && PROBE_DUP == 6
#define GSYNC() do { XB_MAKE(); xcd_barrier(xb_); xcd_barrier(xb_); } while (0)
#else
#define GSYNC() do { XB_MAKE(); xcd_barrier(xb_); } while (0)
#endif
#ifndef PROBE_DUP
#define PROBE_DUP 0
#endif
DI float rs_from_slots32(const float* p) { float s = 0.f;
#pragma unroll
    for (int i = 0; i < 32; ++i) s += p[i];
    return rsqrtf(s * (1.f / DM) + EPS); }

__global__ void __launch_bounds__(512, 2) mega_fwd(Params p) {
    extern __shared__ __attribute__((aligned(16))) unsigned char smem[];
    cg::grid_group grid = cg::this_grid();
    const int G = gridDim.x, b = blockIdx.x, tid = threadIdx.x;
    PG8_LAS unsigned char* glds = (PG8_LAS unsigned char*)smem;
    unsigned char* ws = p.ws; float* out_g = p.out;
    static_assert(sizeof(Params) <= 256, "tab");
    volatile LAS unsigned* xst = (volatile LAS unsigned*)((LAS unsigned char*)smem + LDS_BYTES - 16);
    if (tid < 4) xst[tid] = 0u;
    __syncthreads();
    (void)xcd_barrier_post((unsigned*)(p.ws + WS_BAR), xst);
    { const unsigned long long* ka = (const unsigned long long*)__builtin_amdgcn_kernarg_segment_ptr();
      if (tid < (int)(sizeof(Params) / 8)) ((unsigned long long*)(p.ws + WS_TAB))[tid] = ka[tid]; }
#ifndef NO_P0
    phase0(smem, p);
#if PROBE_DUP == 3
    phase0(smem, p);
#endif
#endif
    grid.sync();
#pragma unroll 1
    for (int l = 0; l < 2; ++l) {
        PView p; p.in.ws = ws; p.out = out_g; p.ws = ws;
#define rowss ((float*)(ws + WS_ROWSS))
#define rowssS ((float*)(ws + WS_ROWSS_S))
        { float* zd = (float*)(ws + WS_ZD); const float* rsS = rowssS + (size_t)(2 * l) * 32 * 32;
#ifndef NO_SKINNY
          for (int skrep = 0; skrep < (PROBE_DUP == 35 ? 2 : 1); ++skrep)
          skinny<DM>(smem, (const bf16_t*)(ws + WS_XSB), (const bf16_t*)(ws + WS_WT_IN + l * SZ_WT_IN), ZS / 32, G - 1 - b, G,
                 [&](int row, int col, float v, int) { zd[(size_t)row * ZS + col] = v * rs_from_slots32(rsS + row * 32); });
#endif
          pg8::Gemm g{(const bf16_t*)(ws + WS_XB), (const bf16_t*)(ws + WS_WT_IN + l * SZ_WT_IN), MP, ZS, DM}; pg8::StaticOrder S; S.init(MP, ZS, G, b);
          EpiZ<0> E{(bf16_t*)(ws + WS_R1), ZS, rowss + (size_t)(2 * l) * MP * 16};
#if !defined(NO_GEMM) && !defined(NO_G1)
          pg8::gemm_phase<EpiZ<0>, pg8::StaticOrder, false>(glds, g, S, E, nullptr);
          { const int nfull = (MP / 256) * (ZS / 256) % G;
            if (nfull > 0 && b >= nfull) { __syncthreads(); deferred_weight_tiles(smem, p, l, b - nfull, G - nfull); } else if (nfull == 0) { __syncthreads(); deferred_weight_tiles(smem, p, l, b, G); } }
#if PROBE_DUP == 31
          __syncthreads();
          pg8::gemm_phase<EpiZ<0>, pg8::StaticOrder, false>(glds, g, S, E, nullptr);
#endif
#endif
          }
        GSYNC();
        if (b < 76) {
#ifndef NO_DEC
            decode_task(smem, p, l, b);
#if PROBE_DUP == 15
            decode_task(smem, p, l, b);
#endif
#endif
        }
#if PROBE_DUP == 1
        for (int rep = 0; rep < 2; ++rep)
#endif
        for (int k = 0;; ++k) {
            int task;
            if (G >= 256) {
                if (k < 2) { if (b < 72) continue; task = k * (G - 72) + (b - 72); }
                else if (k < 4) { if (b < 24) continue; task = 2 * (G - 72) + (k - 2) * (G - 24) + (b - 24); }
                else task = 2 * (G - 72) + 2 * (G - 24) + (k - 4) * G + b;
            } else task = k * G + b;
            if (task >= 1536 * 3 + 256) break;
            const unsigned cslot = (unsigned)(l * 3071 + task);
            if (task < 3071) {
                f32x4 cv[8]; copy_slot_load(p, cslot, cv);
                if (task < 1536) chunk_prep<true>(smem, p, l, task);
                else chunk_prep<false>(smem, p, l, task - 1536);
                copy_slot_store(p, cslot, cv);
            } else {
                if (task < 1536) chunk_prep<true>(smem, p, l, task);
                else if (task < 3072) chunk_prep<false>(smem, p, l, task - 1536);
                else if (task < 4608) aprep_task(smem, p, l, task - 3072);
                else dmix_task(p, l, task - 4608);
            }
        }
        GSYNC();
        { const int nchain = 48;
          if (b < nchain) {
#ifndef NO_CHAIN
              if (b < 24) chain_phase<0>(smem, p, l, b); else chain_phase<1>(smem, p, l, b - 24);
#if PROBE_DUP == 2 || PROBE_DUP == 21
              if (b < 24) chain_phase<0>(smem, p, l, b); else chain_phase<1>(smem, p, l, b - 24);
#endif
#endif
          } else { for (int task0 = b - nchain; task0 < 192; task0 += G - nchain) {
              int task = task0;
              if (G == 256) { const int a = b - nchain, x = a & 7, j = a >> 3; if (j >= 24) break; task = (x + 8 * (j >> 3)) * 8 + (j & 7); }
#ifndef NO_ATTN
              attn_task(p, task);
#if PROBE_DUP == 2 || PROBE_DUP == 22
              attn_task(p, task);
#endif
#endif
            }
          } }
        GSYNC();
#ifndef NO_COUT
#if PROBE_DUP == 4
#pragma unroll 1
        for (int rep = 0; rep < 2; ++rep)
#endif
        chunk_out_phase(p, l, b, G);
        if (l == 0) { __syncthreads(); deferred_weight_tiles(smem, p, 2, b, G); }
#endif
        GSYNC();
        { const float* xsf = l == 0 ? p.in[I_XS] : (const float*)(ws + WS_XSF); float* hsf = (float*)(ws + WS_HSF); bf16_t* hsb = (bf16_t*)(ws + WS_HSB);
          float* ssS = rowssS + (size_t)(2 * l + 1) * 32 * 32;
#ifndef NO_SKINNY
          for (int skrep = 0; skrep < (PROBE_DUP == 35 ? 2 : 1); ++skrep)
          skinny<MIXW>(smem, (const bf16_t*)(ws + WS_MIXS), (const bf16_t*)(ws + WS_WT_OUT + l * SZ_WT_OUT), DM / 32, G - 1 - b, G,
                 [&](int row, int col, float v, int tile) { const float y = v + xsf[row * DM + col]; hsf[row * DM + col] = y; hsb[row * DM + col] = f2bf(y);
                     float s = y * y; s += __shfl_xor(s, 1); s += __shfl_xor(s, 2); s += __shfl_xor(s, 4); s += __shfl_xor(s, 8); s += __shfl_xor(s, 16);
                     if ((col & 31) == 0) ssS[row * 32 + tile] = s; });
#endif
          pg8::Gemm g{(const bf16_t*)(ws + WS_MIX), (const bf16_t*)(ws + WS_WT_OUT + l * SZ_WT_OUT), MP, DM, MIXW}; pg8::StaticOrder S; S.init(MP, DM, G, b);
          EpiRes E{nullptr, (const bf16_t*)(ws + WS_XB), nullptr, (bf16_t*)(ws + WS_HB), rowss + (size_t)(2 * l + 1) * MP * 16};
#if !defined(NO_GEMM) && !defined(NO_G2)
          pg8::gemm_phase<EpiRes, pg8::StaticOrder, false>(glds, g, S, E, nullptr);
#if PROBE_DUP == 32
          __syncthreads();
          pg8::gemm_phase<EpiRes, pg8::StaticOrder, false>(glds, g, S, E, nullptr);
#endif
#endif
          }
        GSYNC();
        { bf16_t* us = (bf16_t*)(ws + WS_US); const float* rsS = rowssS + (size_t)(2 * l + 1) * 32 * 32;
#ifndef NO_SKINNY
          for (int skrep = 0; skrep < (PROBE_DUP == 35 ? 2 : 1); ++skrep)
          skinny<DM>(smem, (const bf16_t*)(ws + WS_HSB), (const bf16_t*)(ws + WS_WT_UP + l * SZ_WT_UP), DFF / 32, G - 1 - b, G,
                 [&](int row, int col, float v, int) { const float y = fmaxf(v * rs_from_slots32(rsS + row * 32), 0.f); us[(size_t)row * DFF + col] = f2bf(y * y); });
#endif
          pg8::Gemm g{(const bf16_t*)(ws + WS_HB), (const bf16_t*)(ws + WS_WT_UP + l * SZ_WT_UP), MP, DFF, DM}; pg8::StaticOrder S; S.init(MP, DFF, G, b);
          EpiZ<1> E{(bf16_t*)(ws + WS_R1), DFF, rowss + (size_t)(2 * l + 1) * MP * 16};
#if !defined(NO_GEMM) && !defined(NO_G3)
          pg8::gemm_phase<EpiZ<1>, pg8::StaticOrder, false>(glds, g, S, E, nullptr);
#if PROBE_DUP == 5
          __syncthreads();
          pg8::gemm_phase<EpiZ<1>, pg8::StaticOrder, false>(glds, g, S, E, nullptr);
#endif
#endif
          }
        GSYNC();
        { const float* hsf = (const float*)(ws + WS_HSF); float* xo = l == 0 ? (float*)(ws + WS_XSF) : p.out + O_YS; bf16_t* xsb = (bf16_t*)(ws + WS_XSB);
          float* ssS = rowssS + (size_t)(2 * l + 2) * 32 * 32;
#ifndef NO_SKINNY
          for (int skrep = 0; skrep < (PROBE_DUP == 35 ? 2 : 1); ++skrep)
          skinny<DFF>(smem, (const bf16_t*)(ws + WS_US), (const bf16_t*)(ws + WS_WT_DOWN + l * SZ_WT_DOWN), DM / 32, G - 1 - b, G,
                 [&](int row, int col, float v, int tile) { const float y = v + hsf[row * DM + col]; xo[row * DM + col] = y; xsb[row * DM + col] = f2bf(y);
                     float s = y * y; s += __shfl_xor(s, 1); s += __shfl_xor(s, 2); s += __shfl_xor(s, 4); s += __shfl_xor(s, 8); s += __shfl_xor(s, 16);
                     if ((col & 31) == 0) ssS[row * 32 + tile] = s; });
#endif
          pg8::Gemm g{(const bf16_t*)(ws + WS_R1), (const bf16_t*)(ws + WS_WT_DOWN + l * SZ_WT_DOWN), MP, DM, DFF}; pg8::StaticOrder S; S.init(MP, DM, G, b);
          EpiRes E{nullptr, (const bf16_t*)(ws + WS_HB), l == 0 ? nullptr : p.out + O_YP, l == 0 ? (bf16_t*)(ws + WS_XB) : nullptr, rowss + (size_t)(2 * l + 2) * MP * 16};
#if !defined(NO_GEMM) && !defined(NO_G4)
          pg8::gemm_phase<EpiRes, pg8::StaticOrder, false>(glds, g, S, E, nullptr);
#if PROBE_DUP == 34
          __syncthreads();
          pg8::gemm_phase<EpiRes, pg8::StaticOrder, false>(glds, g, S, E, nullptr);
#endif
#endif
          }
        if (l == 0) GSYNC();
    }
}

extern "C" void kernel_launch(void* const* d_in, const int* in_sizes, int n_in, void* d_out, int out_size, void* d_ws, size_t ws_size, hipStream_t stream) {
    static int grid = 0;
    if (grid == 0) {
        if (n_in != 22 || (size_t)out_size != O_END || ws_size < WS_END) { fprintf(stderr, "kernel_launch: unexpected shapes: n_in %d out %d (want %zu) ws %zu (want %zu)\n", n_in, out_size, (size_t)O_END, ws_size, (size_t)WS_END); grid = -1; return; }
        int dev = 0, cus = 0, per_cu = 0;
        hipGetDevice(&dev); hipDeviceGetAttribute(&cus, hipDeviceAttributeMultiprocessorCount, dev);
        if (hipFuncSetAttribute((const void*)mega_fwd, hipFuncAttributeMaxDynamicSharedMemorySize, LDS_BYTES) != hipSuccess) { fprintf(stderr, "kernel_launch: hipFuncSetAttribute failed\n"); grid = -1; return; }
        if (hipOccupancyMaxActiveBlocksPerMultiprocessor(&per_cu, (const void*)mega_fwd, 512, LDS_BYTES) != hipSuccess || per_cu < 1) { fprintf(stderr, "kernel_launch: occupancy query says %d\n", per_cu); per_cu = 1; }
        (void)hipGetLastError();
        grid = cus;
    }
    if (grid < 0) return;
    if (hipMemsetAsync((char*)d_ws + WS_BAR, 0, 16384, stream) != hipSuccess) { fprintf(stderr, "kernel_launch: memset of barrier words failed\n"); return; }
    Params p{};
    for (int i = 0; i < 22; ++i) p.in[i] = (const float*)d_in[i];
    p.out = (float*)d_out; p.ws = (unsigned char*)d_ws;
    void* args[] = {&p};
    hipError_t e = hipLaunchCooperativeKernel((const void*)mega_fwd, dim3(grid), dim3(512), args, LDS_BYTES, stream);
    if (e != hipSuccess) fprintf(stderr, "cooperative launch failed: %s (grid %d)\n", hipGetErrorString(e), grid);
}
```

```cpp
#include <hip/hip_runtime.h>
#include <hip/hip_cooperative_groups.h>
#include <cstdio>
namespace cg = cooperative_groups;
namespace pg8 {
#define PG8_LAS __attribute__((address_space(3)))
typedef unsigned short bf16_t;
typedef short bf16x8 __attribute__((ext_vector_type(8)));
typedef float f32x4 __attribute__((ext_vector_type(4)));
typedef unsigned u32x4 __attribute__((ext_vector_type(4)));
constexpr int BM = 256, BK = 64, HALF = 128, HTB = HALF * BK * 2  , STAGE_BYTES = 8 * HTB, NXCD = 8, WGM = 8;

__host__ __device__ __forceinline__ int lds_byte(int r, int c) { const int st = (r >> 4) * 2 + (c >> 5), rr = r & 15, cc = c & 31, ob = rr * 64 + cc * 2; return st * 1024 + (ob ^ (((ob >> 9) & 1) << 5)); }
__host__ __device__ __forceinline__ void stage_rc(int b, int& R, int& C) { const int st = b / 1024, sb = b % 1024, swz = sb ^ (((sb >> 9) & 1) << 5); R = (st >> 1) * 16 + swz / 64; C = (st & 1) * 32 + (swz % 64) / 2; }
__host__ __device__ __forceinline__ int perm32(int rho) { const int n = rho >> 4, i = rho & 15; return 8 * (i >> 2) + 4 * n + (i & 3); }

struct Unit { int pm, pn; };
struct Gemm { const bf16_t* A; const bf16_t* Bt; int M, N, K; };

struct StaticOrder {
    int nM, nN, nwg, G, c;
    __host__ __device__ void init(int M, int N, int G_, int c_) { nM = M / BM; nN = N / BM; nwg = nM * nN; G = G_; c = c_; }
    __host__ __device__ bool next(int i, Unit& u) const {
        const long L = (long)i * G + c; if (L >= nwg) return false;
        int wgid = (int)L; { const int q = nwg / NXCD, r = nwg % NXCD, xcd = wgid % NXCD, off = wgid / NXCD; wgid = (xcd < r ? xcd * (q + 1) : r * (q + 1) + (xcd - r) * q) + off; }
        const int nig = WGM * nN, gid = wgid / nig, fm = gid * WGM, gsz = (nM - fm) < WGM ? (nM - fm) : WGM;
        u.pm = fm + ((wgid % nig) % gsz); u.pn = (wgid % nig) / gsz; return true;
    }
    __device__ __forceinline__ void a_ready(const Unit&) const {}
    __device__ __forceinline__ void done(const Unit&) const {}
};
__device__ __forceinline__ unsigned cvt_pk_bf16(float lo, float hi) { unsigned r; asm volatile("v_cvt_pk_bf16_f32 %0, %1, %2" : "=v"(r) : "v"(lo), "v"(hi)); return r; }
template <class Epi, class Sched, bool STAMP = false>
__device__ __forceinline__ void gemm_phase(PG8_LAS unsigned char* lds, const Gemm g, const Sched& S, const Epi& E, unsigned long long* stamps) {
    int tid_ = threadIdx.x; asm volatile("" : "+v"(tid_));
    const int tid = tid_, wid = __builtin_amdgcn_readfirstlane(tid >> 6), lane = tid & 63, wr = wid >> 2, wc = wid & 3, fr = lane & 15, fq = lane >> 4;
    const int K = g.K, nt = K / BK;
    int ts_lo = 0, ts_hi = 0, nts = 0; const unsigned long long rt_entry = STAMP ? (unsigned long long)wall_clock64() : 0ull;
#define PG8_STAMP() do { if (STAMP && wid == 0 && nts < 64) { const unsigned long long _c = (unsigned long long)clock64(); \
        ts_lo = (lane == nts) ? (int)(unsigned)_c : ts_lo; ts_hi = (lane == nts) ? (int)(unsigned)(_c >> 32) : ts_hi; ++nts; } } while (0)
    PG8_STAMP();
    unsigned voffA[2], voffB[2];
#pragma unroll
    for (int i = 0; i < 2; ++i) { int R, C; stage_rc(tid * 16 + i * 8192, R, C); const int Rb = Epi::PERM ? ((R & ~31) + perm32(R & 31)) : R;
        voffA[i] = (unsigned)(R * K + C) * 2u; voffB[i] = (unsigned)(Rb * K + C) * 2u; }
    const size_t kstep = (size_t)(BK * 2);
    const size_t hstep = (size_t)HALF * K * 2;
    const size_t tstep = 2 * hstep;
    const unsigned ldsw = (unsigned)wid * 1024u;
    const int aoff = lds_byte(wr * 64 + fr, fq * 8), boff = lds_byte(wc * 32 + fr, fq * 8);
#define PG8_SA(b, h) (((b) * 2 + (h)) * HTB)
#define PG8_SB(b, h) ((4 + (b) * 2 + (h)) * HTB)
#define PG8_STAGE(bufoff, gbase, voff) do { _Pragma("unroll") for (int _i = 0; _i < 2; ++_i) \
        __builtin_amdgcn_global_load_lds((const unsigned*)((const char*)(gbase) + (voff)[_i]), (PG8_LAS unsigned*)(lds + (bufoff) + ldsw + _i * 8192), 16, 0, 0); } while (0)
#define PG8_LDA(dst, b, h) do { _Pragma("unroll") for (int m = 0; m < 4; ++m) _Pragma("unroll") for (int k = 0; k < 2; ++k) dst[m][k] = *(const PG8_LAS bf16x8*)(lds + PG8_SA(b, h) + aoff + m * 2048 + k * 1024); } while (0)
#define PG8_LDB(dst, b, h) do { _Pragma("unroll") for (int n = 0; n < 2; ++n) _Pragma("unroll") for (int k = 0; k < 2; ++k) dst[n][k] = *(const PG8_LAS bf16x8*)(lds + PG8_SB(b, h) + boff + n * 2048 + k * 1024); } while (0)
#define PG8_MMA(ai, bj, At, Bt) do { __builtin_amdgcn_s_setprio(1); _Pragma("unroll") for (int m = 0; m < 4; ++m) _Pragma("unroll") for (int n = 0; n < 2; ++n) _Pragma("unroll") for (int k = 0; k < 2; ++k) \
        acc[ai][bj][m][n] = __builtin_amdgcn_mfma_f32_16x16x32_bf16(Bt[n][k], At[m][k], acc[ai][bj][m][n], 0, 0, 0); __builtin_amdgcn_s_setprio(0); } while (0)
#define PG8_WAIT_V(n) asm volatile("s_waitcnt vmcnt(" #n ")" ::: "memory")
#define PG8_WAIT_L(n) asm volatile("s_waitcnt lgkmcnt(" #n ")" ::: "memory")
#define PG8_BAR __builtin_amdgcn_s_barrier()
#define PG8_SCHED __builtin_amdgcn_sched_barrier(0)
    Unit cur, nxt; int ui = 0;
    if (!S.next(0, cur)) return;
    f32x4 acc[2][2][4][2];
#pragma unroll
    for (int a = 0; a < 2; ++a)
#pragma unroll
        for (int b = 0; b < 2; ++b)
#pragma unroll
            for (int m = 0; m < 4; ++m)
#pragma unroll
                for (int n = 0; n < 2; ++n) acc[a][b][m][n] = (f32x4){0.f, 0.f, 0.f, 0.f};
    bf16x8 At[4][2], B0[2][2], B1[2][2];
    const char* cA = (const char*)g.A + (size_t)cur.pm * tstep; const char* cB = (const char*)g.Bt + (size_t)cur.pn * tstep;
    S.a_ready(cur);
    PG8_STAGE(PG8_SB(0, 0), cB, voffB); PG8_STAGE(PG8_SA(0, 0), cA, voffA); PG8_STAGE(PG8_SB(0, 1), cB + hstep, voffB); PG8_STAGE(PG8_SA(0, 1), cA + hstep, voffA);
    if (wr == 1) PG8_BAR;
    PG8_WAIT_V(4); PG8_BAR;
    PG8_STAGE(PG8_SB(1, 0), cB + kstep, voffB); PG8_STAGE(PG8_SA(1, 0), cA + kstep, voffA); PG8_STAGE(PG8_SB(1, 1), cB + hstep + kstep, voffB);
    PG8_WAIT_V(6); PG8_BAR;
    PG8_STAMP();
    for (;;) {
        const bool has_next = S.next(ui + 1, nxt);
        const char* nA = has_next ? (const char*)g.A + (size_t)nxt.pm * tstep : cA; const char* nB = has_next ? (const char*)g.Bt + (size_t)nxt.pn * tstep : cB;
        for (int t = 0; t < nt; t += 2) {
            const bool last = (t == nt - 2);
            const char* a1 = cA + (size_t)(t + 1) * kstep;
            const char* a2 = last ? nA : cA + (size_t)(t + 2) * kstep; const char* b2 = last ? nB : cB + (size_t)(t + 2) * kstep;
            const char* a3 = a2 + kstep; const char* b3 = b2 + kstep;
            if (last && has_next) S.a_ready(nxt);
            PG8_LDB(B0, 0, 0); PG8_SCHED; PG8_LDA(At, 0, 0); PG8_STAGE(PG8_SA(1, 1), a1 + hstep, voffA);
            PG8_WAIT_L(8); PG8_BAR; PG8_WAIT_L(0); PG8_MMA(0, 0, At, B0); PG8_BAR; PG8_SCHED;
            PG8_LDB(B1, 0, 1); PG8_STAGE(PG8_SB(0, 0), b2, voffB);
            PG8_BAR; PG8_WAIT_L(0); PG8_MMA(0, 1, At, B1); PG8_BAR;
            PG8_LDA(At, 0, 1); PG8_STAGE(PG8_SA(0, 0), a2, voffA);
            PG8_BAR; PG8_WAIT_L(0); PG8_MMA(1, 0, At, B0); PG8_BAR; PG8_SCHED;
            PG8_STAGE(PG8_SB(0, 1), b2 + hstep, voffB);
            PG8_WAIT_V(6); PG8_BAR; PG8_MMA(1, 1, At, B1); PG8_BAR;
            PG8_LDB(B0, 1, 0); PG8_SCHED; PG8_LDA(At, 1, 0); PG8_STAGE(PG8_SA(0, 1), a2 + hstep, voffA);
            PG8_WAIT_L(8); PG8_BAR; PG8_WAIT_L(0); PG8_MMA(0, 0, At, B0); PG8_BAR; PG8_SCHED;
            PG8_LDB(B1, 1, 1); PG8_STAGE(PG8_SB(1, 0), b3, voffB);
            PG8_BAR; PG8_WAIT_L(0); PG8_MMA(0, 1, At, B1); PG8_BAR;
            PG8_LDA(At, 1, 1); PG8_STAGE(PG8_SA(1, 0), a3, voffA);
            PG8_BAR; PG8_WAIT_L(0); PG8_MMA(1, 0, At, B0); PG8_BAR; PG8_SCHED;
            PG8_STAGE(PG8_SB(1, 1), b3 + hstep, voffB);
            PG8_WAIT_V(6); PG8_BAR; PG8_MMA(1, 1, At, B1); PG8_BAR;
        }
        PG8_STAMP();
        if constexpr (!Epi::AFTER_DRAIN) { E(acc, cur, wr, wc, fr, fq); S.done(cur); }
        PG8_STAMP();
        if (!has_next) break;
#pragma unroll
        for (int a = 0; a < 2; ++a)
#pragma unroll
            for (int b = 0; b < 2; ++b)
#pragma unroll
                for (int m = 0; m < 4; ++m)
#pragma unroll
                    for (int n = 0; n < 2; ++n) acc[a][b][m][n] = (f32x4){0.f, 0.f, 0.f, 0.f};
        cur = nxt; cA = nA; cB = nB; ++ui;
    }
    PG8_WAIT_V(0);
    if (wr == 0) PG8_BAR;
    PG8_BAR;
    if constexpr (Epi::AFTER_DRAIN) { E.fused(acc, cur, wr, wc, fr, fq, lds, wid, lane); S.done(cur); }
    PG8_STAMP();
    if (STAMP && wid == 0) { stamps[lane] = lane < nts ? (((unsigned long long)(unsigned)ts_hi << 32) | (unsigned)ts_lo) : 0ull;
        if (lane == 62) stamps[62] = rt_entry; if (lane == 63) stamps[63] = (unsigned long long)wall_clock64(); }
#undef PG8_STAMP
#undef PG8_SA
#undef PG8_SB
#undef PG8_STAGE
#undef PG8_LDA
#undef PG8_LDB
#undef PG8_MMA
#undef PG8_WAIT_V
#undef PG8_WAIT_L
#undef PG8_BAR
#undef PG8_SCHED
}
}
using pg8::bf16_t; using pg8::bf16x8; using pg8::f32x4; using pg8::u32x4;
typedef float f32x16 __attribute__((ext_vector_type(16)));
typedef unsigned u32x2 __attribute__((ext_vector_type(2)));
#define LAS __attribute__((address_space(3)))
#define DI __device__ __forceinline__

constexpr int T_ = 4096, NBAT = 4, MP = NBAT * T_, MD = 32, DM = 1024, NH = 6, HD = 64, GW = 384, MIXW = 1536, DFF = 4096, ZS = 5632, NIN = 5388;
constexpr int AQ = 0, AK = 384, AV = 768, BQ = 1152, BKo = 1536, BV = 1920, BZ = 2304, CQ = 2688, CK = 3072, CV = 3456, CG = 3840, DX = 4224, DC = 4608, DB = 4992, GA = 5376, GB = 5382;
constexpr float EPS = 1e-6f;
constexpr int LDS_BYTES = 147456;

constexpr size_t al256(size_t x) { return (x + 255) & ~(size_t)255; }
constexpr size_t SZ_WT_IN = (size_t)ZS * DM * 2, SZ_WT_OUT = (size_t)DM * MIXW * 2, SZ_WT_UP = (size_t)DFF * DM * 2, SZ_WT_DOWN = (size_t)DM * DFF * 2;
constexpr size_t WS_WT_IN = 0;
constexpr size_t WS_WT_OUT = WS_WT_IN + 2 * SZ_WT_IN;
constexpr size_t WS_WT_UP = WS_WT_OUT + 2 * SZ_WT_OUT;
constexpr size_t WS_WT_DOWN = WS_WT_UP + 2 * SZ_WT_UP;
constexpr size_t WS_XB = WS_WT_DOWN + 2 * SZ_WT_DOWN;
constexpr size_t WS_R1 = WS_XB + (size_t)MP * DM * 2;
constexpr size_t SZ_HEADBUF = (size_t)NBAT * NH * T_ * HD * 2;
constexpr size_t WS_QA = WS_R1 + (size_t)MP * ZS * 2;
constexpr size_t WS_KA = WS_QA + SZ_HEADBUF;
constexpr size_t WS_VT = WS_KA + SZ_HEADBUF;
constexpr size_t SZ_BBLK = (size_t)NBAT * NH * 64 * 40960, SZ_CBLK = (size_t)NBAT * NH * 64 * 32768;
constexpr size_t WS_R2 = WS_VT + 3 * SZ_HEADBUF;
constexpr size_t WS_BBLK = WS_R2, WS_CBLK = WS_R2 + SZ_BBLK;
constexpr size_t WS_HF = WS_R2, WS_HB = WS_R2 + (size_t)MP * DM * 4;
static_assert((size_t)MP * DM * 6 <= SZ_BBLK + SZ_CBLK, "alias");
constexpr size_t WS_OPART = WS_R2 + SZ_BBLK + SZ_CBLK;
constexpr size_t WS_LSE = WS_OPART + (size_t)3 * 24 * T_ * 64 * 4;
constexpr size_t WS_MIX = WS_LSE + (size_t)3 * 24 * T_ * 4;
constexpr size_t WS_XF = WS_MIX + (size_t)MP * MIXW * 2;
constexpr size_t WS_ROWSS = WS_XF + (size_t)MP * DM * 4;
constexpr size_t WS_DLB = WS_ROWSS + (size_t)5 * MP * 16 * 4;
constexpr size_t WS_XSB = al256(WS_DLB + 24 * 64 * 4);
constexpr size_t WS_XSF = WS_XSB + (size_t)MD * DM * 2;
constexpr size_t WS_ZD = WS_XSF + (size_t)MD * DM * 4;
constexpr size_t WS_MIXS = WS_ZD + (size_t)MD * ZS * 4;
constexpr size_t WS_HSF = WS_MIXS + (size_t)MD * MIXW * 2;
constexpr size_t WS_HSB = WS_HSF + (size_t)MD * DM * 4;
constexpr size_t WS_US = WS_HSB + (size_t)MD * DM * 2;
constexpr size_t WS_ROWSS_S = WS_US + (size_t)MD * DFF * 2;
constexpr size_t WS_TAB = al256(WS_ROWSS_S + (size_t)5 * 32 * 32 * 4);
constexpr size_t WS_STB = WS_TAB + 256;
constexpr size_t WS_STC = WS_STB + (size_t)24 * 64 * 8192;
constexpr size_t WS_VNB = WS_STC + (size_t)24 * 64 * 8192;
constexpr size_t WS_TRIG = WS_VNB + (size_t)24 * 64 * 8192;
constexpr size_t WS_BAR = WS_TRIG + (size_t)2 * T_ * 32 * 8;
constexpr size_t WS_END = WS_BAR + 16384;

constexpr size_t O_YP = 0;
constexpr size_t O_YS = O_YP + (size_t)MP * DM;
constexpr size_t O_PAK = O_YS + (size_t)MD * DM;
constexpr size_t O_PAV = O_PAK + (size_t)2 * NBAT * 2048 * GW;
constexpr size_t O_PBCONV = O_PAV + (size_t)2 * NBAT * 2048 * GW;
constexpr size_t O_PBREC = O_PBCONV + (size_t)2 * NBAT * 3 * 1152;
constexpr size_t O_PCREC = O_PBREC + (size_t)2 * NBAT * NH * 4096;
constexpr size_t O_PDCONV = O_PCREC + (size_t)2 * NBAT * NH * 4096;
constexpr size_t O_SAK = O_PDCONV + (size_t)2 * NBAT * 2 * GW;
constexpr size_t O_SAV = O_SAK + (size_t)2 * MD * 2048 * GW;
constexpr size_t O_SBCONV = O_SAV + (size_t)2 * MD * 2048 * GW;
constexpr size_t O_SBREC = O_SBCONV + (size_t)2 * MD * 3 * 1152;
constexpr size_t O_SCREC = O_SBREC + (size_t)2 * MD * NH * 4096;
constexpr size_t O_SDCONV = O_SCREC + (size_t)2 * MD * NH * 4096;
constexpr size_t O_END = O_SDCONV + (size_t)2 * MD * 2 * GW;

struct Params { const float* in[22]; float* out; unsigned char* ws; };
template <class T> DI T* as_global(T* q) { return (T*)(__attribute__((address_space(1))) T*)q; }
struct InProxy { const unsigned char* ws; DI const float* operator[](int i) const; };
struct PView { InProxy in; float* out; unsigned char* ws; };
typedef const float __attribute__((address_space(1)))* gcfptr;
DI const float* InProxy::operator[](int i) const { return (const float*)(((const gcfptr*)(ws + WS_TAB))[i]); }
enum { I_XP = 0, I_XS, I_CAK, I_CAV, I_SBCONV, I_SBREC, I_SCREC, I_SDCONV, I_NORM_MIX, I_W_IN, I_QNORM, I_KNORM, I_CONVB, I_ALOG, I_DTBIAS, I_ONORMB, I_ONORMC, I_CONVD, I_W_OUT, I_NORM_FFN, I_W_UP, I_W_DOWN };

DI int opaque_tid() { int t = threadIdx.x; asm volatile("" : "+v"(t)); return t; }
typedef float f32x2v __attribute__((ext_vector_type(2)));
typedef __bf16 bf16x2v __attribute__((ext_vector_type(2)));
DI unsigned short f2bf(float x) { return __builtin_bit_cast(unsigned short, (__bf16)x); }
DI float bf2f(unsigned short b) { return __uint_as_float(((unsigned)b) << 16); }
DI unsigned pack2(float lo, float hi) { f32x2v v; v.x = lo; v.y = hi; return __builtin_bit_cast(unsigned, __builtin_convertvector(v, bf16x2v)); }
DI float bflo(unsigned w) { return __uint_as_float(w << 16); }
DI float bfhi(unsigned w) { return __uint_as_float(w & 0xffff0000u); }
DI void unpack8(const uint4& v, float* f) { f[0] = bflo(v.x); f[1] = bfhi(v.x); f[2] = bflo(v.y); f[3] = bfhi(v.y); f[4] = bflo(v.z); f[5] = bfhi(v.z); f[6] = bflo(v.w); f[7] = bfhi(v.w); }
DI uint4 pack8(const float* f) { uint4 v; v.x = pack2(f[0], f[1]); v.y = pack2(f[2], f[3]); v.z = pack2(f[4], f[5]); v.w = pack2(f[6], f[7]); return v; }
DI float silu_f(float x) { return x / (1.f + __expf(-x)); }
DI float wave_sum(float v) { for (int m = 32; m >= 1; m >>= 1) v += __shfl_xor(v, m); return v; }
DI float wave_max(float v) { for (int m = 32; m >= 1; m >>= 1) v = fmaxf(v, __shfl_xor(v, m)); return v; }
DI int crow(int reg, int h) { return (reg & 3) + 8 * (reg >> 2) + 4 * h; }
#define MFMA32(a, b, c) __builtin_amdgcn_mfma_f32_32x32x16_bf16((a), (b), (c), 0, 0, 0)
#define MFMA16(a, b, c) __builtin_amdgcn_mfma_f32_16x16x32_bf16((a), (b), (c), 0, 0, 0)
DI bf16x8 mk8(unsigned a, unsigned b, unsigned c, unsigned d) { u32x4 v; v.x = a; v.y = b; v.z = c; v.w = d; return __builtin_bit_cast(bf16x8, v); }
DI float rs_from_slots16(const float* p) { const float4 a = *(const float4*)p, b = *(const float4*)(p + 4), c = *(const float4*)(p + 8), d = *(const float4*)(p + 12);
    const float s = (a.x + a.y + a.z + a.w) + (b.x + b.y + b.z + b.w) + (c.x + c.y + c.z + c.w) + (d.x + d.y + d.z + d.w); return rsqrtf(s * (1.f / DM) + EPS); }

template <int ACT> struct EpiZ {
    static constexpr bool PERM = true, AFTER_DRAIN = false;
    bf16_t* O; int ldc; const float* rowss;
    DI void operator()(const f32x4 (&acc)[2][2][4][2], const pg8::Unit& u, int wr, int wc, int fr, int fq) const {
        const int row0 = u.pm * 256 + wr * 64 + fr, col0 = u.pn * 256 + wc * 32 + 8 * fq;
#pragma unroll
        for (int ai = 0; ai < 2; ++ai) {
#pragma unroll
          for (int mh = 0; mh < 2; ++mh) {
            f32x4 sl[2][4];
#pragma unroll
            for (int m2 = 0; m2 < 2; ++m2)
#pragma unroll
                for (int k = 0; k < 4; ++k) sl[m2][k] = *(const f32x4*)(rowss + (size_t)(row0 + ai * 128 + (2 * mh + m2) * 16) * 16 + 4 * k);
            __builtin_amdgcn_sched_barrier(0);
#pragma unroll
            for (int m2 = 0; m2 < 2; ++m2) { const int m = 2 * mh + m2;
                const int row = row0 + ai * 128 + m * 16;
                const f32x4 t = (sl[m2][0] + sl[m2][1]) + (sl[m2][2] + sl[m2][3]);
                const float rs = rsqrtf((t[0] + t[1] + t[2] + t[3]) * (1.f / DM) + EPS);
                bf16_t* rowp = O + (size_t)row * ldc + col0;
#pragma unroll
                for (int bj = 0; bj < 2; ++bj) {
                    f32x4 v0 = acc[ai][bj][m][0] * rs, v1 = acc[ai][bj][m][1] * rs;
                    if (ACT == 1) {
#pragma unroll
                        for (int j = 0; j < 4; ++j) { float a = fmaxf(v0[j], 0.f), b = fmaxf(v1[j], 0.f); v0[j] = a * a; v1[j] = b * b; } }
                    u32x4 w; w.x = pg8::cvt_pk_bf16(v0[0], v0[1]); w.y = pg8::cvt_pk_bf16(v0[2], v0[3]); w.z = pg8::cvt_pk_bf16(v1[0], v1[1]); w.w = pg8::cvt_pk_bf16(v1[2], v1[3]);
                    *(u32x4*)(rowp + bj * 128) = w; } } } }
    }
};
struct EpiRes {
    static constexpr bool PERM = false, AFTER_DRAIN = false;
    const float* resid_f; const bf16_t* resid_b; float* outf; bf16_t* outb; float* ssout;
    DI void operator()(const f32x4 (&acc)[2][2][4][2], const pg8::Unit& u, int wr, int wc, int fr, int fq) const {
        const int row0 = u.pm * 256 + wr * 64 + fr, col0 = u.pn * 256 + wc * 32 + 4 * fq;
#pragma unroll
        for (int ai = 0; ai < 2; ++ai)
#pragma unroll
          for (int mh = 0; mh < 2; ++mh) {
            f32x4 rv[2][2][2];
            if (resid_f) {
#pragma unroll
                for (int m2 = 0; m2 < 2; ++m2)
#pragma unroll
                    for (int bj = 0; bj < 2; ++bj)
#pragma unroll
                        for (int n = 0; n < 2; ++n) rv[m2][bj][n] = *(const f32x4*)(resid_f + (size_t)(row0 + ai * 128 + (2 * mh + m2) * 16) * DM + col0 + bj * 128 + n * 16);
            } else {
                u32x2 rb[2][2][2];
#pragma unroll
                for (int m2 = 0; m2 < 2; ++m2)
#pragma unroll
                    for (int bj = 0; bj < 2; ++bj)
#pragma unroll
                        for (int n = 0; n < 2; ++n) rb[m2][bj][n] = *(const u32x2*)(resid_b + (size_t)(row0 + ai * 128 + (2 * mh + m2) * 16) * DM + col0 + bj * 128 + n * 16);
#pragma unroll
                for (int m2 = 0; m2 < 2; ++m2)
#pragma unroll
                    for (int bj = 0; bj < 2; ++bj)
#pragma unroll
                        for (int n = 0; n < 2; ++n) { const u32x2 w = rb[m2][bj][n]; rv[m2][bj][n] = (f32x4){bflo(w.x), bfhi(w.x), bflo(w.y), bfhi(w.y)}; }
            }
            __builtin_amdgcn_sched_barrier(0);
#pragma unroll
            for (int m2 = 0; m2 < 2; ++m2) { const int m = 2 * mh + m2;
                const int row = row0 + ai * 128 + m * 16; float ss = 0.f;
#pragma unroll
                for (int bj = 0; bj < 2; ++bj)
#pragma unroll
                    for (int n = 0; n < 2; ++n) {
                        const size_t o = (size_t)row * DM + col0 + bj * 128 + n * 16;
                        const f32x4 v = acc[ai][bj][m][n] + rv[m2][bj][n];
                        if (outf) *(f32x4*)(outf + o) = v;
                        if (outb) { uint2 w; w.x = pg8::cvt_pk_bf16(v[0], v[1]); w.y = pg8::cvt_pk_bf16(v[2], v[3]);
                            *(uint2*)(outb + o) = w; }
                        ss += v[0] * v[0] + v[1] * v[1] + v[2] * v[2] + v[3] * v[3]; }
                if (outb) { ss += __shfl_xor(ss, 16); ss += __shfl_xor(ss, 32);
                    if (fq == 0) ssout[(size_t)row * 16 + u.pn * 4 + wc] = ss; } } }
    }
};

template <int K, class F> DI void skinny(unsigned char* smem, const bf16_t* A, const bf16_t* Bt, int ntiles, int first, int stride, F f) {
    float* red = (float*)smem;
    const int tid = opaque_tid(), wid = tid >> 6, lane = tid & 63, r = lane & 31, h = lane >> 5;
    constexpr int kw = K >> 3, NS = kw / 16, BS = NS <= 12 ? NS : 8;
    static_assert(NS % BS == 0, "batch");
    for (int tile = first; tile < ntiles; tile += stride) {
        f32x16 acc; for (int i = 0; i < 16; ++i) acc[i] = 0.f;
        const bf16_t* ap = A + (size_t)r * K + wid * kw + 8 * h;
        const bf16_t* bp = Bt + (size_t)(tile * 32 + r) * K + wid * kw + 8 * h;
#pragma unroll 1
        for (int k = 0; k < kw; k += 16 * BS) { bf16x8 av[BS], bv[BS];
#pragma unroll
            for (int j = 0; j < BS; ++j) { av[j] = *(const bf16x8*)(ap + k + 16 * j); bv[j] = *(const bf16x8*)(bp + k + 16 * j); }
            __builtin_amdgcn_sched_barrier(0);
#pragma unroll
            for (int j = 0; j < BS; ++j) acc = MFMA32(av[j], bv[j], acc); }
#pragma unroll
        for (int i = 0; i < 16; ++i) red[wid * 1024 + crow(i, h) * 32 + r] = acc[i];
        __syncthreads();
        for (int o = tid; o < 1024; o += 512) { float s = 0.f;
#pragma unroll
            for (int w = 0; w < 8; ++w) s += red[w * 1024 + o];
            f(o >> 5, tile * 32 + (o & 31), s, tile); }
        __syncthreads();
    }
}
#define XB_TMO      128
#define XB_XCNT(j)  (256  + 64 * (j))
#define XB_XSUB(j)  (1280 + 64 * (j))
#define XB_XGEN(j)  (2304 + 64 * (j))
#define XB_TOP      3328
#define XB_TOPGEN   3392
#define XCD_BAR_WORDS 3456
#define XB_SPIN_CAP (1u << 18)

__device__ __forceinline__ unsigned xb_ld(unsigned* p)              { return __hip_atomic_load(p, __ATOMIC_RELAXED, __HIP_MEMORY_SCOPE_AGENT); }
__device__ __forceinline__ unsigned xb_add(unsigned* p, unsigned v) { return __hip_atomic_fetch_add(p, v, __ATOMIC_RELAXED, __HIP_MEMORY_SCOPE_AGENT); }
__device__ __forceinline__ unsigned xb_xcc_id() { return (unsigned)__builtin_amdgcn_s_getreg((3 << 11) | 20) & 0xFu; }
#define XB_SPIN(cond, bar) do { unsigned _sp = 0; while (cond) { __builtin_amdgcn_s_sleep(1); \
    if ((++_sp & 255u) == 0u) { if (xb_ld(&(bar)[XB_TMO])) break; if (_sp > XB_SPIN_CAP) { atomicAdd(&(bar)[XB_TMO], 1u); break; } } } } while (0)

struct XcdBarrier {
    unsigned* bar; unsigned x;
    volatile LAS unsigned* st;
};

__device__ __forceinline__ XcdBarrier xcd_barrier_post(unsigned* bar, volatile LAS unsigned* st) {
    XcdBarrier b; b.bar = bar; b.x = xb_xcc_id(); b.st = st;
    if (threadIdx.x == 0) (void)xb_add(&bar[XB_XCNT(b.x)], 1u);
    return b;
}
__device__ __forceinline__ void xcd_barrier_complete(unsigned* bar, unsigned x, unsigned& nloc, unsigned& nx) {
    const unsigned G = gridDim.x * gridDim.y * gridDim.z;
    unsigned sum, cnt, mine, sp = 0u;
    for (;;) {
        sum = 0u; cnt = 0u; mine = 0u;
#pragma unroll
        for (unsigned j = 0; j < 16; ++j) { const unsigned c = xb_ld(&bar[XB_XCNT(j)]); sum += c; cnt += (c > 0u) ? 1u : 0u; mine = (j == x) ? c : mine; }
        if (sum == G) break;
        __builtin_amdgcn_s_sleep(1);
        if ((++sp & 255u) == 0u) { if (xb_ld(&bar[XB_TMO])) break; if (sp > XB_SPIN_CAP) { atomicAdd(&bar[XB_TMO], 1u); break; } }
    }
    nloc = mine > 0u ? mine : 1u; nx = cnt > 0u ? cnt : 1u;
}

__device__ __forceinline__ void xcd_barrier(const XcdBarrier& b) {
    asm volatile("s_waitcnt vmcnt(0)" ::: "memory");
    __syncthreads();
    if (threadIdx.x == 0) {
        unsigned* bar = b.bar;
        __builtin_amdgcn_s_waitcnt(0);
        unsigned nloc = b.st[0], nx = b.st[1];
        if (nloc == 0u) { xcd_barrier_complete(bar, b.x, nloc, nx); b.st[0] = nloc; b.st[1] = nx; }
        const unsigned old = xb_add(&bar[XB_XSUB(b.x)], 1u);
        const unsigned gen = old / nloc;
        if (old + 1u == (gen + 1u) * nloc) {
            __builtin_amdgcn_fence(__ATOMIC_RELEASE, "agent");
            asm volatile("s_waitcnt vmcnt(0)" ::: "memory");
            const unsigned og = xb_add(&bar[XB_TOP], 1u);
            const unsigned tg = og / nx;
            if (og + 1u == (tg + 1u) * nx) xb_add(&bar[XB_TOPGEN], 1u);
            else XB_SPIN(xb_ld(&bar[XB_TOPGEN]) == tg, bar);
            __builtin_amdgcn_fence(__ATOMIC_ACQUIRE, "agent");
            xb_add(&bar[XB_XGEN(b.x)], 1u);
            asm volatile("s_waitcnt vmcnt(0)" ::: "memory");
        } else {
            XB_SPIN(xb_ld(&bar[XB_XGEN(b.x)]) == gen, bar);
            __builtin_amdgcn_fence(__ATOMIC_ACQUIRE, "agent");
            asm volatile("s_waitcnt vmcnt(0)" ::: "memory");
        }
    }
    __syncthreads();
}
DI void transpose_tile(float* tl, const float* W, int ldw, int k0, int nsrc0, int nvalid, const float* gain, bf16_t* Bt, int K, int ndst0) {
    const int tid = opaque_tid(), col = tid & 63, rb = tid >> 6;
    float v[32];
#pragma unroll
    for (int i = 0; i < 32; ++i) { const int kk = rb + 8 * i; v[i] = (col < nvalid) ? W[(size_t)(k0 + kk) * ldw + nsrc0 + col] : 0.f; }
#pragma unroll
    for (int i = 0; i < 32; ++i) { const int kk = rb + 8 * i; tl[kk * 65 + col] = gain ? v[i] * gain[k0 + kk] : v[i]; }
    __syncthreads();
    { const int n = tid >> 3, ks = (tid & 7) * 32;
#pragma unroll
      for (int g = 0; g < 4; ++g) { float f[8];
#pragma unroll
          for (int j = 0; j < 8; ++j) f[j] = tl[(ks + 8 * g + j) * 65 + n];
          *(uint4*)(Bt + (size_t)(ndst0 + n) * K + k0 + ks + 8 * g) = pack8(f); } }
    __syncthreads();
}

DI float rope_inv_freq(int fi) { return exp2f(-(float)(2 * fi) * (13.287712379549449f / 64.f)); }
DI float ret_inv_freq(int fi) { return exp2f(-(float)fi * (13.287712379549449f / 31.f)); }
template <class PT> DI void copy_cache(const PT& p, unsigned first, unsigned stride) {
    const unsigned per = 2047u * GW / 4, tot = per * 64 * 2;
    for (unsigned i0 = first; i0 < tot; i0 += 8 * stride) {
        f32x4 v[8]; f32x4* dp[8];
#pragma unroll
        for (int k = 0; k < 8; ++k) { const unsigned i = i0 + k * stride; dp[k] = nullptr;
            if (i < tot) { const unsigned which = i / (per * 64), rem = i % (per * 64); const size_t ln = rem / per, off = rem % per;
                const f32x4* src = (const f32x4*)(p.in[which ? I_CAV : I_CAK] + ln * 2048 * GW + GW) + off;
                dp[k] = (f32x4*)(p.out + (which ? O_SAV : O_SAK) + ln * 2048 * GW) + off;
                v[k] = __builtin_nontemporal_load(src); } }
#pragma unroll
        for (int k = 0; k < 8; ++k) if (dp[k]) __builtin_nontemporal_store(v[k], dp[k]); }
}
DI unsigned copy_idx(unsigned slot, int k, unsigned tid) { const unsigned tot = (2047u * GW / 4) * 128u; const unsigned i = slot * 4096u + (unsigned)k * 512u + tid; return i < tot ? i : tot - 1u; }
template <class PT> DI void copy_slot_load(const PT& p, unsigned slot, f32x4 (&v)[8]) {
    const unsigned per = 2047u * GW / 4, tid = (unsigned)opaque_tid();
#pragma unroll
    for (int k = 0; k < 8; ++k) { const unsigned i = copy_idx(slot, k, tid), which = i / (per * 64), rem = i % (per * 64); const size_t ln = rem / per, off = rem % per;
        v[k] = __builtin_nontemporal_load((const f32x4*)(p.in[which ? I_CAV : I_CAK] + ln * 2048 * GW + GW) + off); }
}
template <class PT> DI void copy_slot_store(const PT& p, unsigned slot, const f32x4 (&v)[8]) {
    const unsigned per = 2047u * GW / 4, tid = (unsigned)opaque_tid();
#pragma unroll
    for (int k = 0; k < 8; ++k) { const unsigned i = copy_idx(slot, k, tid), which = i / (per * 64), rem = i % (per * 64); const size_t ln = rem / per, off = rem % per;
        __builtin_nontemporal_store(v[k], (f32x4*)(p.out + (which ? O_SAV : O_SAK) + ln * 2048 * GW) + off); }
}
template <class PT> DI void weight_tile(float* tl, const PT& p, int l, int t) {
    if (t < 352) { const int kt = t / 88, nt = t % 88, nd = nt * 64; int ns, nv;
        if (nd < 2688) { ns = nd; nv = 64; } else if (nd < 5376) { ns = nd + 12; nv = 64; } else if (nd == 5376) { ns = 2688; nv = 12; } else { ns = 0; nv = 0; }
        transpose_tile(tl, p.in[I_W_IN] + (size_t)l * DM * NIN, NIN, kt * 256, ns, nv, p.in[I_NORM_MIX] + l * DM, (bf16_t*)(p.ws + WS_WT_IN + l * SZ_WT_IN), DM, nd); }
    else if (t < 352 + 96) { t -= 352; const int kt = t / 16, nt = t % 16;
        transpose_tile(tl, p.in[I_W_OUT] + (size_t)l * MIXW * DM, DM, kt * 256, nt * 64, 64, (const float*)nullptr, (bf16_t*)(p.ws + WS_WT_OUT + l * SZ_WT_OUT), MIXW, nt * 64); }
    else if (t < 352 + 96 + 256) { t -= 352 + 96; const int kt = t / 64, nt = t % 64;
        transpose_tile(tl, p.in[I_W_UP] + (size_t)l * DM * DFF, DFF, kt * 256, nt * 64, 64, p.in[I_NORM_FFN] + l * DM, (bf16_t*)(p.ws + WS_WT_UP + l * SZ_WT_UP), DM, nt * 64); }
    else { t -= 352 + 96 + 256; const int kt = t / 16, nt = t % 16;
        transpose_tile(tl, p.in[I_W_DOWN] + (size_t)l * DFF * DM, DM, kt * 256, nt * 64, 64, (const float*)nullptr, (bf16_t*)(p.ws + WS_WT_DOWN + l * SZ_WT_DOWN), DFF, nt * 64); }
}
template <class PT> DI void deferred_weight_tiles(unsigned char* smem, const PT& p, int list, int first, int stride) {
    float* tl = (float*)smem; const int n = list == 2 ? 352 : 608;
    for (int i = first; i < n; i += stride) { if (list == 0) weight_tile(tl, p, 0, 352 + i); else if (list == 1) weight_tile(tl, p, 1, 352 + i); else weight_tile(tl, p, 1, i); }
}
template <class PT> DI void phase0(unsigned char* smem, const PT& p) {
    const int G = gridDim.x, b = blockIdx.x, tid = opaque_tid(), wid = tid >> 6, lane = tid & 63;
    float* tl = (float*)smem;
    for (int task = b; task < 352; task += G) weight_tile(tl, p, 0, task);
    for (int row = b * 8 + wid; row < MP + MD; row += G * 8) {
        const bool dec = row >= MP; const int r = dec ? row - MP : row;
        const float* src = dec ? p.in[I_XS] + (size_t)r * DM : p.in[I_XP] + (size_t)r * DM;
        bf16_t* dst = dec ? (bf16_t*)(p.ws + WS_XSB) + (size_t)r * DM : (bf16_t*)(p.ws + WS_XB) + (size_t)r * DM;
        float ss = 0.f;
#pragma unroll
        for (int i = 0; i < 4; ++i) { const float4 v = *(const float4*)(src + i * 256 + lane * 4); ss += v.x * v.x + v.y * v.y + v.z * v.z + v.w * v.w;
            uint2 w; w.x = pack2(v.x, v.y); w.y = pack2(v.z, v.w); *(uint2*)(dst + i * 256 + lane * 4) = w; }
        ss = wave_sum(ss);
        if (dec) { float* s = (float*)(p.ws + WS_ROWSS_S) + (size_t)r * 32; if (lane < 32) s[lane] = lane == 0 ? ss : 0.f; }
        else { float* s = (float*)(p.ws + WS_ROWSS) + (size_t)r * 16; if (lane < 16) s[lane] = lane == 0 ? ss : 0.f; }
    }
    for (int i = b * 512 + tid; i < 2 * T_ * 32; i += G * 512) { const int which = i / (T_ * 32), t = (i / 32) % T_, fi = i & 31;
        float sn, cs; sincosf((float)t * (which ? ret_inv_freq(fi) : rope_inv_freq(fi)), &sn, &cs);
        ((float2*)(p.ws + WS_TRIG))[i] = make_float2(cs, sn); }
#ifdef COPY_IN_P0
    copy_cache(p, (unsigned)b * 512 + tid, (unsigned)G * 512);
#endif
}

template <class PT> DI void aprep_task(unsigned char* smem, const PT& p, int l, int task) {
    const int n = task / (NH * 64), h = (task / 64) % NH, tile = task % 64;
    const int tid = opaque_tid(), i = tid >> 3, seg = tid & 7, t = tile * 64 + i;
    const bf16_t* zrow = (const bf16_t*)(p.ws + WS_R1) + (size_t)(n * T_ + t) * ZS;
    const size_t hoff = ((size_t)(n * NH + h) * T_ + t) * HD + 8 * seg;
    const uint4 rawq = *(const uint4*)(zrow + AQ + h * 64 + 8 * seg), rawk = *(const uint4*)(zrow + AK + h * 64 + 8 * seg), rawv = *(const uint4*)(zrow + AV + h * 64 + 8 * seg);
    float gq[8], gk[8];
    { const float* g0 = p.in[I_QNORM] + l * HD + 8 * seg; const float* g1 = p.in[I_KNORM] + l * HD + 8 * seg;
#pragma unroll
      for (int j = 0; j < 8; ++j) { gq[j] = g0[j]; gk[j] = g1[j]; } }
    float cs[8], sn[8];
    { const float4* tp = (const float4*)((const float2*)(p.ws + WS_TRIG) + (size_t)t * 32 + ((8 * seg) & 31));
#pragma unroll
      for (int j = 0; j < 4; ++j) { const float4 v = tp[j]; cs[2 * j] = v.x; sn[2 * j] = v.y; cs[2 * j + 1] = v.z; sn[2 * j + 1] = v.w; } }
#pragma unroll
    for (int which = 0; which < 2; ++which) {
        float x[8]; unpack8(which ? rawk : rawq, x);
        float ss = 0.f;
#pragma unroll
        for (int j = 0; j < 8; ++j) ss += x[j] * x[j];
        ss += __shfl_xor(ss, 1); ss += __shfl_xor(ss, 2); ss += __shfl_xor(ss, 4);
        const float r = rsqrtf(ss * (1.f / 64.f) + EPS);
        float y[8], o[8];
#pragma unroll
        for (int j = 0; j < 8; ++j) y[j] = x[j] * r * (which ? gk[j] : gq[j]);
#pragma unroll
        for (int j = 0; j < 8; ++j) { const float pr = __shfl_xor(y[j], 4); o[j] = (seg < 4) ? (y[j] * cs[j] - pr * sn[j]) : (y[j] * cs[j] + pr * sn[j]); }
        if (which == 0) {
#pragma unroll
            for (int j = 0; j < 8; ++j) o[j] *= 0.125f;
            *(uint4*)((bf16_t*)(p.ws + WS_QA) + hoff) = pack8(o);
        } else {
            *(uint4*)((bf16_t*)(p.ws + WS_KA) + hoff) = pack8(o);
            if (t >= T_ - 2048) { float* d = p.out + O_PAK + (((size_t)(l * NBAT + n) * 2048 + (t - (T_ - 2048))) * NH + h) * HD + 8 * seg;
                *(float4*)d = make_float4(o[0], o[1], o[2], o[3]); *(float4*)(d + 4) = make_float4(o[4], o[5], o[6], o[7]); }
        }
    }
    unsigned short* vt = (unsigned short*)smem;
    { float x[8]; unpack8(rawv, x);
      if (t >= T_ - 2048) { float* d = p.out + O_PAV + (((size_t)(l * NBAT + n) * 2048 + (t - (T_ - 2048))) * NH + h) * HD + 8 * seg;
          *(float4*)d = make_float4(x[0], x[1], x[2], x[3]); *(float4*)(d + 4) = make_float4(x[4], x[5], x[6], x[7]); }
#pragma unroll
      for (int j = 0; j < 8; ++j) vt[i * 66 + 8 * seg + j] = f2bf(x[j]); }
    __syncthreads();
    { const int dim = tid >> 3, ts = tid & 7; unsigned short e[8];
#pragma unroll
      for (int j = 0; j < 8; ++j) e[j] = vt[(8 * ts + j) * 66 + dim];
      const int tb = tile * 64 + 8 * ts;
      bf16_t* base = (bf16_t*)(p.ws + WS_VT) + ((size_t)(n * NH + h) * HD + dim) * T_;
      uint4 w; w.x = e[0] | ((unsigned)e[1] << 16); w.y = e[2] | ((unsigned)e[3] << 16); w.z = e[4] | ((unsigned)e[5] << 16); w.w = e[6] | ((unsigned)e[7] << 16);
      *(uint4*)(base + tb) = w;
      bf16_t* b4 = base + SZ_HEADBUF / 2;
#pragma unroll
      for (int rr = 0; rr < 4; ++rr) *(unsigned*)(b4 + rr * 1024 + tb / 4) = e[rr] | ((unsigned)e[rr + 4] << 16);
      bf16_t* b16 = base + SZ_HEADBUF;
#pragma unroll
      for (int j = 0; j < 8; ++j) b16[(8 * (ts & 1) + j) * 256 + tb / 16] = e[j]; }
    __syncthreads();
}

template <class PT> DI void dmix_task(const PT& p, int l, int task) {
    const int n = task / 64, tile = task % 64, tid = opaque_tid();
    const bf16_t* zb = (const bf16_t*)(p.ws + WS_R1) + (size_t)n * T_ * ZS;
    const float* cw = p.in[I_CONVD] + (size_t)l * 3 * GW;
    for (int item = tid; item < 64 * 48; item += 512) {
        const int i = item / 48, cg8 = (item % 48) * 8, t = tile * 64 + i;
        float prod[3][8];
#pragma unroll
        for (int j = 0; j < 3; ++j) { const int tt = t - 2 + j;
            if (tt >= 0) { float a[8], c[8]; unpack8(*(const uint4*)(zb + (size_t)tt * ZS + DX + cg8), a); unpack8(*(const uint4*)(zb + (size_t)tt * ZS + DC + cg8), c);
#pragma unroll
                for (int e = 0; e < 8; ++e) prod[j][e] = a[e] * c[e]; }
            else {
#pragma unroll
                for (int e = 0; e < 8; ++e) prod[j][e] = 0.f; } }
        float bb[8], o[8]; unpack8(*(const uint4*)(zb + (size_t)t * ZS + DB + cg8), bb);
#pragma unroll
        for (int e = 0; e < 8; ++e) o[e] = bb[e] * (prod[0][e] * cw[cg8 + e] + prod[1][e] * cw[GW + cg8 + e] + prod[2][e] * cw[2 * GW + cg8 + e]);
        *(uint4*)((bf16_t*)(p.ws + WS_MIX) + (size_t)(n * T_ + t) * MIXW + 3 * GW + cg8) = pack8(o);
        if (t >= T_ - 2) { float* d = p.out + O_PDCONV + ((size_t)(l * NBAT + n) * 2 + (t - (T_ - 2))) * GW + cg8;
#pragma unroll
            for (int e = 0; e < 8; ++e) d[e] = prod[2][e]; }
    }
    if (tile == 63) for (int item = tid; item < 3 * 1152; item += 512) { const int rr = item / 1152, c = item % 1152;
        p.out[O_PBCONV + ((size_t)(l * NBAT + n) * 3 + rr) * 1152 + c] = bf2f(zb[(size_t)(T_ - 3 + rr) * ZS + BQ + c]); }
}

template <bool IS_B, class PT> DI void chunk_prep(unsigned char* smem, const PT& p, int l, int task) {
    const int nh = task / 64, ch = task % 64, n = nh / NH, h = nh % NH;
    float* qs = (float*)smem; float* ks = qs + 64 * 68; float* vs = ks + 64 * 68; float* As = vs + 64 * 68; float* Gs = As + 4096; float* betas = Gs + 64; float* graw = betas + 64;
    const int tid = opaque_tid(), i = tid >> 3, seg = tid & 7, t = ch * 64 + i;
    const bf16_t* zrow = (const bf16_t*)(p.ws + WS_R1) + (size_t)(n * T_ + t) * ZS;
    bf16_t* blk = IS_B ? (bf16_t*)(p.ws + WS_BBLK + (size_t)task * 40960) : (bf16_t*)(p.ws + WS_CBLK + (size_t)task * 32768);
    bf16_t* o_w = blk; bf16_t* o_kdt = IS_B ? blk + 4096 : blk; bf16_t* o_qg = o_kdt + 4096; bf16_t* o_qk = o_qg + 4096; bf16_t* o_ut = o_qk + 4096;
    const float lg = IS_B ? 0.f : __logf(1.f - exp2f(-5.f - (float)h));
    if (IS_B) {
        const float* cwb = p.in[I_CONVB] + (size_t)l * 4 * 1152;
        float res[3][8];
        uint4 zr[3][4];
#pragma unroll
        for (int which = 0; which < 3; ++which)
#pragma unroll
            for (int j = 0; j < 4; ++j) { const int back = (t - 3 + j >= 0) ? (j - 3) : 0;
                zr[which][j] = *(const uint4*)(zrow + (ptrdiff_t)back * ZS + BQ + which * GW + h * 64 + 8 * seg); }
#pragma unroll
        for (int which = 0; which < 3; ++which) {
            float a[8];
#pragma unroll
            for (int e = 0; e < 8; ++e) a[e] = 0.f;
            const int co = which * GW + h * 64 + 8 * seg;
            float4 w0[4], w1[4];
#pragma unroll
            for (int j = 0; j < 4; ++j) { w0[j] = *(const float4*)(cwb + j * 1152 + co); w1[j] = *(const float4*)(cwb + j * 1152 + co + 4); }
#pragma unroll
            for (int j = 0; j < 4; ++j) { const float mk = (t - 3 + j >= 0) ? 1.f : 0.f; float x[8]; unpack8(zr[which][j], x);
                a[0] += mk * x[0] * w0[j].x; a[1] += mk * x[1] * w0[j].y; a[2] += mk * x[2] * w0[j].z; a[3] += mk * x[3] * w0[j].w;
                a[4] += mk * x[4] * w1[j].x; a[5] += mk * x[5] * w1[j].y; a[6] += mk * x[6] * w1[j].z; a[7] += mk * x[7] * w1[j].w; }
#pragma unroll
            for (int e = 0; e < 8; ++e) a[e] = silu_f(a[e]);
            if (which < 2) { float ss = 0.f;
#pragma unroll
                for (int e = 0; e < 8; ++e) ss += a[e] * a[e];
                ss += __shfl_xor(ss, 1); ss += __shfl_xor(ss, 2); ss += __shfl_xor(ss, 4);
                const float r = rsqrtf(ss + EPS) * (which == 0 ? 0.125f : 1.f);
#pragma unroll
                for (int e = 0; e < 8; ++e) a[e] *= r; }
#pragma unroll
            for (int e = 0; e < 8; ++e) res[which][e] = a[e];
        }
        float gA = 0.f, gB = 0.f;
        if (seg == 0) { const float za = bf2f(zrow[GA + h]), zb = bf2f(zrow[GB + h]);
            const float xx = za + p.in[I_DTBIAS][l * NH + h]; const float sp = xx > 20.f ? xx : __logf(1.f + __expf(xx));
            gA = -__expf(p.in[I_ALOG][l * NH + h]) * sp; gB = 1.f / (1.f + __expf(-zb)); }
#pragma unroll
        for (int which = 0; which < 3; ++which) { float* dst = (which == 0 ? qs : which == 1 ? ks : vs) + i * 68 + 8 * seg;
            *(float4*)dst = make_float4(res[which][0], res[which][1], res[which][2], res[which][3]); *(float4*)(dst + 4) = make_float4(res[which][4], res[which][5], res[which][6], res[which][7]); }
        if (seg == 0) { graw[i] = gA; betas[i] = gB; }
        __syncthreads();
        if (tid < 64) { float v = graw[tid];
#pragma unroll
            for (int off = 1; off < 64; off <<= 1) { const float u = __shfl_up(v, off); if (tid >= off) v += u; }
            Gs[tid] = v; }
        __syncthreads();
    } else {
        const uint4 rawq = *(const uint4*)(zrow + CQ + h * 64 + 8 * seg), rawk = *(const uint4*)(zrow + CK + h * 64 + 8 * seg), rawv = *(const uint4*)(zrow + CV + h * 64 + 8 * seg);
        float cs[8], sn[8];
        { const float4* tp = (const float4*)((const float2*)(p.ws + WS_TRIG) + (size_t)(T_ + t) * 32 + ((8 * seg) & 31));
#pragma unroll
          for (int j = 0; j < 4; ++j) { const float4 v = tp[j]; cs[2 * j] = v.x; sn[2 * j] = v.y; cs[2 * j + 1] = v.z; sn[2 * j + 1] = v.w; } }
#pragma unroll
        for (int which = 0; which < 2; ++which) {
            float y[8], o[8]; unpack8(which ? rawk : rawq, y);
#pragma unroll
            for (int j = 0; j < 8; ++j) { const float pr = __shfl_xor(y[j], 4); o[j] = (seg < 4) ? (y[j] * cs[j] - pr * sn[j]) : (y[j] * cs[j] + pr * sn[j]); if (which) o[j] *= 0.125f; }
            float* dst = (which ? ks : qs) + i * 68 + 8 * seg;
            *(float4*)dst = make_float4(o[0], o[1], o[2], o[3]); *(float4*)(dst + 4) = make_float4(o[4], o[5], o[6], o[7]);
        }
        { float x[8]; unpack8(rawv, x); float* dst = vs + i * 68 + 8 * seg;
          *(float4*)dst = make_float4(x[0], x[1], x[2], x[3]); *(float4*)(dst + 4) = make_float4(x[4], x[5], x[6], x[7]); }
        if (tid < 64) Gs[tid] = (float)(tid + 1) * lg;
        __syncthreads();
    }
    { unsigned short* QH = (unsigned short*)(graw + 64 + 8192); unsigned short* KH = QH + 64 * 72; unsigned short* KL = KH + 64 * 72;
      { float a[8], b8[8];
        { const float4 x0 = *(const float4*)(qs + i * 68 + 8 * seg), x1 = *(const float4*)(qs + i * 68 + 8 * seg + 4); a[0] = x0.x; a[1] = x0.y; a[2] = x0.z; a[3] = x0.w; a[4] = x1.x; a[5] = x1.y; a[6] = x1.z; a[7] = x1.w; }
        *(uint4*)(QH + i * 72 + 8 * seg) = pack8(a);
        { const float4 x0 = *(const float4*)(ks + i * 68 + 8 * seg), x1 = *(const float4*)(ks + i * 68 + 8 * seg + 4); a[0] = x0.x; a[1] = x0.y; a[2] = x0.z; a[3] = x0.w; a[4] = x1.x; a[5] = x1.y; a[6] = x1.z; a[7] = x1.w; }
        const uint4 kh = pack8(a); *(uint4*)(KH + i * 72 + 8 * seg) = kh;
        if (IS_B) { float hf[8]; unpack8(kh, hf);
#pragma unroll
            for (int e = 0; e < 8; ++e) b8[e] = a[e] - hf[e];
            *(uint4*)(KL + i * 72 + 8 * seg) = pack8(b8); } }
      __syncthreads();
      const int wid = tid >> 6, lane = tid & 63, col = lane & 15, quad = lane >> 4, it = wid >> 1;
      bf16x8 qa[2], ka[2], la[2];
#pragma unroll
      for (int ksx = 0; ksx < 2; ++ksx) { qa[ksx] = *(const bf16x8*)(QH + (16 * it + col) * 72 + 32 * ksx + 8 * quad); ka[ksx] = *(const bf16x8*)(KH + (16 * it + col) * 72 + 32 * ksx + 8 * quad);
          if (IS_B) la[ksx] = *(const bf16x8*)(KL + (16 * it + col) * 72 + 32 * ksx + 8 * quad); }
#pragma unroll
      for (int jj = 0; jj < 2; ++jj) { const int jt = (wid & 1) * 2 + jj;
          f32x4 aqk = (f32x4){0.f, 0.f, 0.f, 0.f}, akk = (f32x4){0.f, 0.f, 0.f, 0.f};
#pragma unroll
          for (int ksx = 0; ksx < 2; ++ksx) { const bf16x8 kb = *(const bf16x8*)(KH + (16 * jt + col) * 72 + 32 * ksx + 8 * quad);
              aqk = MFMA16(qa[ksx], kb, aqk);
              if (IS_B) { const bf16x8 lb = *(const bf16x8*)(KL + (16 * jt + col) * 72 + 32 * ksx + 8 * quad);
                  akk = MFMA16(ka[ksx], kb, akk); akk = MFMA16(ka[ksx], lb, akk); akk = MFMA16(la[ksx], kb, akk); } }
          const int j = 16 * jt + col; const float Gj = Gs[j];
          const float4 g4 = *(const float4*)(Gs + 16 * it + 4 * quad); const float gi[4] = {g4.x, g4.y, g4.z, g4.w};
          float bt[4] = {0.f, 0.f, 0.f, 0.f};
          if (IS_B) { const float4 b4 = *(const float4*)(betas + 16 * it + 4 * quad); bt[0] = b4.x; bt[1] = b4.y; bt[2] = b4.z; bt[3] = b4.w; }
#pragma unroll
          for (int r = 0; r < 4; ++r) { const int ii = 16 * it + 4 * quad + r; const float ex = __expf(fminf(gi[r] - Gj, 0.f)); const float dec = (ii >= j) ? ex : 0.f;
              o_qk[ii * 64 + j] = f2bf(aqk[r] * dec);
              if (IS_B) As[ii * 64 + j] = (ii > j) ? bt[r] * akk[r] * dec : 0.f; } } }
    { const float eg = __expf(Gs[i]); float o[8];
#pragma unroll
      for (int e = 0; e < 8; ++e) o[e] = qs[i * 68 + 8 * seg + e] * eg;
      *(uint4*)(o_qg + i * 64 + 8 * seg) = pack8(o);
      const int d = i; const float G63 = Gs[63];
#pragma unroll
      for (int e = 0; e < 8; ++e) { const int j = 8 * seg + e; o[e] = ks[j * 68 + d] * __expf(G63 - Gs[j]); }
      *(uint4*)(o_kdt + d * 64 + 8 * seg) = pack8(o);
      if (!IS_B) {
#pragma unroll
          for (int e = 0; e < 8; ++e) o[e] = vs[(8 * seg + e) * 68 + d];
          *(uint4*)(o_ut + d * 64 + 8 * seg) = pack8(o); }
      if (IS_B && tid == 0) ((float*)(p.ws + WS_DLB))[task] = __expf(G63); }
    __syncthreads();
    if (IS_B) {
        float* Xs = graw + 64;
        float* TMP = Xs + 8192 + 6912;
        float* Ti = TMP + 2048;
        { const int c = tid & 127, pt = tid >> 7;
#pragma unroll 4
          for (int k = 0; k < 16; ++k) { const int i2 = pt * 16 + k;
              Xs[i2 * 128 + c] = (c < 64) ? betas[i2] * vs[i2 * 68 + c] : betas[i2] * __expf(Gs[i2]) * ks[i2 * 68 + (c - 64)]; } }
        if (tid < 64) { const int bb = tid >> 4, c = tid & 15; float t[16];
#pragma unroll
            for (int i2 = 0; i2 < 16; ++i2) { float sx = (i2 == c) ? 1.f : 0.f;
#pragma unroll
                for (int j = 0; j < i2; ++j) sx -= As[(16 * bb + i2) * 64 + 16 * bb + j] * t[j];
                t[i2] = sx; }
#pragma unroll
            for (int i2 = 0; i2 < 16; ++i2) Ti[bb * 256 + i2 * 16 + c] = t[i2]; }
        __syncthreads();
#pragma unroll 1
        for (int rb = 0; rb < 4; ++rb) {
            const int c = tid & 127, pt = tid >> 7, r0 = 16 * rb + 4 * pt;
            { float a0 = 0.f, a1 = 0.f, a2 = 0.f, a3 = 0.f;
#pragma unroll 4
              for (int j = 0; j < 16 * rb; ++j) { const float x = Xs[j * 128 + c];
                  a0 += As[(r0 + 0) * 64 + j] * x; a1 += As[(r0 + 1) * 64 + j] * x; a2 += As[(r0 + 2) * 64 + j] * x; a3 += As[(r0 + 3) * 64 + j] * x; }
              TMP[(4 * pt + 0) * 128 + c] = Xs[(r0 + 0) * 128 + c] - a0; TMP[(4 * pt + 1) * 128 + c] = Xs[(r0 + 1) * 128 + c] - a1;
              TMP[(4 * pt + 2) * 128 + c] = Xs[(r0 + 2) * 128 + c] - a2; TMP[(4 * pt + 3) * 128 + c] = Xs[(r0 + 3) * 128 + c] - a3; }
            __syncthreads();
            { float o0 = 0.f, o1 = 0.f, o2 = 0.f, o3 = 0.f; const float* tr = Ti + rb * 256 + (4 * pt) * 16;
#pragma unroll
              for (int j = 0; j < 16; ++j) { const float x = TMP[j * 128 + c];
                  o0 += tr[j] * x; o1 += tr[16 + j] * x; o2 += tr[32 + j] * x; o3 += tr[48 + j] * x; }
              Xs[(r0 + 0) * 128 + c] = o0; Xs[(r0 + 1) * 128 + c] = o1; Xs[(r0 + 2) * 128 + c] = o2; Xs[(r0 + 3) * 128 + c] = o3; }
            __syncthreads();
        }
        { const int e = tid >> 3, g = tid & 7; float o[8];
#pragma unroll
          for (int k = 0; k < 8; ++k) o[k] = Xs[(8 * g + k) * 128 + e];
          *(uint4*)(o_ut + e * 64 + 8 * g) = pack8(o);
#pragma unroll
          for (int k = 0; k < 8; ++k) o[k] = Xs[e * 128 + 64 + 8 * g + k];
          *(uint4*)(o_w + e * 64 + 8 * g) = pack8(o); }
    }
    __syncthreads();
}
template <class PT> DI void decode_task(unsigned char* smem, const PT& p, int l, int bt) {
    const int tid = opaque_tid(), wid = tid >> 6, lane = tid & 63;
    float* wl = (float*)smem + wid * 576;
    const int gw = bt * 8 + wid;
    const float pos = 16384.f;
    if (gw < 192) {
        const int n = gw / 6, h = gw % 6; const int fi = lane & 31;
        const float* zr = (const float*)(p.ws + WS_ZD) + (size_t)n * ZS; bf16_t* mixs = (bf16_t*)(p.ws + WS_MIXS) + (size_t)n * MIXW;
        float sn, cs; sincosf(pos * rope_inv_freq(fi), &sn, &cs);
        float q = zr[AQ + h * 64 + lane], k = zr[AK + h * 64 + lane]; const float v = zr[AV + h * 64 + lane];
        { const float r = rsqrtf(wave_sum(q * q) * (1.f / 64.f) + EPS); q = q * r * p.in[I_QNORM][l * HD + lane];
          const float pr = __shfl_xor(q, 32); q = (lane < 32) ? (q * cs - pr * sn) : (q * cs + pr * sn); q *= 0.125f; }
        { const float r = rsqrtf(wave_sum(k * k) * (1.f / 64.f) + EPS); k = k * r * p.in[I_KNORM][l * HD + lane];
          const float pr = __shfl_xor(k, 32); k = (lane < 32) ? (k * cs - pr * sn) : (k * cs + pr * sn); }
        p.out[O_SAK + (((size_t)(l * MD + n) * 2048 + 2047) * NH + h) * HD + lane] = k;
        p.out[O_SAV + (((size_t)(l * MD + n) * 2048 + 2047) * NH + h) * HD + lane] = v;
        wl[lane] = q; wl[512 + lane] = v;
        const float snew = wave_sum(q * k);
        const float* ck = p.in[I_CAK] + (size_t)(l * MD + n) * 2048 * GW + h * HD;
        const float* cv = p.in[I_CAV] + (size_t)(l * MD + n) * 2048 * GW + h * HD;
        float mx = snew;
#pragma unroll 1
        for (int it = 0; it < 7; ++it) { const int e = it * 64 + lane; float s = -1e30f;
            if (e < 387) { const int br = e / 129, j = e % 129; const int dil = br == 0 ? 1 : (br == 1 ? 4 : 16);
                if (j == 0) s = snew; else { const float* kr = ck + (size_t)(2048 - dil * j) * GW; float4 kv[16];
#pragma unroll
                    for (int d4 = 0; d4 < 16; ++d4) kv[d4] = *(const float4*)(kr + 4 * d4);
                    float a = 0.f;
#pragma unroll
                    for (int d4 = 0; d4 < 16; ++d4) a += kv[d4].x * wl[4 * d4] + kv[d4].y * wl[4 * d4 + 1] + kv[d4].z * wl[4 * d4 + 2] + kv[d4].w * wl[4 * d4 + 3];
                    s = a; } }
            wl[64 + e] = s; mx = fmaxf(mx, s); }
        mx = wave_max(mx); float sum = 0.f;
#pragma unroll 1
        for (int it = 0; it < 7; ++it) { const int e = it * 64 + lane; const float pe = (e < 387) ? __expf(wl[64 + e] - mx) : 0.f; sum += pe; wl[64 + e] = pe; }
        sum = wave_sum(sum);
        const int g = lane >> 4, dl4 = (lane & 15) * 4;
        float4 acc = make_float4(0.f, 0.f, 0.f, 0.f);
#pragma unroll 8
        for (int it = 0; it < 97; ++it) { const int e = 4 * it + g; const int ee = e < 387 ? e : 386; const int br = ee / 129, j = ee % 129; const int dil = br == 0 ? 1 : (br == 1 ? 4 : 16);
            const float pe = (e < 387 && j != 0) ? wl[64 + ee] : 0.f; const int row = j != 0 ? 2048 - dil * j : 0;
            const float4 vv = *(const float4*)(cv + (size_t)row * GW + dl4);
            acc.x += pe * vv.x; acc.y += pe * vv.y; acc.z += pe * vv.z; acc.w += pe * vv.w; }
        acc.x += __shfl_xor(acc.x, 16); acc.y += __shfl_xor(acc.y, 16); acc.z += __shfl_xor(acc.z, 16); acc.w += __shfl_xor(acc.w, 16);
        acc.x += __shfl_xor(acc.x, 32); acc.y += __shfl_xor(acc.y, 32); acc.z += __shfl_xor(acc.z, 32); acc.w += __shfl_xor(acc.w, 32);
        if (lane < 16) { const float pn = wl[64] + wl[64 + 129] + wl[64 + 258], inv = 1.f / sum;
            uint2 w; w.x = pack2((acc.x + pn * wl[512 + dl4]) * inv, (acc.y + pn * wl[512 + dl4 + 1]) * inv); w.y = pack2((acc.z + pn * wl[512 + dl4 + 2]) * inv, (acc.w + pn * wl[512 + dl4 + 3]) * inv);
            *(uint2*)(mixs + h * 64 + dl4) = w; }
    } else if (gw < 384) {
        const int n = (gw - 192) / 6, h = (gw - 192) % 6; float qkv[3];
        const float* zr = (const float*)(p.ws + WS_ZD) + (size_t)n * ZS; bf16_t* mixs = (bf16_t*)(p.ws + WS_MIXS) + (size_t)n * MIXW;
        const float* sb = p.in[I_SBCONV] + (size_t)(l * MD + n) * 3 * 1152; const float* cwb = p.in[I_CONVB] + (size_t)l * 4 * 1152;
        float* sbo = p.out + O_SBCONV + (size_t)(l * MD + n) * 3 * 1152;
#pragma unroll
        for (int which = 0; which < 3; ++which) { const int c = which * GW + h * 64 + lane; const float xn = zr[BQ + c];
            const float s0 = sb[c], s1 = sb[1152 + c], s2 = sb[2 * 1152 + c];
            qkv[which] = silu_f(s0 * cwb[c] + s1 * cwb[1152 + c] + s2 * cwb[2 * 1152 + c] + xn * cwb[3 * 1152 + c]);
            sbo[c] = s1; sbo[1152 + c] = s2; sbo[2 * 1152 + c] = xn; }
        const float q = qkv[0] * rsqrtf(wave_sum(qkv[0] * qkv[0]) + EPS) * 0.125f, k = qkv[1] * rsqrtf(wave_sum(qkv[1] * qkv[1]) + EPS), v = qkv[2];
        const float beta = 1.f / (1.f + __expf(-zr[GB + h])); const float xx = zr[GA + h] + p.in[I_DTBIAS][l * NH + h];
        const float sp = xx > 20.f ? xx : __logf(1.f + __expf(xx)); const float eg = __expf(-__expf(p.in[I_ALOG][l * NH + h]) * sp);
        const float* S0 = p.in[I_SBREC] + (size_t)((l * MD + n) * NH + h) * 4096; float* S1 = p.out + O_SBREC + (size_t)((l * MD + n) * NH + h) * 4096;
        float kS = 0.f;
#pragma unroll 16
        for (int d = 0; d < 64; ++d) kS += __shfl(k, d) * S0[d * 64 + lane];
        const float vn = beta * (v - eg * kS); float o = 0.f;
#pragma unroll 16
        for (int d = 0; d < 64; ++d) { const float sv = eg * S0[d * 64 + lane] + __shfl(k, d) * vn; S1[d * 64 + lane] = sv; o += __shfl(q, d) * sv; }
        const float r = rsqrtf(wave_sum(o * o) * (1.f / 64.f) + EPS);
        mixs[GW + h * 64 + lane] = f2bf(o * r * p.in[I_ONORMB][l * HD + lane] * silu_f(zr[BZ + h * 64 + lane]));
    } else if (gw < 576) {
        const int n = (gw - 384) / 6, h = (gw - 384) % 6; const int fi = lane & 31;
        const float* zr = (const float*)(p.ws + WS_ZD) + (size_t)n * ZS; bf16_t* mixs = (bf16_t*)(p.ws + WS_MIXS) + (size_t)n * MIXW;
        float sn, cs; sincosf(pos * ret_inv_freq(fi), &sn, &cs);
        float q = zr[CQ + h * 64 + lane], k = zr[CK + h * 64 + lane]; const float v = zr[CV + h * 64 + lane];
        { const float pr = __shfl_xor(q, 32); q = (lane < 32) ? (q * cs - pr * sn) : (q * cs + pr * sn); }
        { const float pr = __shfl_xor(k, 32); k = (lane < 32) ? (k * cs - pr * sn) : (k * cs + pr * sn); k *= 0.125f; }
        const float gam = 1.f - exp2f(-5.f - (float)h);
        const float* S0 = p.in[I_SCREC] + (size_t)((l * MD + n) * NH + h) * 4096; float* S1 = p.out + O_SCREC + (size_t)((l * MD + n) * NH + h) * 4096;
        float o = 0.f;
#pragma unroll 16
        for (int d = 0; d < 64; ++d) { const float sv = gam * S0[d * 64 + lane] + __shfl(k, d) * v; S1[d * 64 + lane] = sv; o += __shfl(q, d) * sv; }
        const float r = rsqrtf(wave_sum(o * o) * (1.f / 64.f) + EPS);
        mixs[2 * GW + h * 64 + lane] = f2bf(o * r * p.in[I_ONORMC][l * HD + lane] * silu_f(zr[CG + h * 64 + lane]));
    } else if (gw < 608) {
        const int n = gw - 576;
        const float* zr = (const float*)(p.ws + WS_ZD) + (size_t)n * ZS; bf16_t* mixs = (bf16_t*)(p.ws + WS_MIXS) + (size_t)n * MIXW;
        const float* sd = p.in[I_SDCONV] + (size_t)(l * MD + n) * 2 * GW; const float* cw = p.in[I_CONVD] + (size_t)l * 3 * GW;
        float* sdo = p.out + O_SDCONV + (size_t)(l * MD + n) * 2 * GW;
        for (int c = lane; c < GW; c += 64) { const float pr = zr[DC + c] * zr[DX + c]; const float s0 = sd[c], s1 = sd[GW + c];
            mixs[3 * GW + c] = f2bf(zr[DB + c] * (s0 * cw[c] + s1 * cw[GW + c] + pr * cw[2 * GW + c]));
            sdo[c] = s1; sdo[GW + c] = pr; }
    }
    __syncthreads();
}
DI bf16x8 packB(const f32x4& x0, const f32x4& x1) { return mk8(pack2(x0[0], x0[1]), pack2(x0[2], x0[3]), pack2(x1[0], x1[1]), pack2(x1[2], x1[3])); }
DI bf16x8 afrag(LAS unsigned char* lds, unsigned tilebase, int it, int ks, int col, int q) {
    const unsigned a = tilebase + (unsigned)(16 * it + col) * 144u + (unsigned)(32 * ks + 4 * q) * 2u;
    const u32x2 lo = *(const LAS u32x2*)(lds + a), hi = *(const LAS u32x2*)(lds + a + 32);
    return mk8(lo.x, lo.y, hi.x, hi.y);
}
template <int ROLE, class PT> DI void chain_phase(unsigned char* smem, const PT& p, int l, int nh) {
    LAS unsigned char* lds = (LAS unsigned char*)smem;
    const int tid = opaque_tid(), wid = tid >> 6, lane = tid & 63, col = lane & 15, q = lane >> 4, chain = wid >> 2, w = wid & 3;
    const int n = nh / NH, h = nh % NH;
    const unsigned T_W = 0u, T_KDT = chain ? 27648u : 9216u, T_UT = chain ? 36864u : 18432u;
    const float* dlb = (const float*)(p.ws + WS_DLB) + nh * 64;
    bf16_t* stp = (bf16_t*)(p.ws + (chain ? WS_STC : WS_STB)) + (size_t)nh * 64 * 4096 + (16 * w + col) * 64 + 4 * q;
    bf16_t* vnp = (bf16_t*)(p.ws + WS_VNB) + (size_t)nh * 64 * 4096 + (16 * w + col) * 64 + 4 * q;
    if (chain != ROLE) {
        constexpr int NPC = ROLE == 0 ? 6 : 4;
        const int ht = tid & 255;
        const unsigned char* src = ROLE == 0 ? p.ws + WS_BBLK + (size_t)nh * 64 * 40960 : p.ws + WS_CBLK + (size_t)nh * 64 * 32768;
        constexpr size_t CST = ROLE == 0 ? 40960 : 32768;
        u32x4 rA[NPC], rB[NPC], rC[NPC], rD[NPC];
#define CH_SRC(j) ((ROLE == 0 ? ((j) >> 1) == 0 ? 0u : ((j) >> 1) == 1 ? 8192u : 32768u : ((j) >> 1) == 0 ? 0u : 24576u) + (unsigned)(ht + 256 * ((j) & 1)) * 16u)
#define CH_DST(j) ((ROLE == 0 ? 0u : 27648u) + (unsigned)((j) >> 1) * 9216u + (unsigned)((ht + 256 * ((j) & 1)) >> 3) * 144u + (unsigned)((ht + 256 * ((j) & 1)) & 7) * 16u)
#define CH_LOAD(R, cc) do { _Pragma("unroll") for (int j = 0; j < NPC; ++j) R[j] = *(const u32x4*)(src + (size_t)(cc) * CST + CH_SRC(j)); } while (0)
#define CH_STORE(R, bo) do { _Pragma("unroll") for (int j = 0; j < NPC; ++j) *(LAS u32x4*)(lds + (bo) + CH_DST(j)) = R[j]; } while (0)
        CH_LOAD(rA, 0); CH_STORE(rA, 0u);
        CH_LOAD(rB, 1); CH_LOAD(rC, 2); CH_LOAD(rD, 3); CH_LOAD(rA, 4);
        __syncthreads();
#pragma unroll 1
        for (int c = 0; c < 64; c += 4) {
            CH_STORE(rB, 46080u); if (c + 5 < 64) CH_LOAD(rB, c + 5);
            __syncthreads();
            CH_STORE(rC, 0u); if (c + 6 < 64) CH_LOAD(rC, c + 6);
            __syncthreads();
            CH_STORE(rD, 46080u); if (c + 7 < 64) CH_LOAD(rD, c + 7);
            __syncthreads();
            if (c + 4 < 64) CH_STORE(rA, 0u);
            if (c + 8 < 64) CH_LOAD(rA, c + 8);
            __syncthreads();
        }
#undef CH_SRC
#undef CH_DST
#undef CH_LOAD
#undef CH_STORE
        return;
    }
    __builtin_amdgcn_s_setprio(3);
    const float dlv = dlb[lane];
    __syncthreads();
    f32x4 S[4];
#pragma unroll
    for (int i = 0; i < 4; ++i) S[i] = (f32x4){0.f, 0.f, 0.f, 0.f};
    auto step = [&](const int c, const unsigned bo) {
        int hi_ = h; asm volatile("" : "+v"(hi_)); const float hf = (float)hi_;
        const float dl = chain ? __expf(64.f * __logf(1.f - exp2f(-5.f - hf))) : __int_as_float(__builtin_amdgcn_readlane(__float_as_int(dlv), c));
        u32x4 sb0, sb1; sb0.x = pack2(S[0][0], S[0][1]); sb0.y = pack2(S[0][2], S[0][3]); sb0.z = pack2(S[1][0], S[1][1]); sb0.w = pack2(S[1][2], S[1][3]);
        sb1.x = pack2(S[2][0], S[2][1]); sb1.y = pack2(S[2][2], S[2][3]); sb1.z = pack2(S[3][0], S[3][1]); sb1.w = pack2(S[3][2], S[3][3]);
        { bf16_t* sp = stp + (size_t)c * 4096; u32x2 t;
          t.x = sb0.x; t.y = sb0.y; *(u32x2*)(sp) = t; t.x = sb0.z; t.y = sb0.w; *(u32x2*)(sp + 16) = t;
          t.x = sb1.x; t.y = sb1.y; *(u32x2*)(sp + 32) = t; t.x = sb1.z; t.y = sb1.w; *(u32x2*)(sp + 48) = t; }
        bf16x8 Sb[2], Vb[2]; Sb[0] = __builtin_bit_cast(bf16x8, sb0); Sb[1] = __builtin_bit_cast(bf16x8, sb1);
        bf16x8 wf[4][2], kf[4][2]; u32x2 urr[4];
#pragma unroll
        for (int it = 0; it < 4; ++it) { urr[it] = *(const LAS u32x2*)(lds + bo + T_UT + (unsigned)(16 * w + col) * 144u + (unsigned)(16 * it + 4 * q) * 2u);
#pragma unroll
            for (int ks = 0; ks < 2; ++ks) { if (ROLE == 0) wf[it][ks] = afrag(lds, bo + T_W, it, ks, col, q); kf[it][ks] = afrag(lds, bo + T_KDT, it, ks, col, q); } }
        __builtin_amdgcn_sched_barrier(0);
        f32x4 vn[4];
#pragma unroll
        for (int it = 0; it < 4; ++it) {
            const u32x2 ur = urr[it];
            f32x4 u; u[0] = bflo(ur.x); u[1] = bfhi(ur.x); u[2] = bflo(ur.y); u[3] = bfhi(ur.y);
            if (ROLE == 0) { f32x4 a = (f32x4){0.f, 0.f, 0.f, 0.f};
#pragma unroll
                for (int ks = 0; ks < 2; ++ks) a = MFMA16(wf[it][ks], Sb[ks], a);
                u = u - a; }
            vn[it] = u; }
        u32x4 vb0, vb1; vb0.x = pack2(vn[0][0], vn[0][1]); vb0.y = pack2(vn[0][2], vn[0][3]); vb0.z = pack2(vn[1][0], vn[1][1]); vb0.w = pack2(vn[1][2], vn[1][3]);
        vb1.x = pack2(vn[2][0], vn[2][1]); vb1.y = pack2(vn[2][2], vn[2][3]); vb1.z = pack2(vn[3][0], vn[3][1]); vb1.w = pack2(vn[3][2], vn[3][3]);
        if (ROLE == 0) { bf16_t* vp = vnp + (size_t)c * 4096; u32x2 t;
          t.x = vb0.x; t.y = vb0.y; *(u32x2*)(vp) = t; t.x = vb0.z; t.y = vb0.w; *(u32x2*)(vp + 16) = t;
          t.x = vb1.x; t.y = vb1.y; *(u32x2*)(vp + 32) = t; t.x = vb1.z; t.y = vb1.w; *(u32x2*)(vp + 48) = t; }
        Vb[0] = __builtin_bit_cast(bf16x8, vb0); Vb[1] = __builtin_bit_cast(bf16x8, vb1);
#pragma unroll
        for (int rt = 0; rt < 4; ++rt) { f32x4 a = S[rt] * dl;
#pragma unroll
            for (int ks = 0; ks < 2; ++ks) a = MFMA16(kf[rt][ks], Vb[ks], a);
            S[rt] = a; }
    };
#pragma unroll 1
    for (int c = 0; c < 64; c += 2) {
        step(c, 0u);
        __syncthreads();
        step(c + 1, 46080u);
        __syncthreads();
    }
    __builtin_amdgcn_s_setprio(0);
    float* so = p.out + (chain ? O_PCREC : O_PBREC) + (size_t)((l * NBAT + n) * NH + h) * 4096 + 16 * w + col;
#pragma unroll
    for (int rt = 0; rt < 4; ++rt)
#pragma unroll
        for (int i = 0; i < 4; ++i) so[(16 * rt + 4 * q + i) * 64] = S[rt][i];
}

struct CoRegs { bf16x8 qgf[2], qkf[2], stf[4][2], vtf[4][2]; unsigned short gt[4][4]; };
template <class PT> DI void co_load(const PT& p, int task, CoRegs& R) {
    const int tid = opaque_tid(), wid = tid >> 6, lane = tid & 63, col = lane & 15, q = lane >> 4, chain = wid >> 2, it = wid & 3;
    const int nh = task >> 6, c = task & 63, n = nh / NH, h = nh % NH;
    const bf16_t* blk = chain ? (const bf16_t*)(p.ws + WS_CBLK + (size_t)task * 32768) : (const bf16_t*)(p.ws + WS_BBLK + (size_t)task * 40960);
    const bf16_t* qg = blk + (chain ? 4096 : 8192), *qk = qg + 4096;
    const bf16_t* st = (const bf16_t*)(p.ws + (chain ? WS_STC : WS_STB)) + (size_t)task * 4096;
    const bf16_t* vt = chain ? blk + 12288 : (const bf16_t*)(p.ws + WS_VNB) + (size_t)task * 4096;
#pragma unroll
    for (int ks = 0; ks < 2; ++ks) { R.qgf[ks] = *(const bf16x8*)(qg + (16 * it + col) * 64 + 32 * ks + 8 * q); R.qkf[ks] = *(const bf16x8*)(qk + (16 * it + col) * 64 + 32 * ks + 8 * q); }
#pragma unroll
    for (int ct = 0; ct < 4; ++ct)
#pragma unroll
        for (int ks = 0; ks < 2; ++ks) { R.stf[ct][ks] = *(const bf16x8*)(st + (16 * ct + col) * 64 + 32 * ks + 8 * q); R.vtf[ct][ks] = *(const bf16x8*)(vt + (16 * ct + col) * 64 + 32 * ks + 8 * q); }
    const int tok0 = c * 64 + 16 * it + 4 * q;
    const bf16_t* gate0 = (const bf16_t*)(p.ws + WS_R1) + (size_t)(n * T_ + tok0) * ZS + (chain ? CG : BZ) + h * 64 + col;
#pragma unroll
    for (int ct = 0; ct < 4; ++ct)
#pragma unroll
        for (int i = 0; i < 4; ++i) R.gt[ct][i] = gate0[(size_t)i * ZS + 16 * ct];
}
template <class PT> DI void co_compute(const PT& p, int l, int task, const CoRegs& R) {
    const int tid = opaque_tid(), wid = tid >> 6, lane = tid & 63, col = lane & 15, q = lane >> 4, chain = wid >> 2, it = wid & 3;
    const int nh = task >> 6, c = task & 63, n = nh / NH, h = nh % NH;
    const int tok0 = c * 64 + 16 * it + 4 * q;
    f32x4 o[4]; float ss[4] = {0.f, 0.f, 0.f, 0.f};
#pragma unroll
    for (int ct = 0; ct < 4; ++ct) { f32x4 a = (f32x4){0.f, 0.f, 0.f, 0.f};
#pragma unroll
        for (int ks = 0; ks < 2; ++ks) a = MFMA16(R.qgf[ks], R.stf[ct][ks], a);
#pragma unroll
        for (int ks = 0; ks < 2; ++ks) a = MFMA16(R.qkf[ks], R.vtf[ct][ks], a);
        o[ct] = a;
#pragma unroll
        for (int i = 0; i < 4; ++i) ss[i] += a[i] * a[i]; }
    const float* onp = p.in[chain ? I_ONORMC : I_ONORMB] + l * HD + col;
    bf16_t* mix0 = (bf16_t*)(p.ws + WS_MIX) + (size_t)(n * T_ + tok0) * MIXW + (chain ? 2 * GW : GW) + h * 64 + col;
#pragma unroll
    for (int i = 0; i < 4; ++i) { float s = ss[i]; s += __shfl_xor(s, 1); s += __shfl_xor(s, 2); s += __shfl_xor(s, 4); s += __shfl_xor(s, 8);
        const float r = rsqrtf(s * (1.f / 64.f) + EPS);
#pragma unroll
        for (int ct = 0; ct < 4; ++ct) mix0[(size_t)i * MIXW + 16 * ct] = f2bf(o[ct][i] * r * onp[16 * ct] * silu_f(bf2f(R.gt[ct][i]))); }
}
template <class PT> DI void chunk_out_phase(const PT& p, int l, int first, int stride) {
    constexpr int NT = 1536;
    if (first >= NT) return;
    CoRegs A, B;
    int t = first;
    co_load(p, t, A);
    for (;;) {
        const int t1 = t + stride; co_load(p, t1 < NT ? t1 : NT - 1, B);
        __builtin_amdgcn_sched_barrier(0);
        co_compute(p, l, t, A);
        if (t1 >= NT) break;
        const int t2 = t1 + stride; co_load(p, t2 < NT ? t2 : NT - 1, A);
        __builtin_amdgcn_sched_barrier(0);
        co_compute(p, l, t1, B);
        if (t2 >= NT) break;
        t = t2;
    }
}

template <class PT> DI void attn_task(const PT& p, int task) {
    const int nh = task >> 3, tile = task & 7, n = nh / NH, h = nh % NH, T0 = tile * 512;
    const int tid = opaque_tid(), wid = tid >> 6, lane = tid & 63, r = lane & 31, hh = lane >> 5;
    const bf16_t* qa = (const bf16_t*)(p.ws + WS_QA) + (size_t)nh * T_ * HD;
    const bf16_t* ka = (const bf16_t*)(p.ws + WS_KA) + (size_t)nh * T_ * HD;
    bf16_t* opart = (bf16_t*)(p.ws + WS_OPART); float* lse = (float*)(p.ws + WS_LSE);
    for (int u = wid; u < 48; u += 8) {
        const int br = u >> 4, within = u & 15;
        const int d = br == 0 ? 1 : (br == 1 ? 4 : 16), res = br == 0 ? 0 : (br == 1 ? (within >> 2) : within), qb = br == 0 ? within : (br == 1 ? (within & 3) : 0);
        const int L = T_ / d, Iq0 = T0 / d + 32 * qb;
        const int tq = (Iq0 + r) * d + res;
        bf16x8 Qf[4], KfA[2][4], KfB[2][4];
        f32x16 sacc[5];
#pragma unroll
        for (int s = 0; s < 4; ++s) Qf[s] = *(const bf16x8*)(qa + (size_t)tq * HD + 16 * s + 8 * hh);
#define ATT_KLOAD(KF, KT0, NKT) do { _Pragma("unroll") for (int kt = 0; kt < (NKT); ++kt) { const ptrdiff_t tk = (ptrdiff_t)(Iq0 - 128 + 32 * ((KT0) + kt) + r) * d + res;   \
            _Pragma("unroll") for (int s = 0; s < 4; ++s) KF[kt][s] = *(const bf16x8*)(ka + tk * HD + 16 * s + 8 * hh); } } while (0)
#define ATT_QK(KF, KT0, NKT) do { _Pragma("unroll") for (int kt = 0; kt < (NKT); ++kt) { const bool ok = (Iq0 - 128 + 32 * ((KT0) + kt) + r) >= 0; \
            f32x16 a; for (int i = 0; i < 16; ++i) a[i] = 0.f; \
            _Pragma("unroll") for (int s = 0; s < 4; ++s) { bf16x8 kf = KF[kt][s]; if (!ok) kf = (bf16x8){0, 0, 0, 0, 0, 0, 0, 0}; a = MFMA32(kf, Qf[s], a); } \
            sacc[(KT0) + kt] = a; } } while (0)
        const bf16_t* vt = (const bf16_t*)(p.ws + WS_VT) + (size_t)br * (SZ_HEADBUF / 2) + (size_t)nh * HD * T_ + (size_t)res * L;
        u32x2 VloA[2][2][2], VhiA[2][2][2], VloB[2][2][2], VhiB[2][2][2];
        const ptrdiff_t vi0 = (ptrdiff_t)(Iq0 - 128 + 4 * hh);
#define ATT_VLOAD(VLO, VHI, KT0, NKT) do { _Pragma("unroll") for (int kt = 0; kt < (NKT); ++kt) _Pragma("unroll") for (int s = 0; s < 2; ++s) _Pragma("unroll") for (int dt = 0; dt < 2; ++dt) { \
            const bf16_t* vp = vt + (size_t)(32 * dt + r) * T_ + vi0 + 32 * ((KT0) + kt) + 16 * s; VLO[kt][s][dt] = *(const u32x2*)(vp); VHI[kt][s][dt] = *(const u32x2*)(vp + 8); } } while (0)
#define ATT_PV(VLO, VHI, KT0, NKT) do { _Pragma("unroll") for (int kt = 0; kt < (NKT); ++kt) _Pragma("unroll") for (int s = 0; s < 2; ++s) { const int kx = (KT0) + kt; \
            const bf16x8 pf = mk8(pack2(sacc[kx][8 * s], sacc[kx][8 * s + 1]), pack2(sacc[kx][8 * s + 2], sacc[kx][8 * s + 3]), pack2(sacc[kx][8 * s + 4], sacc[kx][8 * s + 5]), pack2(sacc[kx][8 * s + 6], sacc[kx][8 * s + 7])); \
            const int idx0 = Iq0 - 128 + 32 * kx + 16 * s + 4 * hh; \
            _Pragma("unroll") for (int dt = 0; dt < 2; ++dt) { u32x2 lo = VLO[kt][s][dt], hi = VHI[kt][s][dt]; \
                if (idx0 < 0) { lo.x = 0u; lo.y = 0u; } if (idx0 + 8 < 0) { hi.x = 0u; hi.y = 0u; } \
                oacc[dt] = MFMA32(mk8(lo.x, lo.y, hi.x, hi.y), pf, oacc[dt]); } } } while (0)
        ATT_KLOAD(KfA, 0, 2); ATT_KLOAD(KfB, 2, 2);
        __builtin_amdgcn_sched_barrier(0);
        ATT_QK(KfA, 0, 2);
        __builtin_amdgcn_sched_barrier(0);
        ATT_KLOAD(KfA, 4, 1);
        __builtin_amdgcn_sched_barrier(0);
        ATT_QK(KfB, 2, 2);
        __builtin_amdgcn_sched_barrier(0);
        ATT_VLOAD(VloA, VhiA, 0, 2);
        __builtin_amdgcn_sched_barrier(0);
        ATT_QK(KfA, 4, 1);
        __builtin_amdgcn_sched_barrier(0);
        ATT_VLOAD(VloB, VhiB, 2, 2);
        __builtin_amdgcn_sched_barrier(0);
        float m = -1e30f;
        int rq = r - crow(0, hh); asm volatile("" : "+v"(rq));
        const int kmin = 128 - Iq0;
#pragma unroll
        for (int kt = 0; kt < 5; ++kt)
#pragma unroll
            for (int i = 0; i < 16; ++i) { const int kc = 32 * kt + crow(i, 0); const int kk = kc + 4 * hh; const bool valid = ((unsigned)(kc - rq) <= 128u) && (kk >= kmin);
                const float s = valid ? sacc[kt][i] : -1e30f; sacc[kt][i] = s; m = fmaxf(m, s); }
        m = fmaxf(m, __shfl_xor(m, 32));
        float lsum = 0.f;
#pragma unroll
        for (int kt = 0; kt < 5; ++kt)
#pragma unroll
            for (int i = 0; i < 16; ++i) { const float pe = __expf(sacc[kt][i] - m); sacc[kt][i] = pe; lsum += pe; }
        lsum += __shfl_xor(lsum, 32);
        f32x16 oacc[2];
#pragma unroll
        for (int dt = 0; dt < 2; ++dt) for (int i = 0; i < 16; ++i) oacc[dt][i] = 0.f;
        ATT_PV(VloA, VhiA, 0, 2);
        __builtin_amdgcn_sched_barrier(0);
        ATT_VLOAD(VloA, VhiA, 4, 1);
        __builtin_amdgcn_sched_barrier(0);
        ATT_PV(VloB, VhiB, 2, 2);
        __builtin_amdgcn_sched_barrier(0);
        ATT_PV(VloA, VhiA, 4, 1);
#undef ATT_KLOAD
#undef ATT_QK
#undef ATT_VLOAD
#undef ATT_PV
        const float inv = 1.f / lsum;
        bf16_t* op = opart + ((size_t)(br * 24 + nh) * T_ + tq) * HD;
#pragma unroll
        for (int dt = 0; dt < 2; ++dt)
#pragma unroll
            for (int g = 0; g < 4; ++g) { u32x2 w; w.x = pack2(oacc[dt][4 * g] * inv, oacc[dt][4 * g + 1] * inv); w.y = pack2(oacc[dt][4 * g + 2] * inv, oacc[dt][4 * g + 3] * inv);
                *(u32x2*)(op + 32 * dt + 8 * g + 4 * hh) = w; }
        if (hh == 0) lse[(size_t)(br * 24 + nh) * T_ + tq] = m + __logf(lsum);
    }
    __syncthreads();
    for (int it = 0; it < 8; ++it) { const int item = it * 512 + tid, t = T0 + (item >> 3), seg = item & 7;
        const float l0 = lse[(size_t)(0 * 24 + nh) * T_ + t], l1 = lse[(size_t)(1 * 24 + nh) * T_ + t], l2 = lse[(size_t)(2 * 24 + nh) * T_ + t];
        const float mx = fmaxf(l0, fmaxf(l1, l2)); float w0 = __expf(l0 - mx), w1 = __expf(l1 - mx), w2 = __expf(l2 - mx); const float iv = 1.f / (w0 + w1 + w2); w0 *= iv; w1 *= iv; w2 *= iv;
        float acc[8];
#pragma unroll
        for (int e = 0; e < 8; ++e) acc[e] = 0.f;
#pragma unroll
        for (int g = 0; g < 3; ++g) { const float wg = g == 0 ? w0 : (g == 1 ? w1 : w2); float x[8]; unpack8(*(const uint4*)(opart + ((size_t)(g * 24 + nh) * T_ + t) * HD + 8 * seg), x);
#pragma unroll
            for (int e = 0; e < 8; ++e) acc[e] += wg * x[e]; }
        *(uint4*)((bf16_t*)(p.ws + WS_MIX) + (size_t)(n * T_ + t) * MIXW + h * 64 + 8 * seg) = pack8(acc); }
    __syncthreads();
}
#define XB_MAKE() XcdBarrier xb_; xb_.bar = (unsigned*)(ws + WS_BAR); xb_.x = xb_xcc_id(); xb_.st = (volatile LAS unsigned*)((LAS unsigned char*)smem + LDS_BYTES - 16)
#if defined(PROBE_DUP) && PROBE_DUP == 6
#define GSYNC() do { XB_MAKE(); xcd_barrier(xb_); xcd_barrier(xb_); } while (0)
#else
#define GSYNC() do { XB_MAKE(); xcd_barrier(xb_); } while (0)
#endif
#ifndef PROBE_DUP
#define PROBE_DUP 0
#endif
DI float rs_from_slots32(const float* p) { float s = 0.f;
#pragma unroll
    for (int i = 0; i < 32; ++i) s += p[i];
    return rsqrtf(s * (1.f / DM) + EPS); }

__global__ void __launch_bounds__(512, 2) mega_fwd(Params p) {
    extern __shared__ __attribute__((aligned(16))) unsigned char smem[];
    cg::grid_group grid = cg::this_grid();
    const int G = gridDim.x, b = blockIdx.x, tid = threadIdx.x;
    PG8_LAS unsigned char* glds = (PG8_LAS unsigned char*)smem;
    unsigned char* ws = p.ws; float* out_g = p.out;
    static_assert(sizeof(Params) <= 256, "tab");
    volatile LAS unsigned* xst = (volatile LAS unsigned*)((LAS unsigned char*)smem + LDS_BYTES - 16);
    if (tid < 4) xst[tid] = 0u;
    __syncthreads();
    (void)xcd_barrier_post((unsigned*)(p.ws + WS_BAR), xst);
    { const unsigned long long* ka = (const unsigned long long*)__builtin_amdgcn_kernarg_segment_ptr();
      if (tid < (int)(sizeof(Params) / 8)) ((unsigned long long*)(p.ws + WS_TAB))[tid] = ka[tid]; }
#ifndef NO_P0
    phase0(smem, p);
#if PROBE_DUP == 3
    phase0(smem, p);
#endif
#endif
    if (p.out == nullptr) grid.sync();
    GSYNC();
#pragma unroll 1
    for (int l = 0; l < 2; ++l) {
        PView p; p.in.ws = ws; p.out = out_g; p.ws = ws;
#define rowss ((float*)(ws + WS_ROWSS))
#define rowssS ((float*)(ws + WS_ROWSS_S))
        { float* zd = (float*)(ws + WS_ZD); const float* rsS = rowssS + (size_t)(2 * l) * 32 * 32;
#ifndef NO_SKINNY
          for (int skrep = 0; skrep < (PROBE_DUP == 35 ? 2 : 1); ++skrep)
          skinny<DM>(smem, (const bf16_t*)(ws + WS_XSB), (const bf16_t*)(ws + WS_WT_IN + l * SZ_WT_IN), ZS / 32, G - 1 - b, G,
                 [&](int row, int col, float v, int) { zd[(size_t)row * ZS + col] = v * rs_from_slots32(rsS + row * 32); });
#endif
          pg8::Gemm g{(const bf16_t*)(ws + WS_XB), (const bf16_t*)(ws + WS_WT_IN + l * SZ_WT_IN), MP, ZS, DM}; pg8::StaticOrder S; S.init(MP, ZS, G, b);
          EpiZ<0> E{(bf16_t*)(ws + WS_R1), ZS, rowss + (size_t)(2 * l) * MP * 16};
#if !defined(NO_GEMM) && !defined(NO_G1)
          pg8::gemm_phase<EpiZ<0>, pg8::StaticOrder, false>(glds, g, S, E, nullptr);
          { const int nfull = (MP / 256) * (ZS / 256) % G;
            if (nfull > 0 && b >= nfull) { __syncthreads(); deferred_weight_tiles(smem, p, l, b - nfull, G - nfull); } else if (nfull == 0) { __syncthreads(); deferred_weight_tiles(smem, p, l, b, G); } }
#if PROBE_DUP == 31
          __syncthreads();
          pg8::gemm_phase<EpiZ<0>, pg8::StaticOrder, false>(glds, g, S, E, nullptr);
#endif
#endif
          }
        GSYNC();
        if (b < 76) {
#ifndef NO_DEC
            decode_task(smem, p, l, b);
#if PROBE_DUP == 15
            decode_task(smem, p, l, b);
#endif
#endif
        }
#if PROBE_DUP == 1
        for (int rep = 0; rep < 2; ++rep)
#endif
        for (int k = 0;; ++k) {
            int task;
            if (G >= 256) {
                if (k < 2) { if (b < 72) continue; task = k * (G - 72) + (b - 72); }
                else if (k < 4) { if (b < 24) continue; task = 2 * (G - 72) + (k - 2) * (G - 24) + (b - 24); }
                else task = 2 * (G - 72) + 2 * (G - 24) + (k - 4) * G + b;
            } else task = k * G + b;
            if (task >= 1536 * 3 + 256) break;
            const unsigned cslot = (unsigned)(l * 3071 + task);
            if (task < 3071) {
                f32x4 cv[8]; copy_slot_load(p, cslot, cv);
                if (task < 1536) chunk_prep<true>(smem, p, l, task);
                else chunk_prep<false>(smem, p, l, task - 1536);
                copy_slot_store(p, cslot, cv);
            } else {
                if (task < 1536) chunk_prep<true>(smem, p, l, task);
                else if (task < 3072) chunk_prep<false>(smem, p, l, task - 1536);
                else if (task < 4608) aprep_task(smem, p, l, task - 3072);
                else dmix_task(p, l, task - 4608);
            }
        }
        GSYNC();
        { const int nchain = 48;
          if (b < nchain) {
#ifndef NO_CHAIN
              if (b < 24) chain_phase<0>(smem, p, l, b); else chain_phase<1>(smem, p, l, b - 24);
#if PROBE_DUP == 2 || PROBE_DUP == 21
              if (b < 24) chain_phase<0>(smem, p, l, b); else chain_phase<1>(smem, p, l, b - 24);
#endif
#endif
          } else { for (int task0 = b - nchain; task0 < 192; task0 += G - nchain) {
              int task = task0;
              if (G == 256) { const int a = b - nchain, x = a & 7, j = a >> 3; if (j >= 24) break; task = (x + 8 * (j >> 3)) * 8 + (j & 7); }
#ifndef NO_ATTN
              attn_task(p, task);
#if PROBE_DUP == 2 || PROBE_DUP == 22
              attn_task(p, task);
#endif
#endif
            }
          } }
        GSYNC();
#ifndef NO_COUT
#if PROBE_DUP == 4
#pragma unroll 1
        for (int rep = 0; rep < 2; ++rep)
#endif
        chunk_out_phase(p, l, b, G);
        if (l == 0) { __syncthreads(); deferred_weight_tiles(smem, p, 2, b, G); }
#endif
        GSYNC();
        { const float* xsf = l == 0 ? p.in[I_XS] : (const float*)(ws + WS_XSF); float* hsf = (float*)(ws + WS_HSF); bf16_t* hsb = (bf16_t*)(ws + WS_HSB);
          float* ssS = rowssS + (size_t)(2 * l + 1) * 32 * 32;
#ifndef NO_SKINNY
          for (int skrep = 0; skrep < (PROBE_DUP == 35 ? 2 : 1); ++skrep)
          skinny<MIXW>(smem, (const bf16_t*)(ws + WS_MIXS), (const bf16_t*)(ws + WS_WT_OUT + l * SZ_WT_OUT), DM / 32, G - 1 - b, G,
                 [&](int row, int col, float v, int tile) { const float y = v + xsf[row * DM + col]; hsf[row * DM + col] = y; hsb[row * DM + col] = f2bf(y);
                     float s = y * y; s += __shfl_xor(s, 1); s += __shfl_xor(s, 2); s += __shfl_xor(s, 4); s += __shfl_xor(s, 8); s += __shfl_xor(s, 16);
                     if ((col & 31) == 0) ssS[row * 32 + tile] = s; });
#endif
          pg8::Gemm g{(const bf16_t*)(ws + WS_MIX), (const bf16_t*)(ws + WS_WT_OUT + l * SZ_WT_OUT), MP, DM, MIXW}; pg8::StaticOrder S; S.init(MP, DM, G, b);
          EpiRes E{nullptr, (const bf16_t*)(ws + WS_XB), nullptr, (bf16_t*)(ws + WS_HB), rowss + (size_t)(2 * l + 1) * MP * 16};
#if !defined(NO_GEMM) && !defined(NO_G2)
          pg8::gemm_phase<EpiRes, pg8::StaticOrder, false>(glds, g, S, E, nullptr);
#if PROBE_DUP == 32
          __syncthreads();
          pg8::gemm_phase<EpiRes, pg8::StaticOrder, false>(glds, g, S, E, nullptr);
#endif
#endif
          }
        GSYNC();
        { bf16_t* us = (bf16_t*)(ws + WS_US); const float* rsS = rowssS + (size_t)(2 * l + 1) * 32 * 32;
#ifndef NO_SKINNY
          for (int skrep = 0; skrep < (PROBE_DUP == 35 ? 2 : 1); ++skrep)
          skinny<DM>(smem, (const bf16_t*)(ws + WS_HSB), (const bf16_t*)(ws + WS_WT_UP + l * SZ_WT_UP), DFF / 32, G - 1 - b, G,
                 [&](int row, int col, float v, int) { const float y = fmaxf(v * rs_from_slots32(rsS + row * 32), 0.f); us[(size_t)row * DFF + col] = f2bf(y * y); });
#endif
          pg8::Gemm g{(const bf16_t*)(ws + WS_HB), (const bf16_t*)(ws + WS_WT_UP + l * SZ_WT_UP), MP, DFF, DM}; pg8::StaticOrder S; S.init(MP, DFF, G, b);
          EpiZ<1> E{(bf16_t*)(ws + WS_R1), DFF, rowss + (size_t)(2 * l + 1) * MP * 16};
#if !defined(NO_GEMM) && !defined(NO_G3)
          pg8::gemm_phase<EpiZ<1>, pg8::StaticOrder, false>(glds, g, S, E, nullptr);
#if PROBE_DUP == 5
          __syncthreads();
          pg8::gemm_phase<EpiZ<1>, pg8::StaticOrder, false>(glds, g, S, E, nullptr);
#endif
#endif
          }
        GSYNC();
        { const float* hsf = (const float*)(ws + WS_HSF); float* xo = l == 0 ? (float*)(ws + WS_XSF) : p.out + O_YS; bf16_t* xsb = (bf16_t*)(ws + WS_XSB);
          float* ssS = rowssS + (size_t)(2 * l + 2) * 32 * 32;
#ifndef NO_SKINNY
          for (int skrep = 0; skrep < (PROBE_DUP == 35 ? 2 : 1); ++skrep)
          skinny<DFF>(smem, (const bf16_t*)(ws + WS_US), (const bf16_t*)(ws + WS_WT_DOWN + l * SZ_WT_DOWN), DM / 32, G - 1 - b, G,
                 [&](int row, int col, float v, int tile) { const float y = v + hsf[row * DM + col]; xo[row * DM + col] = y; xsb[row * DM + col] = f2bf(y);
                     float s = y * y; s += __shfl_xor(s, 1); s += __shfl_xor(s, 2); s += __shfl_xor(s, 4); s += __shfl_xor(s, 8); s += __shfl_xor(s, 16);
                     if ((col & 31) == 0) ssS[row * 32 + tile] = s; });
#endif
          pg8::Gemm g{(const bf16_t*)(ws + WS_R1), (const bf16_t*)(ws + WS_WT_DOWN + l * SZ_WT_DOWN), MP, DM, DFF}; pg8::StaticOrder S; S.init(MP, DM, G, b);
          EpiRes E{nullptr, (const bf16_t*)(ws + WS_HB), l == 0 ? nullptr : p.out + O_YP, l == 0 ? (bf16_t*)(ws + WS_XB) : nullptr, rowss + (size_t)(2 * l + 2) * MP * 16};
#if !defined(NO_GEMM) && !defined(NO_G4)
          pg8::gemm_phase<EpiRes, pg8::StaticOrder, false>(glds, g, S, E, nullptr);
#if PROBE_DUP == 34
          __syncthreads();
          pg8::gemm_phase<EpiRes, pg8::StaticOrder, false>(glds, g, S, E, nullptr);
#endif
#endif
          }
        if (l == 0) GSYNC();
    }
}

extern "C" void kernel_launch(void* const* d_in, const int* in_sizes, int n_in, void* d_out, int out_size, void* d_ws, size_t ws_size, hipStream_t stream) {
    static int grid = 0;
    if (grid == 0) {
        if (n_in != 22 || (size_t)out_size != O_END || ws_size < WS_END) { fprintf(stderr, "kernel_launch: unexpected shapes: n_in %d out %d (want %zu) ws %zu (want %zu)\n", n_in, out_size, (size_t)O_END, ws_size, (size_t)WS_END); grid = -1; return; }
        int dev = 0, cus = 0, per_cu = 0;
        hipGetDevice(&dev); hipDeviceGetAttribute(&cus, hipDeviceAttributeMultiprocessorCount, dev);
        if (hipFuncSetAttribute((const void*)mega_fwd, hipFuncAttributeMaxDynamicSharedMemorySize, LDS_BYTES) != hipSuccess) { fprintf(stderr, "kernel_launch: hipFuncSetAttribute failed\n"); grid = -1; return; }
        if (hipOccupancyMaxActiveBlocksPerMultiprocessor(&per_cu, (const void*)mega_fwd, 512, LDS_BYTES) != hipSuccess || per_cu < 1) { fprintf(stderr, "kernel_launch: occupancy query says %d\n", per_cu); per_cu = 1; }
        (void)hipGetLastError();
        grid = cus;
    }
    if (grid < 0) return;
    if (hipMemsetAsync((char*)d_ws + WS_BAR, 0, 16384, stream) != hipSuccess) { fprintf(stderr, "kernel_launch: memset of barrier words failed\n"); return; }
    Params p{};
    for (int i = 0; i < 22; ++i) p.in[i] = (const float*)d_in[i];
    p.out = (float*)d_out; p.ws = (unsigned char*)d_ws;
    void* args[] = {&p};
    hipError_t e = hipLaunchCooperativeKernel((const void*)mega_fwd, dim3(grid), dim3(512), args, LDS_BYTES, stream);
    if (e != hipSuccess) fprintf(stderr, "cooperative launch failed: %s (grid %d)\n", hipGetErrorString(e), grid);
}
```
